# Optimizing an MI355X kernel written in HIP

```python
import jax, jax.numpy as jnp
from jax import lax
import numpy as np

D_MODEL = 1024
BATCH = 16
SEQ = 256
DEPTH = 2
DEC_BATCH = 4
DEC_SEQ = 1024
PAST_LEN = 256

GRID_W = 64
CONV_W = 512
N_HEADS = 8
HEAD_DIM = 64
ATTN_W = N_HEADS * HEAD_DIM
POOL_W = 512
POOL_SIZES = (2, 4, 8, 16)
POOL_GROUP = POOL_W // len(POOL_SIZES)
N_BRANCH = 3
BRANCH_W = 512
WIN_H_MAX = 8
WIN_W = 16
Q_BLK_W = 16
K_BAND_W = Q_BLK_W + WIN_W
CTX_Q_BLOCK = 128
D_FF = 2816
CONV_K = 3
EPS = 1e-6
IN_W = 3 * CONV_W + 3 * ATTN_W + POOL_W + N_BRANCH * D_MODEL

kernel_name = "hybrid_diffusion_prefix_trunk_step"

F32 = jnp.float32


def rmsnorm(x, g):
    xf = x.astype(F32)
    y = xf * lax.rsqrt(jnp.mean(xf * xf, axis=-1, keepdims=True) + EPS)
    return (y * g.astype(F32)).astype(x.dtype)


def dwconv3(x, w):
    xp = jnp.pad(x, ((0, 0), (1, 1), (0, 0)))
    return xp[:, :-2] * w[0] + xp[:, 1:-1] * w[1] + xp[:, 2:] * w[2]


def adaln(cvec, w_mod, b_mod):
    m = jax.nn.silu(cvec) @ w_mod + b_mod
    return jnp.split(m[:, None, :], 6, axis=-1)


def multiscale_pool(p, pool_w, pool_scale):
    Bn, N, _ = p.shape
    pf = p.astype(F32)
    cs = jnp.concatenate([jnp.zeros((Bn, 1, POOL_W), F32), jnp.cumsum(pf, axis=1)], axis=1)
    t = np.arange(N)
    outs = []
    for gi, w in enumerate(POOL_SIZES):
        lo = np.clip(t - w // 2, 0, N)
        hi = np.clip(t - w // 2 + w, 0, N)
        cnt = (hi - lo).astype(np.float32)[None, :, None]
        sl = slice(gi * POOL_GROUP, (gi + 1) * POOL_GROUP)
        mean = (cs[:, hi, sl] - cs[:, lo, sl]) / cnt
        outs.append(mean - pf[:, :, sl])
    d = jnp.stack(outs, axis=2).astype(p.dtype)
    y = jnp.einsum('bngc,gce->bnge', d, pool_w).reshape(Bn, N, POOL_W)
    return y * pool_scale


def ctx_attention(q, k, v):
    Bn, L = q.shape[:2]
    nb = L // CTX_Q_BLOCK
    qb = q.reshape(Bn, nb, CTX_Q_BLOCK, N_HEADS, HEAD_DIM).transpose(1, 0, 2, 3, 4)
    scale = HEAD_DIM ** -0.5

    def one(qblk):
        s = jnp.einsum('bqhd,bkhd->bhqk', qblk, k).astype(F32) * scale
        pr = jax.nn.softmax(s, axis=-1).astype(v.dtype)
        return jnp.einsum('bhqk,bkhd->bqhd', pr, v)

    o = lax.map(one, qb)
    return o.transpose(1, 0, 2, 3, 4).reshape(Bn, L, ATTN_W)


def neighbourhood_attention(q, k, v, k_ctx, v_ctx, rpb):
    Bn, S = q.shape[:2]
    rows = S // GRID_W
    kh = min(WIN_H_MAX, rows)
    ncb = GRID_W // Q_BLK_W
    r = np.arange(rows)
    row_idx = np.clip(r - kh // 2, 0, rows - kh)[:, None] + np.arange(kh)
    j = np.arange(ncb)
    col_idx = np.clip(j * Q_BLK_W - WIN_W // 2, 0, GRID_W - K_BAND_W)[:, None] + np.arange(K_BAND_W)
    qc = j[:, None] * Q_BLK_W + np.arange(Q_BLK_W)
    col_start = np.clip(qc - WIN_W // 2, 0, GRID_W - WIN_W)[..., None]
    kc = col_idx[:, None, :]
    valid = (kc >= col_start) & (kc < col_start + WIN_W)
    dr = row_idx - r[:, None] + WIN_H_MAX - 1
    dc = np.clip(kc - qc[..., None] + WIN_W - 1, 0, 2 * WIN_W - 2)
    bias = rpb[:, dr[:, None, None, :, None], dc[None, :, :, None, :]].astype(F32)

    qg = q.reshape(Bn, rows, ncb, Q_BLK_W, N_HEADS, HEAD_DIM)
    kgrid = k.reshape(Bn, rows, GRID_W, N_HEADS, HEAD_DIM)
    vgrid = v.reshape(Bn, rows, GRID_W, N_HEADS, HEAD_DIM)
    kg = kgrid[:, row_idx][:, :, :, col_idx]
    vg = vgrid[:, row_idx][:, :, :, col_idx]
    scale = HEAD_DIM ** -0.5
    s_lat = jnp.einsum('brjqhd,brkjchd->bhrjqkc', qg, kg).astype(F32) * scale + bias[None]
    s_lat = jnp.where(valid[None, None, None, :, :, None, :], s_lat, -jnp.inf)
    s_ctx = jnp.einsum('brjqhd,bhld->bhrjql', qg, k_ctx).astype(F32) * scale
    nlat = kh * K_BAND_W
    s = jnp.concatenate([s_lat.reshape(s_lat.shape[:5] + (nlat,)), s_ctx], axis=-1)
    pr = jax.nn.softmax(s, axis=-1).astype(v.dtype)
    p_lat = pr[..., :nlat].reshape(s_lat.shape)
    p_ctx = pr[..., nlat:]
    o = (jnp.einsum('bhrjqkc,brkjchd->brjqhd', p_lat, vg)
         + jnp.einsum('bhrjql,bhld->brjqhd', p_ctx, v_ctx))
    return o.reshape(Bn, S, ATTN_W)


def token_mixer(h, w_in, conv_w, pool_w, pool_scale, w_branch, w_out, attend):
    Bn, N, _ = h.shape
    z = h @ w_in
    sizes = [CONV_W] * 3 + [ATTN_W] * 3 + [POOL_W]
    pts, acc = [], 0
    for sz in sizes:
        acc += sz
        pts.append(acc)
    b_g, c_g, hc, q, k, v, pz, gz = jnp.split(z, pts, axis=-1)
    y_conv = b_g * dwconv3(c_g * hc, conv_w)
    q = q.reshape(Bn, N, N_HEADS, HEAD_DIM)
    k = k.reshape(Bn, N, N_HEADS, HEAD_DIM)
    v = v.reshape(Bn, N, N_HEADS, HEAD_DIM)
    y_attn = attend(q, k, v)
    y_pool = multiscale_pool(pz, pool_w, pool_scale)
    ys = jnp.stack([y_conv, y_attn, y_pool], axis=2)
    proj = jnp.einsum('bnic,icd->bnid', ys, w_branch)
    gates = jax.nn.sigmoid(gz.astype(F32)).astype(h.dtype).reshape(Bn, N, N_BRANCH, D_MODEL)
    merged = jnp.sum(gates * proj, axis=2)
    return merged @ w_out, k.transpose(0, 2, 1, 3), v.transpose(0, 2, 1, 3)


def conv_glu(h, w_up, conv, w_down):
    u, val = jnp.split(h @ w_up, 2, axis=-1)
    u = dwconv3(u, conv)
    return (jax.nn.gelu(u, approximate=True) * val) @ w_down


def trunk_layer(x, mod, g1n, g2n, w_in, conv_w, pool_w, pool_scale, w_branch, w_out,
                w_up, f_conv, w_down, attend):
    sh1, sc1, gt1, sh2, sc2, gt2 = mod
    h = rmsnorm(x, g1n) * (1 + sc1) + sh1
    mix, k, v = token_mixer(h, w_in, conv_w, pool_w, pool_scale, w_branch, w_out, attend)
    x = x + gt1 * mix
    h = rmsnorm(x, g2n) * (1 + sc2) + sh2
    x = x + gt2 * conv_glu(h, w_up, f_conv, w_down)
    return x, k, v


def setup_inputs(seed: int = 0) -> dict:
    key = jax.random.key(seed)
    ks = jax.random.split(key, 24)
    nrm = jax.random.normal
    D = D_MODEL
    return {
        "x_prompt": nrm(ks[0], (BATCH, SEQ, D), F32),
        "x_sample": nrm(ks[1], (DEC_BATCH, DEC_SEQ, D), F32),
        "cache_kv": nrm(ks[2], (DEC_BATCH, DEPTH, 2, N_HEADS, PAST_LEN, HEAD_DIM), F32),
        "c": nrm(ks[3], (DEC_BATCH, D), F32),
        "c_ctx": nrm(ks[4], (D,), F32),
        "w_mod": nrm(ks[5], (DEPTH, D, 6 * D), F32) * (0.5 * D ** -0.5),
        "b_mod": nrm(ks[6], (DEPTH, 6 * D), F32) * 0.02,
        "g_norm1": 1.0 + 0.02 * nrm(ks[7], (DEPTH, D), F32),
        "g_norm2": 1.0 + 0.02 * nrm(ks[8], (DEPTH, D), F32),
        "w_in": nrm(ks[9], (DEPTH, D, IN_W), F32) * D ** -0.5,
        "conv_w": nrm(ks[10], (DEPTH, CONV_K, CONV_W), F32) * CONV_K ** -0.5,
        "rpb": nrm(ks[11], (DEPTH, N_HEADS, 2 * WIN_H_MAX - 1, 2 * WIN_W - 1), F32) * 0.1,
        "pool_w": nrm(ks[12], (DEPTH, len(POOL_SIZES), POOL_GROUP, POOL_GROUP), F32) * POOL_GROUP ** -0.5,
        "pool_scale": 1.0 + 0.02 * nrm(ks[13], (DEPTH, POOL_W), F32),
        "w_branch": nrm(ks[14], (DEPTH, N_BRANCH, BRANCH_W, D), F32) * BRANCH_W ** -0.5,
        "w_out": nrm(ks[15], (DEPTH, D, D), F32) * D ** -0.5,
        "ffn_w_up": nrm(ks[16], (DEPTH, D, 2 * D_FF), F32) * D ** -0.5,
        "ffn_conv": nrm(ks[17], (DEPTH, CONV_K, D_FF), F32) * CONV_K ** -0.5,
        "ffn_w_down": nrm(ks[18], (DEPTH, D_FF, D), F32) * D_FF ** -0.5,
        "g_final": 1.0 + 0.02 * nrm(ks[19], (D,), F32),
    }


def reference(x_prompt, x_sample, cache_kv, c, c_ctx, w_mod, b_mod, g_norm1, g_norm2, w_in,
              conv_w, rpb, pool_w, pool_scale, w_branch, w_out, ffn_w_up, ffn_conv, ffn_w_down,
              g_final):
    xp = x_prompt
    xs = x_sample
    kv_layers = []
    for l in range(DEPTH):
        shared = (g_norm1[l], g_norm2[l], w_in[l], conv_w[l], pool_w[l], pool_scale[l],
                  w_branch[l], w_out[l], ffn_w_up[l], ffn_conv[l], ffn_w_down[l])
        mod_ctx = adaln(c_ctx[None, :], w_mod[l], b_mod[l])
        xp, k_new, v_new = trunk_layer(xp, mod_ctx, *shared, attend=ctx_attention)
        kv_layers.append(jnp.stack([k_new, v_new], axis=1))
        mod_lat = adaln(c, w_mod[l], b_mod[l])
        k_ctx = cache_kv[:, l, 0]
        v_ctx = cache_kv[:, l, 1]
        rb = rpb[l]
        attend_lat = lambda q, k, v, kc=k_ctx, vc=v_ctx, rb=rb: neighbourhood_attention(q, k, v, kc, vc, rb)
        xs, _, _ = trunk_layer(xs, mod_lat, *shared, attend=attend_lat)
    y_prompt = rmsnorm(xp, g_final)
    y_sample = rmsnorm(xs, g_final)
    kv_state = jnp.stack(kv_layers, axis=1)
    return (y_prompt, y_sample, kv_state)
```

```cpp
#include <hip/hip_runtime.h>
#include <hip/hip_cooperative_groups.h>
#include <cstdio>
namespace cg = cooperative_groups;

typedef unsigned short bf16_t;
typedef short bf16x8 __attribute__((ext_vector_type(8)));
typedef float f32x4 __attribute__((ext_vector_type(4)));
typedef unsigned u32x4 __attribute__((ext_vector_type(4)));
typedef unsigned u32x2 __attribute__((ext_vector_type(2)));

#define DI __device__ __forceinline__
DI int tidx() { int t = threadIdx.x; asm volatile("" : "+v"(t)); return t; }
DI int bidx() { int b = blockIdx.x; asm volatile("" : "+s"(b)); return b; }

constexpr int D = 1024, NTOK = 8192, NCTX = 4096, INW = 6656, DFF = 2816;
constexpr int NTHREADS = 256;

struct Params {
  const float *x_prompt, *x_sample, *cache_kv, *c, *c_ctx, *w_mod, *b_mod, *g1, *g2, *w_in, *conv_w, *rpb, *pool_w,
      *pool_scale, *w_branch, *w_out, *w_up, *f_conv, *w_down, *g_final;
  float* out;
  float* MOD;
  float* X;
  bf16_t *KC, *VCT, *WIN, *WB, *WO, *WU, *WD, *H, *Z, *U, *YS, *MERGED, *VT, *ACT;
};

typedef float f32x2 __attribute__((ext_vector_type(2)));
typedef __bf16 bf16x2_t __attribute__((ext_vector_type(2)));
DI unsigned cvt_pk_bf16(float lo, float hi) {
  const f32x2 v = {lo, hi};
  return __builtin_bit_cast(unsigned, __builtin_convertvector(v, bf16x2_t));
}
DI float bf_lo(unsigned u) { return __uint_as_float(u << 16); }
DI float bf_hi(unsigned u) { return __uint_as_float(u & 0xffff0000u); }
DI float wave_sum(float v) {
#pragma unroll
  for (int o = 32; o > 0; o >>= 1) v += __shfl_xor(v, o);
  return v;
}
DI const float* xin_row(const Params& p, int row) {
  return row < NCTX ? p.x_prompt + (size_t)row * D : p.x_sample + (size_t)(row - NCTX) * D;
}
DI int vec_of_row(int row) { return row < NCTX ? 0 : 1 + ((row - NCTX) >> 10); }
DI bool seq_first(int row) { return row < NCTX ? ((row & 255) == 0) : ((row & 1023) == 0); }
DI bool seq_last(int row) { return row < NCTX ? ((row & 255) == 255) : ((row & 1023) == 1023); }

DI void transpose_tile(const float* __restrict__ src, int srcld, bf16_t* __restrict__ dst, int dstld, int kt, int nt,
                       float* sm) {
  const int t = tidx();
  const float* s = src + (size_t)(kt * 64) * srcld + nt * 64;
#pragma unroll
  for (int i = 0; i < 4; ++i) {
    const int row = (t >> 4) + 16 * i, c4 = (t & 15) * 4;
    const f32x4 v = *(const f32x4*)(s + (size_t)row * srcld + c4);
    sm[row * 65 + c4 + 0] = v[0];
    sm[row * 65 + c4 + 1] = v[1];
    sm[row * 65 + c4 + 2] = v[2];
    sm[row * 65 + c4 + 3] = v[3];
  }
  __syncthreads();
  const int n = t >> 2, ks = (t & 3) * 16;
  u32x4 w0, w1;
#pragma unroll
  for (int j = 0; j < 4; ++j) {
    w0[j] = cvt_pk_bf16(sm[(ks + 2 * j) * 65 + n], sm[(ks + 2 * j + 1) * 65 + n]);
    w1[j] = cvt_pk_bf16(sm[(ks + 8 + 2 * j) * 65 + n], sm[(ks + 8 + 2 * j + 1) * 65 + n]);
  }
  bf16_t* d = dst + (size_t)(nt * 64 + n) * dstld + kt * 64 + ks;
  *(u32x4*)d = w0;
  *(u32x4*)(d + 8) = w1;
  __syncthreads();
}

constexpr int PREP_T_IN = 16 * 104, PREP_T_BR = 2 * 8 * 16, PREP_T_OUT = 16 * 16, PREP_T_UP = 16 * 88,
              PREP_T_DN = 44 * 16, PREP_WEFF = 256;
constexpr int PREP_ITEMS = PREP_T_IN + PREP_T_BR + PREP_T_OUT + PREP_T_UP + PREP_T_DN + PREP_WEFF;

DI void prep_item(const Params& p, int l, int it, float* sm) {
  if (it < PREP_T_IN) {
    transpose_tile(p.w_in + (size_t)l * D * INW, INW, p.WIN, D, it / 104, it % 104, sm);
    return;
  }
  it -= PREP_T_IN;
  if (it < PREP_T_BR) {
    const int i = it >> 7, r = it & 127;
    transpose_tile(p.w_branch + (size_t)(l * 3 + i) * 512 * D, D, p.WB + i * 512, 1536, r >> 4, r & 15, sm);
    return;
  }
  it -= PREP_T_BR;
  if (it < PREP_T_OUT) {
    transpose_tile(p.w_out + (size_t)l * D * D, D, p.WO, D, it >> 4, it & 15, sm);
    return;
  }
  it -= PREP_T_OUT;
  if (it < PREP_T_UP) {
    transpose_tile(p.w_up + (size_t)l * D * 2 * DFF, 2 * DFF, p.WU, D, it / 88, it % 88, sm);
    return;
  }
  it -= PREP_T_UP;
  if (it < PREP_T_DN) {
    transpose_tile(p.w_down + (size_t)l * DFF * D, D, p.WD, DFF, it >> 4, it & 15, sm);
    return;
  }
  it -= PREP_T_DN;
  {
    const int g = it >> 6, cb = (it >> 2) & 15, db = it & 3;
    const int dd = db * 256 + tidx();
    const float* wb2 = p.w_branch + (size_t)(l * 3 + 2) * 512 * D + (size_t)(g * 128) * D + dd;
    const float* psc = p.pool_scale + l * 512 + g * 128;
    const float* pw = p.pool_w + ((size_t)(l * 4 + g) * 128 + cb * 8) * 128;
    float acc[8];
#pragma unroll
    for (int c = 0; c < 8; ++c) acc[c] = 0.f;
    for (int e = 0; e < 128; ++e) {
      const float w = wb2[(size_t)e * D] * psc[e];
#pragma unroll
      for (int c = 0; c < 8; ++c) acc[c] += pw[c * 128 + e] * w;
    }
    u32x4 o;
#pragma unroll
    for (int j = 0; j < 4; ++j) o[j] = cvt_pk_bf16(acc[2 * j], acc[2 * j + 1]);
    *(u32x4*)(p.WB + (size_t)dd * 1536 + 1024 + g * 128 + cb * 8) = o;
  }
}

constexpr int MOD_ITEMS = 2 * 96;
DI void mod_item(const Params& p, int it, float* sm) {
  const int t = tidx();
  const int l = it / 96, cb = it % 96;
  float* red = sm + 5 * 1024;
  for (int i = t; i < 5 * 1024; i += NTHREADS) {
    const int v = i >> 10, k = i & 1023;
    const float cv = (v == 0) ? p.c_ctx[k] : p.c[(v - 1) * D + k];
    sm[i] = cv / (1.f + __expf(-cv));
  }
  __syncthreads();
  const int kg = t >> 4, ct = t & 15;
  f32x4 acc[5];
#pragma unroll
  for (int v = 0; v < 5; ++v) acc[v] = (f32x4){0.f, 0.f, 0.f, 0.f};
  const float* w = p.w_mod + ((size_t)l * D + kg * 64) * 6144 + cb * 64 + ct * 4;
#pragma unroll 8
  for (int kk = 0; kk < 64; ++kk) {
    const f32x4 wv = *(const f32x4*)(w + (size_t)kk * 6144);
#pragma unroll
    for (int v = 0; v < 5; ++v) acc[v] += sm[v * 1024 + kg * 64 + kk] * wv;
  }
#pragma unroll
  for (int v = 0; v < 5; ++v)
#pragma unroll
    for (int j = 0; j < 4; ++j) red[(kg * 5 + v) * 64 + ct * 4 + j] = acc[v][j];
  __syncthreads();
  for (int i = t; i < 320; i += NTHREADS) {
    const int v = i >> 6, c = i & 63;
    float s = p.b_mod[l * 6144 + cb * 64 + c];
#pragma unroll
    for (int g = 0; g < 16; ++g) s += red[(g * 5 + v) * 64 + c];
    p.MOD[(size_t)(l * 5 + v) * 6144 + cb * 64 + c] = s;
  }
  __syncthreads();
}

constexpr int CACHE_ITEMS = 64;
DI void cache_item(const Params& p, int it) {
  const int t = tidx();
  const int b = it >> 4, l = (it >> 3) & 1, h = it & 7;
  const float* ks = p.cache_kv + ((size_t)(((b * 2 + l) * 2 + 0) * 8 + h)) * 16384;
  const float* vs = p.cache_kv + ((size_t)(((b * 2 + l) * 2 + 1) * 8 + h)) * 16384;
  bf16_t* kd = p.KC + (size_t)((b * 2 + l) * 8 + h) * 16384;
  bf16_t* vd = p.VCT + (size_t)((b * 2 + l) * 8 + h) * 16384;
#pragma unroll 4
  for (int i = 0; i < 16; ++i) {
    const int e = (i * 256 + t) * 4;
    const f32x4 v = *(const f32x4*)(ks + e);
    u32x2 o;
    o[0] = cvt_pk_bf16(v[0], v[1]);
    o[1] = cvt_pk_bf16(v[2], v[3]);
    *(u32x2*)(kd + e) = o;
  }
#pragma unroll 4
  for (int d = 0; d < 64; d += 4) {
    const f32x4 v = *(const f32x4*)(vs + t * 64 + d);
#pragma unroll
    for (int j = 0; j < 4; ++j) vd[(d + j) * 256 + t] = (bf16_t)(cvt_pk_bf16(v[j], 0.f) & 0xffffu);
  }
}

DI void normmod_row(const Params& p, int l, int which, int row, const float* xr) {
  const int lane = tidx() & 63;
  f32x4 v[4];
  float ss = 0.f;
#pragma unroll
  for (int i = 0; i < 4; ++i) {
    v[i] = *(const f32x4*)(xr + i * 256 + lane * 4);
    ss += v[i][0] * v[i][0] + v[i][1] * v[i][1] + v[i][2] * v[i][2] + v[i][3] * v[i][3];
  }
  ss = wave_sum(ss);
  const float rstd = rsqrtf(ss * (1.f / 1024.f) + 1e-6f);
  const float* g = (which == 0 ? p.g1 : p.g2) + l * D;
  const float* mod = p.MOD + (size_t)(l * 5 + vec_of_row(row)) * 6144 + which * 3072;
#pragma unroll
  for (int i = 0; i < 4; ++i) {
    const int col = i * 256 + lane * 4;
    const f32x4 gg = *(const f32x4*)(g + col);
    const f32x4 sh = *(const f32x4*)(mod + col);
    const f32x4 sc = *(const f32x4*)(mod + 1024 + col);
    f32x4 h;
#pragma unroll
    for (int j = 0; j < 4; ++j) h[j] = v[i][j] * rstd * gg[j] * (1.f + sc[j]) + sh[j];
    u32x2 o;
    o[0] = cvt_pk_bf16(h[0], h[1]);
    o[1] = cvt_pk_bf16(h[2], h[3]);
    *(u32x2*)(p.H + (size_t)row * D + col) = o;
  }
}

DI void gemm_load(const bf16_t* __restrict__ A, int lda, int row0, int k0, u32x4 (&r)[4], int t) {
  const int c = t & 7, rr = t >> 3;
#pragma unroll
  for (int i = 0; i < 4; ++i) r[i] = *(const u32x4*)(A + (size_t)(row0 + rr + 32 * i) * lda + k0 + c * 8);
}
DI void gemm_store(char* s, const u32x4 (&r)[4], int t) {
  const int c = t & 7, rr = t >> 3;
#pragma unroll
  for (int i = 0; i < 4; ++i) *(u32x4*)(s + (rr + 32 * i) * 128 + ((c ^ (rr & 7)) << 4)) = r[i];
}
DI void gemm_compute(const char* sA, const char* sB, f32x4 (&acc)[4][4], int wm, int wn, int lane) {
  const int fr = lane & 15, fq = lane >> 4;
#pragma unroll
  for (int ks = 0; ks < 2; ++ks) {
    bf16x8 a[4], b[4];
    const int sw = ((ks * 4 + fq) ^ (fr & 7)) << 4;
#pragma unroll
    for (int mi = 0; mi < 4; ++mi) a[mi] = *(const bf16x8*)(sA + (wm * 64 + mi * 16 + fr) * 128 + sw);
#pragma unroll
    for (int ni = 0; ni < 4; ++ni) b[ni] = *(const bf16x8*)(sB + (wn * 64 + ni * 16 + fr) * 128 + sw);
#pragma unroll
    for (int mi = 0; mi < 4; ++mi)
#pragma unroll
      for (int ni = 0; ni < 4; ++ni)
        acc[mi][ni] = __builtin_amdgcn_mfma_f32_16x16x32_bf16(b[ni], a[mi], acc[mi][ni], 0, 0, 0);
  }
}

template <bool GATED, class Epi>
DI void gemm_tile(const bf16_t* __restrict__ A, int lda, const bf16_t* __restrict__ Bt, int ldb, int K, int row0,
                  int col0, char* smem, const Epi& epi, const bf16_t* gates) {
  const int tid = tidx();
  const int wid = tid >> 6, lane = tid & 63, wm = wid >> 1, wn = wid & 1;
  const int fr = lane & 15, fq = lane >> 4;
  f32x4 acc[4][4];
  f32x4 tot[4][4];
#pragma unroll
  for (int mi = 0; mi < 4; ++mi)
#pragma unroll
    for (int ni = 0; ni < 4; ++ni) {
      acc[mi][ni] = (f32x4){0.f, 0.f, 0.f, 0.f};
      if (GATED) tot[mi][ni] = (f32x4){0.f, 0.f, 0.f, 0.f};
    }
  u32x4 ra[4], rb[4];
  const int nt = K >> 6;
  gemm_load(A, lda, row0, 0, ra, tid);
  gemm_load(Bt, ldb, col0, 0, rb, tid);
  gemm_store(smem, ra, tid);
  gemm_store(smem + 16384, rb, tid);
  __syncthreads();
  for (int t = 0; t < nt; ++t) {
    char* cur = smem + (t & 1) * 32768;
    char* nxt = smem + ((t + 1) & 1) * 32768;
    if (t + 1 < nt) {
      gemm_load(A, lda, row0, (t + 1) * 64, ra, tid);
      gemm_load(Bt, ldb, col0, (t + 1) * 64, rb, tid);
    }
    gemm_compute(cur, cur + 16384, acc, wm, wn, lane);
    if (t + 1 < nt) {
      gemm_store(nxt, ra, tid);
      gemm_store(nxt + 16384, rb, tid);
    }
    if (GATED && ((t & 7) == 7)) {
      const int seg = t >> 3;
#pragma unroll
      for (int mi = 0; mi < 4; ++mi)
#pragma unroll
        for (int ni = 0; ni < 4; ++ni) {
          const int row = row0 + wm * 64 + mi * 16 + fr, col = col0 + wn * 64 + ni * 16 + fq * 4;
          const u32x2 g = *(const u32x2*)(gates + (size_t)row * INW + seg * 1024 + col);
          tot[mi][ni][0] += bf_lo(g[0]) * acc[mi][ni][0];
          tot[mi][ni][1] += bf_hi(g[0]) * acc[mi][ni][1];
          tot[mi][ni][2] += bf_lo(g[1]) * acc[mi][ni][2];
          tot[mi][ni][3] += bf_hi(g[1]) * acc[mi][ni][3];
          acc[mi][ni] = (f32x4){0.f, 0.f, 0.f, 0.f};
        }
    }
    __syncthreads();
  }
#pragma unroll
  for (int mi = 0; mi < 4; ++mi)
#pragma unroll
    for (int ni = 0; ni < 4; ++ni) {
      const int row = row0 + wm * 64 + mi * 16 + fr, col = col0 + wn * 64 + ni * 16 + fq * 4;
      epi(row, col, GATED ? tot[mi][ni] : acc[mi][ni]);
    }
}

DI void store_bf16x4(bf16_t* d, f32x4 v) {
  u32x2 o;
  o[0] = cvt_pk_bf16(v[0], v[1]);
  o[1] = cvt_pk_bf16(v[2], v[3]);
  *(u32x2*)d = o;
}

struct EpiZ {
  bf16_t* Z; bf16_t* VT; float* kv; int l;
  DI void operator()(int row, int col, f32x4 v) const {
    if (col >= 3584) {
#pragma unroll
      for (int j = 0; j < 4; ++j) v[j] = 1.f / (1.f + __expf(-v[j]));
    }
    store_bf16x4(Z + (size_t)row * INW + col, v);
    if (col >= 2048 && col < 3072) {
      const int which = (col - 2048) >> 9, hd = (col - 2048) & 511;
      if (row < NCTX) {
        const int b = row >> 8, s = row & 255, hh = hd >> 6, d = hd & 63;
        *(f32x4*)(kv + ((size_t)((((b * 2 + l) * 2 + which) * 8 + hh) * 256 + s)) * 64 + d) = v;
      }
      if (which == 1) {
#pragma unroll
        for (int j = 0; j < 4; ++j) VT[(size_t)(hd + j) * NTOK + row] = (bf16_t)(cvt_pk_bf16(v[j], 0.f) & 0xffffu);
      }
    }
  }
};
struct EpiBf16 {
  bf16_t* O; int ld;
  DI void operator()(int row, int col, f32x4 v) const { store_bf16x4(O + (size_t)row * ld + col, v); }
};
struct EpiResid {
  const Params* p; int l; int gate_off; bool from_input;
  DI void operator()(int row, int col, f32x4 v) const {
    const float* xi = from_input ? xin_row(*p, row) + col : p->X + (size_t)row * D + col;
    const f32x4 x = *(const f32x4*)xi;
    const f32x4 g = *(const f32x4*)(p->MOD + (size_t)(l * 5 + vec_of_row(row)) * 6144 + gate_off + col);
    f32x4 o;
#pragma unroll
    for (int j = 0; j < 4; ++j) o[j] = x[j] + g[j] * v[j];
    *(f32x4*)(p->X + (size_t)row * D + col) = o;
  }
};

template <bool LATBIAS>
DI void attn_chunk(const bf16x8 qf0, const bf16x8 qf1, const bf16_t* __restrict__ kbase, int kstride,
                   const bf16_t* __restrict__ vtbase, int vstride, int tk0, int tk1, int tk2, int tk3,
                   const float* __restrict__ rpb_h, int dr0, int band, int qc, float& m, float& lsum,
                   f32x4 (&o)[4], int lane) {
  const int fr = lane & 15, fq = lane >> 4;
  f32x4 s[4];
#pragma unroll
  for (int T = 0; T < 4; ++T) {
    const int tk = (T == 0 ? tk0 : T == 1 ? tk1 : T == 2 ? tk2 : tk3);
    const bf16_t* kp = kbase + (size_t)(tk + fr) * kstride + fq * 8;
    const bf16x8 k0 = *(const bf16x8*)kp;
    const bf16x8 k1 = *(const bf16x8*)(kp + 32);
    f32x4 z = (f32x4){0.f, 0.f, 0.f, 0.f};
    z = __builtin_amdgcn_mfma_f32_16x16x32_bf16(k0, qf0, z, 0, 0, 0);
    z = __builtin_amdgcn_mfma_f32_16x16x32_bf16(k1, qf1, z, 0, 0, 0);
    s[T] = z;
  }
  float cmax = -INFINITY;
#pragma unroll
  for (int T = 0; T < 4; ++T) {
#pragma unroll
    for (int j = 0; j < 4; ++j) {
      float v = s[T][j] * 0.125f;
      if (LATBIAS) {
        const int kc = band + (T & 1) * 16 + fq * 4 + j;
        const int cs = min(max(qc - 8, 0), 48);
        const bool valid = (kc >= cs) && (kc < cs + 16);
        const int dr = dr0 + (T >> 1);
        const int dc = min(max(kc - qc + 15, 0), 30);
        v = valid ? v + rpb_h[dr * 31 + dc] : -INFINITY;
      }
      s[T][j] = v;
      cmax = fmaxf(cmax, v);
    }
  }
  cmax = fmaxf(cmax, __shfl_xor(cmax, 16));
  cmax = fmaxf(cmax, __shfl_xor(cmax, 32));
  const float mnew = fmaxf(m, cmax);
  const float alpha = __expf(m - mnew);
  m = mnew;
  float ps = 0.f;
#pragma unroll
  for (int T = 0; T < 4; ++T)
#pragma unroll
    for (int j = 0; j < 4; ++j) {
      const float pv = __expf(s[T][j] - mnew);
      s[T][j] = pv;
      ps += pv;
    }
  lsum = lsum * alpha + ps;
#pragma unroll
  for (int dt = 0; dt < 4; ++dt) o[dt] *= alpha;
#pragma unroll
  for (int pr = 0; pr < 2; ++pr) {
    u32x4 pk;
    pk[0] = cvt_pk_bf16(s[2 * pr][0], s[2 * pr][1]);
    pk[1] = cvt_pk_bf16(s[2 * pr][2], s[2 * pr][3]);
    pk[2] = cvt_pk_bf16(s[2 * pr + 1][0], s[2 * pr + 1][1]);
    pk[3] = cvt_pk_bf16(s[2 * pr + 1][2], s[2 * pr + 1][3]);
    const bf16x8 pa = __builtin_bit_cast(bf16x8, pk);
    const int ta = (pr == 0 ? tk0 : tk2), tb = (pr == 0 ? tk1 : tk3);
#pragma unroll
    for (int dt = 0; dt < 4; ++dt) {
      const bf16_t* vp = vtbase + (size_t)(dt * 16 + fr) * vstride + fq * 4;
      const u32x2 lo = *(const u32x2*)(vp + ta);
      const u32x2 hi = *(const u32x2*)(vp + tb);
      u32x4 vv;
      vv[0] = lo[0]; vv[1] = lo[1]; vv[2] = hi[0]; vv[3] = hi[1];
      o[dt] = __builtin_amdgcn_mfma_f32_16x16x32_bf16(__builtin_bit_cast(bf16x8, vv), pa, o[dt], 0, 0, 0);
    }
  }
}

DI void attn_finish(bf16_t* ys_row, float lsum, const f32x4 (&o)[4], int lane) {
  const int fq = lane >> 4;
  lsum += __shfl_xor(lsum, 16);
  lsum += __shfl_xor(lsum, 32);
  const float inv = 1.f / lsum;
#pragma unroll
  for (int dt = 0; dt < 4; ++dt) store_bf16x4(ys_row + dt * 16 + fq * 4, o[dt] * inv);
}

DI void attn_ctx_unit(const Params& p, int u, int lane) {
  const int b = u >> 7, h = (u >> 4) & 7, qt = u & 15;
  const int fr = lane & 15, fq = lane >> 4;
  const int qtok = b * 256 + qt * 16 + fr;
  const bf16_t* qp = p.Z + (size_t)qtok * INW + 1536 + h * 64 + fq * 8;
  const bf16x8 qf0 = *(const bf16x8*)qp, qf1 = *(const bf16x8*)(qp + 32);
  const bf16_t* kbase = p.Z + 2048 + h * 64;
  const bf16_t* vtbase = p.VT + (size_t)h * 64 * NTOK;
  float m = -INFINITY, lsum = 0.f;
  f32x4 o[4];
#pragma unroll
  for (int dt = 0; dt < 4; ++dt) o[dt] = (f32x4){0.f, 0.f, 0.f, 0.f};
  for (int ch = 0; ch < 4; ++ch) {
    const int t0 = b * 256 + ch * 64;
    attn_chunk<false>(qf0, qf1, kbase, INW, vtbase, NTOK, t0, t0 + 16, t0 + 32, t0 + 48, nullptr, 0, 0, 0, m, lsum, o,
                      lane);
  }
  attn_finish(p.YS + (size_t)qtok * 1536 + 512 + h * 64, lsum, o, lane);
}

DI void attn_lat_unit(const Params& p, int l, int u, int lane) {
  const int b = u >> 9, h = (u >> 6) & 7, r = (u >> 2) & 15, j = u & 3;
  const int fr = lane & 15, fq = lane >> 4;
  const int qc = j * 16 + fr;
  const int qtok = NCTX + b * 1024 + r * 64 + qc;
  const bf16_t* qp = p.Z + (size_t)qtok * INW + 1536 + h * 64 + fq * 8;
  const bf16x8 qf0 = *(const bf16x8*)qp, qf1 = *(const bf16x8*)(qp + 32);
  float m = -INFINITY, lsum = 0.f;
  f32x4 o[4];
#pragma unroll
  for (int dt = 0; dt < 4; ++dt) o[dt] = (f32x4){0.f, 0.f, 0.f, 0.f};
  {
    const bf16_t* kbase = p.Z + 2048 + h * 64;
    const bf16_t* vtbase = p.VT + (size_t)h * 64 * NTOK;
    const float* rpb_h = p.rpb + (size_t)(l * 8 + h) * 15 * 31;
    const int rs = min(max(r - 4, 0), 8);
    const int band = min(max(j * 16 - 8, 0), 32);
    for (int ch = 0; ch < 4; ++ch) {
      const int kr = rs + 2 * ch;
      const int t0 = NCTX + b * 1024 + kr * 64 + band;
      attn_chunk<true>(qf0, qf1, kbase, INW, vtbase, NTOK, t0, t0 + 16, t0 + 64, t0 + 80, rpb_h, kr - r + 7, band, qc,
                       m, lsum, o, lane);
    }
  }
  {
    const bf16_t* kbase = p.KC + (size_t)((b * 2 + l) * 8 + h) * 16384;
    const bf16_t* vtbase = p.VCT + (size_t)((b * 2 + l) * 8 + h) * 16384;
    for (int ch = 0; ch < 4; ++ch) {
      const int t0 = ch * 64;
      attn_chunk<false>(qf0, qf1, kbase, 64, vtbase, 256, t0, t0 + 16, t0 + 32, t0 + 48, nullptr, 0, 0, 0, m, lsum, o,
                        lane);
    }
  }
  attn_finish(p.YS + (size_t)qtok * 1536 + 512 + h * 64, lsum, o, lane);
}

DI void unpack8(u32x4 u, float (&f)[8]) {
#pragma unroll
  for (int j = 0; j < 4; ++j) {
    f[2 * j] = bf_lo(u[j]);
    f[2 * j + 1] = bf_hi(u[j]);
  }
}
DI u32x4 pack8(const float (&f)[8]) {
  u32x4 o;
#pragma unroll
  for (int j = 0; j < 4; ++j) o[j] = cvt_pk_bf16(f[2 * j], f[2 * j + 1]);
  return o;
}

DI void conv_item(const Params& p, int l, int it) {
  const int t = tidx();
  const int row = it * 4 + (t >> 6), ch = (t & 63) * 8;
  const bf16_t* z = p.Z + (size_t)row * INW;
  float bg[8], a[8], b[8], acc[8];
  unpack8(*(const u32x4*)(z + ch), bg);
  const float* cw = p.conv_w + (size_t)l * 3 * 512 + ch;
  unpack8(*(const u32x4*)(z + 512 + ch), a);
  unpack8(*(const u32x4*)(z + 1024 + ch), b);
#pragma unroll
  for (int j = 0; j < 8; ++j) acc[j] = a[j] * b[j] * cw[512 + j];
  if (!seq_first(row)) {
    unpack8(*(const u32x4*)(z - INW + 512 + ch), a);
    unpack8(*(const u32x4*)(z - INW + 1024 + ch), b);
#pragma unroll
    for (int j = 0; j < 8; ++j) acc[j] += a[j] * b[j] * cw[j];
  }
  if (!seq_last(row)) {
    unpack8(*(const u32x4*)(z + INW + 512 + ch), a);
    unpack8(*(const u32x4*)(z + INW + 1024 + ch), b);
#pragma unroll
    for (int j = 0; j < 8; ++j) acc[j] += a[j] * b[j] * cw[1024 + j];
  }
#pragma unroll
  for (int j = 0; j < 8; ++j) acc[j] *= bg[j];
  *(u32x4*)(p.YS + (size_t)row * 1536 + ch) = pack8(acc);
}

DI void pool_item(const Params& p, int it) {
  const int t = tidx();
  const int row = it * 4 + (t >> 6), ch = (t & 63) * 8;
  const int g = ch >> 7, w = 2 << g;
  int seq0, seqn;
  if (row < NCTX) { seq0 = row & ~255; seqn = 256; } else { seq0 = row & ~1023; seqn = 1024; }
  const int tt = row - seq0;
  const int lo = max(tt - w / 2, 0), hi = min(tt - w / 2 + w, seqn);
  float acc[8], f[8];
#pragma unroll
  for (int j = 0; j < 8; ++j) acc[j] = 0.f;
  for (int q = lo; q < hi; ++q) {
    unpack8(*(const u32x4*)(p.Z + (size_t)(seq0 + q) * INW + 3072 + ch), f);
#pragma unroll
    for (int j = 0; j < 8; ++j) acc[j] += f[j];
  }
  unpack8(*(const u32x4*)(p.Z + (size_t)row * INW + 3072 + ch), f);
  const float inv = 1.f / (float)(hi - lo);
#pragma unroll
  for (int j = 0; j < 8; ++j) acc[j] = acc[j] * inv - f[j];
  *(u32x4*)(p.YS + (size_t)row * 1536 + 1024 + ch) = pack8(acc);
}

DI float gelu_tanh(float x) {
  const float y = 0.7978845608028654f * (x + 0.044715f * x * x * x);
  const float e = __expf(2.f * y);
  const float th = 1.f - 2.f / (e + 1.f);
  return 0.5f * x * (1.f + th);
}
DI void act_item(const Params& p, int l, int it) {
  const int id = it * 256 + tidx();
  const int row = id / 352, ch = (id % 352) * 8;
  const bf16_t* u = p.U + (size_t)row * (2 * DFF);
  const float* cw = p.f_conv + (size_t)l * 3 * DFF + ch;
  float a[8], acc[8], val[8];
  unpack8(*(const u32x4*)(u + ch), a);
#pragma unroll
  for (int j = 0; j < 8; ++j) acc[j] = a[j] * cw[DFF + j];
  if (!seq_first(row)) {
    unpack8(*(const u32x4*)(u - 2 * DFF + ch), a);
#pragma unroll
    for (int j = 0; j < 8; ++j) acc[j] += a[j] * cw[j];
  }
  if (!seq_last(row)) {
    unpack8(*(const u32x4*)(u + 2 * DFF + ch), a);
#pragma unroll
    for (int j = 0; j < 8; ++j) acc[j] += a[j] * cw[2 * DFF + j];
  }
  unpack8(*(const u32x4*)(u + DFF + ch), val);
#pragma unroll
  for (int j = 0; j < 8; ++j) acc[j] = gelu_tanh(acc[j]) * val[j];
  *(u32x4*)(p.ACT + (size_t)row * DFF + ch) = pack8(acc);
}

DI void final_row(const Params& p, int row) {
  const int lane = tidx() & 63;
  const float* xr = p.X + (size_t)row * D;
  f32x4 v[4];
  float ss = 0.f;
#pragma unroll
  for (int i = 0; i < 4; ++i) {
    v[i] = *(const f32x4*)(xr + i * 256 + lane * 4);
    ss += v[i][0] * v[i][0] + v[i][1] * v[i][1] + v[i][2] * v[i][2] + v[i][3] * v[i][3];
  }
  ss = wave_sum(ss);
  const float rstd = rsqrtf(ss * (1.f / 1024.f) + 1e-6f);
#pragma unroll
  for (int i = 0; i < 4; ++i) {
    const int col = i * 256 + lane * 4;
    const f32x4 gg = *(const f32x4*)(p.g_final + col);
    f32x4 o;
#pragma unroll
    for (int j = 0; j < 4; ++j) o[j] = v[i][j] * rstd * gg[j];
    *(f32x4*)(p.out + (size_t)row * D + col) = o;
  }
}

constexpr int N_PHASES = 20;
__shared__ __attribute__((aligned(16))) char g_smem[65536];
#define NI __device__ __forceinline__
constexpr size_t KV_OFF = (size_t)NTOK * D;

NI void ph_prep0(const Params& p) {
  char* smem = g_smem;
  const int nb = gridDim.x, bid = bidx();
  const int total = PREP_ITEMS + MOD_ITEMS + CACHE_ITEMS;
  for (int it = bid; it < total; it += nb) {
    if (it < MOD_ITEMS) mod_item(p, it, (float*)smem);
    else if (it < MOD_ITEMS + CACHE_ITEMS) cache_item(p, it - MOD_ITEMS);
    else prep_item(p, 0, it - MOD_ITEMS - CACHE_ITEMS, (float*)smem);
  }
}
NI void ph_final(const Params& p) {
  const int nb = gridDim.x, bid = bidx(), wid = tidx() >> 6;
  for (int row = bid * 4 + wid; row < NTOK; row += nb * 4) final_row(p, row);
}
NI void ph_normmod1(const Params& p, int l) {
  char* smem = g_smem;
  const int nb = gridDim.x, bid = bidx(), wid = tidx() >> 6;
  for (int row = bid * 4 + wid; row < NTOK; row += nb * 4)
    normmod_row(p, l, 0, row, l == 0 ? xin_row(p, row) : p.X + (size_t)row * D);
  if (l == 1)
    for (int it = bid; it < PREP_ITEMS; it += nb) prep_item(p, 1, it, (float*)smem);
}
NI void ph_inproj(const Params& p, int l) {
  char* smem = g_smem;
  const int nb = gridDim.x, bid = bidx();
  EpiZ epi{p.Z, p.VT, p.out + KV_OFF, l};
  for (int t = bid; t < 64 * 52; t += nb)
    gemm_tile<false>(p.H, D, p.WIN, D, D, (t & 63) * 128, (t >> 6) * 128, smem, epi, nullptr);
}
NI void ph_attn(const Params& p, int l) {
  const int nb = gridDim.x, bid = bidx(), wid = tidx() >> 6, lane = tidx() & 63;
  for (int it = bid; it < 1024; it += nb) {
    if (it < 512) attn_lat_unit(p, l, it * 4 + wid, lane);
    else attn_ctx_unit(p, (it - 512) * 4 + wid, lane);
  }
}
NI void ph_convpool(const Params& p, int l) {
  const int nb = gridDim.x, bid = bidx();
  for (int it = bid; it < 4096; it += nb) {
    if (it < 2048) conv_item(p, l, it);
    else pool_item(p, it - 2048);
  }
}
NI void ph_branch(const Params& p) {
  char* smem = g_smem;
  const int nb = gridDim.x, bid = bidx();
  EpiBf16 epi{p.MERGED, D};
  for (int t = bid; t < 64 * 8; t += nb)
    gemm_tile<true>(p.YS, 1536, p.WB, 1536, 1536, (t & 63) * 128, (t >> 6) * 128, smem, epi, p.Z + 3584);
}
NI void ph_outproj(const Params& p, int l) {
  char* smem = g_smem;
  const int nb = gridDim.x, bid = bidx();
  EpiResid epi{&p, l, 2048, l == 0};
  for (int t = bid; t < 64 * 8; t += nb)
    gemm_tile<false>(p.MERGED, D, p.WO, D, D, (t & 63) * 128, (t >> 6) * 128, smem, epi, nullptr);
}
NI void ph_normmod2(const Params& p, int l) {
  const int nb = gridDim.x, bid = bidx(), wid = tidx() >> 6;
  for (int row = bid * 4 + wid; row < NTOK; row += nb * 4) normmod_row(p, l, 1, row, p.X + (size_t)row * D);
}
NI void ph_up(const Params& p) {
  char* smem = g_smem;
  const int nb = gridDim.x, bid = bidx();
  EpiBf16 epi{p.U, 2 * DFF};
  for (int t = bid; t < 64 * 44; t += nb)
    gemm_tile<false>(p.H, D, p.WU, D, D, (t & 63) * 128, (t >> 6) * 128, smem, epi, nullptr);
}
NI void ph_act(const Params& p, int l) {
  const int nb = gridDim.x, bid = bidx();
  for (int it = bid; it < NTOK * 352 / 256; it += nb) act_item(p, l, it);
}
NI void ph_down(const Params& p, int l) {
  char* smem = g_smem;
  const int nb = gridDim.x, bid = bidx();
  EpiResid epi{&p, l, 5120, false};
  for (int t = bid; t < 64 * 8; t += nb)
    gemm_tile<false>(p.ACT, DFF, p.WD, DFF, DFF, (t & 63) * 128, (t >> 6) * 128, smem, epi, nullptr);
}

DI void run_phase(const Params& p, int ph) {
  if (ph == 0) { ph_prep0(p); return; }
  if (ph == 19) { ph_final(p); return; }
  const int l = (ph - 1) / 9, s = (ph - 1) % 9;
  switch (s) {
    case 0: ph_normmod1(p, l); break;
    case 1: ph_inproj(p, l); break;
    case 2: ph_attn(p, l); ph_convpool(p, l); break;
    case 3: ph_branch(p); break;
    case 4: ph_outproj(p, l); break;
    case 5: ph_normmod2(p, l); break;
    case 6: ph_up(p); break;
    case 7: ph_act(p, l); break;
    case 8: ph_down(p, l); break;
  }
}

__global__ void __launch_bounds__(NTHREADS, 2) mega_kernel(Params p, int ph_lo, int ph_hi) {
  cg::grid_group grid = cg::this_grid();
  for (int ph = ph_lo; ph < ph_hi; ++ph) {
    run_phase(p, ph);
    if (ph + 1 < ph_hi) grid.sync();
  }
}

extern "C" void kernel_launch(void* const* d_in, const int* in_sizes, int n_in, void* d_out, int out_size, void* d_ws,
                              size_t ws_size, hipStream_t stream) {
  static int grid_blocks = 0;
  if (!grid_blocks) {
    int dev = 0, cus = 0, per_cu = 0;
    hipGetDevice(&dev);
    hipDeviceGetAttribute(&cus, hipDeviceAttributeMultiprocessorCount, dev);
    hipOccupancyMaxActiveBlocksPerMultiprocessor(&per_cu, mega_kernel, NTHREADS, 0);
    if (per_cu > 2) per_cu = 2;
    grid_blocks = cus * per_cu;
  }
  Params p{};
  const float** f = (const float**)&p;
  for (int i = 0; i < 20; ++i) f[i] = (const float*)d_in[i];
  p.out = (float*)d_out;
  char* ws = (char*)d_ws;
  size_t off = 0;
  auto take = [&](size_t bytes) { char* r = ws + off; off += (bytes + 255) & ~(size_t)255; return r; };
  p.MOD = (float*)take(2 * 5 * 6144 * 4);
  p.X = (float*)take((size_t)NTOK * D * 4);
  p.KC = (bf16_t*)take((size_t)64 * 16384 * 2);
  p.VCT = (bf16_t*)take((size_t)64 * 16384 * 2);
  p.WIN = (bf16_t*)take((size_t)INW * D * 2);
  p.WB = (bf16_t*)take((size_t)D * 1536 * 2);
  p.WO = (bf16_t*)take((size_t)D * D * 2);
  p.WU = (bf16_t*)take((size_t)2 * DFF * D * 2);
  p.WD = (bf16_t*)take((size_t)D * DFF * 2);
  p.H = (bf16_t*)take((size_t)NTOK * D * 2);
  p.Z = (bf16_t*)take((size_t)NTOK * INW * 2);
  p.U = p.Z;
  char* r2 = take((size_t)NTOK * 1536 * 2 + (size_t)NTOK * D * 2 + (size_t)512 * NTOK * 2);
  p.YS = (bf16_t*)r2;
  p.MERGED = (bf16_t*)(r2 + (size_t)NTOK * 1536 * 2);
  p.VT = (bf16_t*)(r2 + (size_t)NTOK * 1536 * 2 + (size_t)NTOK * D * 2);
  p.ACT = (bf16_t*)r2;
#ifndef MULTI_LAUNCH
#define MULTI_LAUNCH 0
#endif
#if MULTI_LAUNCH
  for (int ph = 0; ph < N_PHASES; ++ph) mega_kernel<<<dim3(grid_blocks), dim3(NTHREADS), 0, stream>>>(p, ph, ph + 1);
#else
  int lo = 0, hi = N_PHASES;
  void* args[] = {&p, &lo, &hi};
  hipError_t e = hipLaunchCooperativeKernel((void*)mega_kernel, dim3(grid_blocks), dim3(NTHREADS), args, 0, stream);
  if (e != hipSuccess) fprintf(stderr, "cooperative launch failed: %s (grid %d)\n", hipGetErrorString(e), grid_blocks);
#endif
}
```

```cpp
#include <hip/hip_runtime.h>
#include <hip/hip_cooperative_groups.h>
#include <cstdio>
namespace cg = cooperative_groups;

typedef unsigned short bf16_t;
typedef short bf16x8 __attribute__((ext_vector_type(8)));
typedef float f32x4 __attribute__((ext_vector_type(4)));
typedef unsigned u32x4 __attribute__((ext_vector_type(4)));
typedef unsigned u32x2 __attribute__((ext_vector_type(2)));

#define DI __device__ __forceinline__
DI int tidx() { int t = threadIdx.x; asm volatile("" : "+v"(t)); return t; }
DI int bidx() { int b = blockIdx.x; asm volatile("" : "+s"(b)); return b; }

constexpr int D = 1024, NTOK = 8192, NCTX = 4096, INW = 6656, DFF = 2816;
constexpr int NTHREADS = 256;

struct Params {
  const float *x_prompt, *x_sample, *cache_kv, *c, *c_ctx, *w_mod, *b_mod, *g1, *g2, *w_in, *conv_w, *rpb, *pool_w,
      *pool_scale, *w_branch, *w_out, *w_up, *f_conv, *w_down, *g_final;
  float* out;
  float* MOD;
  float* X;
  unsigned* BAR;
  bf16_t *KC, *VCT, *WIN, *WB, *WO, *WU, *WD, *H, *Z, *U, *YS, *MERGED, *VT, *ACT;
};

typedef float f32x2 __attribute__((ext_vector_type(2)));
typedef __bf16 bf16x2_t __attribute__((ext_vector_type(2)));
DI unsigned cvt_pk_bf16(float lo, float hi) {
  const f32x2 v = {lo, hi};
  return __builtin_bit_cast(unsigned, __builtin_convertvector(v, bf16x2_t));
}
DI float bf_lo(unsigned u) { return __uint_as_float(u << 16); }
DI float bf_hi(unsigned u) { return __uint_as_float(u & 0xffff0000u); }
DI float wave_sum(float v) {
#pragma unroll
  for (int o = 32; o > 0; o >>= 1) v += __shfl_xor(v, o);
  return v;
}
DI const float* xin_row(const Params& p, int row) {
  return row < NCTX ? p.x_prompt + (size_t)row * D : p.x_sample + (size_t)(row - NCTX) * D;
}
DI int vec_of_row(int row) { return row < NCTX ? 0 : 1 + ((row - NCTX) >> 10); }
DI bool seq_first(int row) { return row < NCTX ? ((row & 255) == 0) : ((row & 1023) == 0); }
DI bool seq_last(int row) { return row < NCTX ? ((row & 255) == 255) : ((row & 1023) == 1023); }

DI void transpose_tile(const float* __restrict__ src, int srcld, bf16_t* __restrict__ dst, int dstld, int kt, int nt,
                       float* sm) {
  const int t = tidx();
  const float* s = src + (size_t)(kt * 64) * srcld + nt * 64;
#pragma unroll
  for (int i = 0; i < 4; ++i) {
    const int row = (t >> 4) + 16 * i, c4 = (t & 15) * 4;
    const f32x4 v = *(const f32x4*)(s + (size_t)row * srcld + c4);
    sm[row * 65 + c4 + 0] = v[0];
    sm[row * 65 + c4 + 1] = v[1];
    sm[row * 65 + c4 + 2] = v[2];
    sm[row * 65 + c4 + 3] = v[3];
  }
  __syncthreads();
  const int n = t >> 2, ks = (t & 3) * 16;
  u32x4 w0, w1;
#pragma unroll
  for (int j = 0; j < 4; ++j) {
    w0[j] = cvt_pk_bf16(sm[(ks + 2 * j) * 65 + n], sm[(ks + 2 * j + 1) * 65 + n]);
    w1[j] = cvt_pk_bf16(sm[(ks + 8 + 2 * j) * 65 + n], sm[(ks + 8 + 2 * j + 1) * 65 + n]);
  }
  bf16_t* d = dst + (size_t)(nt * 64 + n) * dstld + kt * 64 + ks;
  *(u32x4*)d = w0;
  *(u32x4*)(d + 8) = w1;
  __syncthreads();
}

constexpr int PREP_T_IN = 16 * 104, PREP_T_BR = 2 * 8 * 16, PREP_T_OUT = 16 * 16, PREP_T_UP = 16 * 88,
              PREP_T_DN = 44 * 16, PREP_WEFF = 256;
constexpr int PREP_ITEMS = PREP_T_IN + PREP_T_BR + PREP_T_OUT + PREP_T_UP + PREP_T_DN + PREP_WEFF;

DI void prep_item(const Params& p, int l, int it, float* sm) {
  if (it < PREP_T_IN) {
    transpose_tile(p.w_in + (size_t)l * D * INW, INW, p.WIN, D, it / 104, it % 104, sm);
    return;
  }
  it -= PREP_T_IN;
  if (it < PREP_T_BR) {
    const int i = it >> 7, r = it & 127;
    transpose_tile(p.w_branch + (size_t)(l * 3 + i) * 512 * D, D, p.WB + i * 512, 1536, r >> 4, r & 15, sm);
    return;
  }
  it -= PREP_T_BR;
  if (it < PREP_T_OUT) {
    transpose_tile(p.w_out + (size_t)l * D * D, D, p.WO, D, it >> 4, it & 15, sm);
    return;
  }
  it -= PREP_T_OUT;
  if (it < PREP_T_UP) {
    transpose_tile(p.w_up + (size_t)l * D * 2 * DFF, 2 * DFF, p.WU, D, it / 88, it % 88, sm);
    return;
  }
  it -= PREP_T_UP;
  if (it < PREP_T_DN) {
    transpose_tile(p.w_down + (size_t)l * DFF * D, D, p.WD, DFF, it >> 4, it & 15, sm);
    return;
  }
  it -= PREP_T_DN;
  {
    const int g = it >> 6, cb = (it >> 2) & 15, db = it & 3;
    const int dd = db * 256 + tidx();
    const float* wb2 = p.w_branch + (size_t)(l * 3 + 2) * 512 * D + (size_t)(g * 128) * D + dd;
    const float* psc = p.pool_scale + l * 512 + g * 128;
    const float* pw = p.pool_w + ((size_t)(l * 4 + g) * 128 + cb * 8) * 128;
    float acc[8];
#pragma unroll
    for (int c = 0; c < 8; ++c) acc[c] = 0.f;
    for (int e = 0; e < 128; ++e) {
      const float w = wb2[(size_t)e * D] * psc[e];
#pragma unroll
      for (int c = 0; c < 8; ++c) acc[c] += pw[c * 128 + e] * w;
    }
    u32x4 o;
#pragma unroll
    for (int j = 0; j < 4; ++j) o[j] = cvt_pk_bf16(acc[2 * j], acc[2 * j + 1]);
    *(u32x4*)(p.WB + (size_t)dd * 1536 + 1024 + g * 128 + cb * 8) = o;
  }
}

constexpr int MOD_ITEMS = 2 * 96;
DI void mod_item(const Params& p, int it, float* sm) {
  const int t = tidx();
  const int l = it / 96, cb = it % 96;
  float* red = sm + 5 * 1024;
  for (int i = t; i < 5 * 1024; i += NTHREADS) {
    const int v = i >> 10, k = i & 1023;
    const float cv = (v == 0) ? p.c_ctx[k] : p.c[(v - 1) * D + k];
    sm[i] = cv / (1.f + __expf(-cv));
  }
  __syncthreads();
  const int kg = t >> 4, ct = t & 15;
  f32x4 acc[5];
#pragma unroll
  for (int v = 0; v < 5; ++v) acc[v] = (f32x4){0.f, 0.f, 0.f, 0.f};
  const float* w = p.w_mod + ((size_t)l * D + kg * 64) * 6144 + cb * 64 + ct * 4;
#pragma unroll 8
  for (int kk = 0; kk < 64; ++kk) {
    const f32x4 wv = *(const f32x4*)(w + (size_t)kk * 6144);
#pragma unroll
    for (int v = 0; v < 5; ++v) acc[v] += sm[v * 1024 + kg * 64 + kk] * wv;
  }
#pragma unroll
  for (int v = 0; v < 5; ++v)
#pragma unroll
    for (int j = 0; j < 4; ++j) red[(kg * 5 + v) * 64 + ct * 4 + j] = acc[v][j];
  __syncthreads();
  for (int i = t; i < 320; i += NTHREADS) {
    const int v = i >> 6, c = i & 63;
    float s = p.b_mod[l * 6144 + cb * 64 + c];
#pragma unroll
    for (int g = 0; g < 16; ++g) s += red[(g * 5 + v) * 64 + c];
    p.MOD[(size_t)(l * 5 + v) * 6144 + cb * 64 + c] = s;
  }
  __syncthreads();
}

constexpr int CACHE_ITEMS = 64;
DI void cache_item(const Params& p, int it) {
  const int t = tidx();
  const int b = it >> 4, l = (it >> 3) & 1, h = it & 7;
  const float* ks = p.cache_kv + ((size_t)(((b * 2 + l) * 2 + 0) * 8 + h)) * 16384;
  const float* vs = p.cache_kv + ((size_t)(((b * 2 + l) * 2 + 1) * 8 + h)) * 16384;
  bf16_t* kd = p.KC + (size_t)((b * 2 + l) * 8 + h) * 16384;
  bf16_t* vd = p.VCT + (size_t)((b * 2 + l) * 8 + h) * 16384;
#pragma unroll 4
  for (int i = 0; i < 16; ++i) {
    const int e = (i * 256 + t) * 4;
    const f32x4 v = *(const f32x4*)(ks + e);
    u32x2 o;
    o[0] = cvt_pk_bf16(v[0], v[1]);
    o[1] = cvt_pk_bf16(v[2], v[3]);
    *(u32x2*)(kd + e) = o;
  }
#pragma unroll 4
  for (int d = 0; d < 64; d += 4) {
    const f32x4 v = *(const f32x4*)(vs + t * 64 + d);
#pragma unroll
    for (int j = 0; j < 4; ++j) vd[(d + j) * 256 + t] = (bf16_t)(cvt_pk_bf16(v[j], 0.f) & 0xffffu);
  }
}

DI void normmod_row(const Params& p, int l, int which, int row, const float* xr) {
  const int lane = tidx() & 63;
  f32x4 v[4];
  float ss = 0.f;
#pragma unroll
  for (int i = 0; i < 4; ++i) {
    v[i] = *(const f32x4*)(xr + i * 256 + lane * 4);
    ss += v[i][0] * v[i][0] + v[i][1] * v[i][1] + v[i][2] * v[i][2] + v[i][3] * v[i][3];
  }
  ss = wave_sum(ss);
  const float rstd = rsqrtf(ss * (1.f / 1024.f) + 1e-6f);
  const float* g = (which == 0 ? p.g1 : p.g2) + l * D;
  const float* mod = p.MOD + (size_t)(l * 5 + vec_of_row(row)) * 6144 + which * 3072;
#pragma unroll
  for (int i = 0; i < 4; ++i) {
    const int col = i * 256 + lane * 4;
    const f32x4 gg = *(const f32x4*)(g + col);
    const f32x4 sh = *(const f32x4*)(mod + col);
    const f32x4 sc = *(const f32x4*)(mod + 1024 + col);
    f32x4 h;
#pragma unroll
    for (int j = 0; j < 4; ++j) h[j] = v[i][j] * rstd * gg[j] * (1.f + sc[j]) + sh[j];
    u32x2 o;
    o[0] = cvt_pk_bf16(h[0], h[1]);
    o[1] = cvt_pk_bf16(h[2], h[3]);
    *(u32x2*)(p.H + (size_t)row * D + col) = o;
  }
}

DI void gemm_load(const bf16_t* __restrict__ A, int lda, int row0, int k0, u32x4 (&r)[4], int t) {
  const int c = t & 7, rr = t >> 3;
#pragma unroll
  for (int i = 0; i < 4; ++i) r[i] = *(const u32x4*)(A + (size_t)(row0 + rr + 32 * i) * lda + k0 + c * 8);
}
DI void gemm_store(char* s, const u32x4 (&r)[4], int t) {
  const int c = t & 7, rr = t >> 3;
#pragma unroll
  for (int i = 0; i < 4; ++i) *(u32x4*)(s + (rr + 32 * i) * 128 + ((c ^ (rr & 7)) << 4)) = r[i];
}
DI void gemm_compute(const char* sA, const char* sB, f32x4 (&acc)[4][4], int wm, int wn, int lane) {
  const int fr = lane & 15, fq = lane >> 4;
#pragma unroll
  for (int ks = 0; ks < 2; ++ks) {
    bf16x8 a[4], b[4];
    const int sw = ((ks * 4 + fq) ^ (fr & 7)) << 4;
#pragma unroll
    for (int mi = 0; mi < 4; ++mi) a[mi] = *(const bf16x8*)(sA + (wm * 64 + mi * 16 + fr) * 128 + sw);
#pragma unroll
    for (int ni = 0; ni < 4; ++ni) b[ni] = *(const bf16x8*)(sB + (wn * 64 + ni * 16 + fr) * 128 + sw);
#pragma unroll
    for (int mi = 0; mi < 4; ++mi)
#pragma unroll
      for (int ni = 0; ni < 4; ++ni)
        acc[mi][ni] = __builtin_amdgcn_mfma_f32_16x16x32_bf16(b[ni], a[mi], acc[mi][ni], 0, 0, 0);
  }
}

template <bool GATED, class Epi>
DI void gemm_tile(const bf16_t* __restrict__ A, int lda, const bf16_t* __restrict__ Bt, int ldb, int K, int row0,
                  int col0, char* smem, const Epi& epi, const bf16_t* gates) {
  const int tid = tidx();
  const int wid = tid >> 6, lane = tid & 63, wm = wid >> 1, wn = wid & 1;
  const int fr = lane & 15, fq = lane >> 4;
  f32x4 acc[4][4];
  f32x4 tot[4][4];
#pragma unroll
  for (int mi = 0; mi < 4; ++mi)
#pragma unroll
    for (int ni = 0; ni < 4; ++ni) {
      acc[mi][ni] = (f32x4){0.f, 0.f, 0.f, 0.f};
      if (GATED) tot[mi][ni] = (f32x4){0.f, 0.f, 0.f, 0.f};
    }
  u32x4 ra[4], rb[4];
  const int nt = K >> 6;
  gemm_load(A, lda, row0, 0, ra, tid);
  gemm_load(Bt, ldb, col0, 0, rb, tid);
  gemm_store(smem, ra, tid);
  gemm_store(smem + 16384, rb, tid);
  __syncthreads();
  for (int t = 0; t < nt; ++t) {
    char* cur = smem + (t & 1) * 32768;
    char* nxt = smem + ((t + 1) & 1) * 32768;
    if (t + 1 < nt) {
      gemm_load(A, lda, row0, (t + 1) * 64, ra, tid);
      gemm_load(Bt, ldb, col0, (t + 1) * 64, rb, tid);
    }
    gemm_compute(cur, cur + 16384, acc, wm, wn, lane);
    if (t + 1 < nt) {
      gemm_store(nxt, ra, tid);
      gemm_store(nxt + 16384, rb, tid);
    }
    if (GATED && ((t & 7) == 7)) {
      const int seg = t >> 3;
#pragma unroll
      for (int mi = 0; mi < 4; ++mi)
#pragma unroll
        for (int ni = 0; ni < 4; ++ni) {
          const int row = row0 + wm * 64 + mi * 16 + fr, col = col0 + wn * 64 + ni * 16 + fq * 4;
          const u32x2 g = *(const u32x2*)(gates + (size_t)row * INW + seg * 1024 + col);
          tot[mi][ni][0] += bf_lo(g[0]) * acc[mi][ni][0];
          tot[mi][ni][1] += bf_hi(g[0]) * acc[mi][ni][1];
          tot[mi][ni][2] += bf_lo(g[1]) * acc[mi][ni][2];
          tot[mi][ni][3] += bf_hi(g[1]) * acc[mi][ni][3];
          acc[mi][ni] = (f32x4){0.f, 0.f, 0.f, 0.f};
        }
    }
    __syncthreads();
  }
#pragma unroll
  for (int mi = 0; mi < 4; ++mi)
#pragma unroll
    for (int ni = 0; ni < 4; ++ni) {
      const int row = row0 + wm * 64 + mi * 16 + fr, col = col0 + wn * 64 + ni * 16 + fq * 4;
      epi(row, col, GATED ? tot[mi][ni] : acc[mi][ni]);
    }
}

DI void store_bf16x4(bf16_t* d, f32x4 v) {
  u32x2 o;
  o[0] = cvt_pk_bf16(v[0], v[1]);
  o[1] = cvt_pk_bf16(v[2], v[3]);
  *(u32x2*)d = o;
}

struct EpiZ {
  bf16_t* Z; bf16_t* VT; float* kv; int l;
  DI void operator()(int row, int col, f32x4 v) const {
    if (col >= 3584) {
#pragma unroll
      for (int j = 0; j < 4; ++j) v[j] = 1.f / (1.f + __expf(-v[j]));
    }
    store_bf16x4(Z + (size_t)row * INW + col, v);
    if (col >= 2048 && col < 3072) {
      const int which = (col - 2048) >> 9, hd = (col - 2048) & 511;
      if (row < NCTX) {
        const int b = row >> 8, s = row & 255, hh = hd >> 6, d = hd & 63;
        *(f32x4*)(kv + ((size_t)((((b * 2 + l) * 2 + which) * 8 + hh) * 256 + s)) * 64 + d) = v;
      }
      if (which == 1) {
#pragma unroll
        for (int j = 0; j < 4; ++j) VT[(size_t)(hd + j) * NTOK + row] = (bf16_t)(cvt_pk_bf16(v[j], 0.f) & 0xffffu);
      }
    }
  }
};
struct EpiBf16 {
  bf16_t* O; int ld;
  DI void operator()(int row, int col, f32x4 v) const { store_bf16x4(O + (size_t)row * ld + col, v); }
};
struct EpiResid {
  const Params* p; int l; int gate_off; bool from_input;
  DI void operator()(int row, int col, f32x4 v) const {
    const float* xi = from_input ? xin_row(*p, row) + col : p->X + (size_t)row * D + col;
    const f32x4 x = *(const f32x4*)xi;
    const f32x4 g = *(const f32x4*)(p->MOD + (size_t)(l * 5 + vec_of_row(row)) * 6144 + gate_off + col);
    f32x4 o;
#pragma unroll
    for (int j = 0; j < 4; ++j) o[j] = x[j] + g[j] * v[j];
    *(f32x4*)(p->X + (size_t)row * D + col) = o;
  }
};

template <bool LATBIAS>
DI void attn_chunk(const bf16x8 qf0, const bf16x8 qf1, const bf16_t* __restrict__ kbase, int kstride,
                   const bf16_t* __restrict__ vtbase, int vstride, int tk0, int tk1, int tk2, int tk3,
                   const float* __restrict__ rpb_h, int dr0, int band, int qc, float& m, float& lsum,
                   f32x4 (&o)[4], int lane) {
  const int fr = lane & 15, fq = lane >> 4;
  f32x4 s[4];
#pragma unroll
  for (int T = 0; T < 4; ++T) {
    const int tk = (T == 0 ? tk0 : T == 1 ? tk1 : T == 2 ? tk2 : tk3);
    const bf16_t* kp = kbase + (size_t)(tk + fr) * kstride + fq * 8;
    const bf16x8 k0 = *(const bf16x8*)kp;
    const bf16x8 k1 = *(const bf16x8*)(kp + 32);
    f32x4 z = (f32x4){0.f, 0.f, 0.f, 0.f};
    z = __builtin_amdgcn_mfma_f32_16x16x32_bf16(k0, qf0, z, 0, 0, 0);
    z = __builtin_amdgcn_mfma_f32_16x16x32_bf16(k1, qf1, z, 0, 0, 0);
    s[T] = z;
  }
  float cmax = -INFINITY;
#pragma unroll
  for (int T = 0; T < 4; ++T) {
#pragma unroll
    for (int j = 0; j < 4; ++j) {
      float v = s[T][j] * 0.125f;
      if (LATBIAS) {
        const int kc = band + (T & 1) * 16 + fq * 4 + j;
        const int cs = min(max(qc - 8, 0), 48);
        const bool valid = (kc >= cs) && (kc < cs + 16);
        const int dr = dr0 + (T >> 1);
        const int dc = min(max(kc - qc + 15, 0), 30);
        v = valid ? v + rpb_h[dr * 31 + dc] : -INFINITY;
      }
      s[T][j] = v;
      cmax = fmaxf(cmax, v);
    }
  }
  cmax = fmaxf(cmax, __shfl_xor(cmax, 16));
  cmax = fmaxf(cmax, __shfl_xor(cmax, 32));
  const float mnew = fmaxf(m, cmax);
  const float alpha = __expf(m - mnew);
  m = mnew;
  float ps = 0.f;
#pragma unroll
  for (int T = 0; T < 4; ++T)
#pragma unroll
    for (int j = 0; j < 4; ++j) {
      const float pv = __expf(s[T][j] - mnew);
      s[T][j] = pv;
      ps += pv;
    }
  lsum = lsum * alpha + ps;
#pragma unroll
  for (int dt = 0; dt < 4; ++dt) o[dt] *= alpha;
#pragma unroll
  for (int pr = 0; pr < 2; ++pr) {
    u32x4 pk;
    pk[0] = cvt_pk_bf16(s[2 * pr][0], s[2 * pr][1]);
    pk[1] = cvt_pk_bf16(s[2 * pr][2], s[2 * pr][3]);
    pk[2] = cvt_pk_bf16(s[2 * pr + 1][0], s[2 * pr + 1][1]);
    pk[3] = cvt_pk_bf16(s[2 * pr + 1][2], s[2 * pr + 1][3]);
    const bf16x8 pa = __builtin_bit_cast(bf16x8, pk);
    const int ta = (pr == 0 ? tk0 : tk2), tb = (pr == 0 ? tk1 : tk3);
#pragma unroll
    for (int dt = 0; dt < 4; ++dt) {
      const bf16_t* vp = vtbase + (size_t)(dt * 16 + fr) * vstride + fq * 4;
      const u32x2 lo = *(const u32x2*)(vp + ta);
      const u32x2 hi = *(const u32x2*)(vp + tb);
      u32x4 vv;
      vv[0] = lo[0]; vv[1] = lo[1]; vv[2] = hi[0]; vv[3] = hi[1];
      o[dt] = __builtin_amdgcn_mfma_f32_16x16x32_bf16(__builtin_bit_cast(bf16x8, vv), pa, o[dt], 0, 0, 0);
    }
  }
}

DI void attn_finish(bf16_t* ys_row, float lsum, const f32x4 (&o)[4], int lane) {
  const int fq = lane >> 4;
  lsum += __shfl_xor(lsum, 16);
  lsum += __shfl_xor(lsum, 32);
  const float inv = 1.f / lsum;
#pragma unroll
  for (int dt = 0; dt < 4; ++dt) store_bf16x4(ys_row + dt * 16 + fq * 4, o[dt] * inv);
}

DI void attn_ctx_unit(const Params& p, int u, int lane) {
  const int b = u >> 7, h = (u >> 4) & 7, qt = u & 15;
  const int fr = lane & 15, fq = lane >> 4;
  const int qtok = b * 256 + qt * 16 + fr;
  const bf16_t* qp = p.Z + (size_t)qtok * INW + 1536 + h * 64 + fq * 8;
  const bf16x8 qf0 = *(const bf16x8*)qp, qf1 = *(const bf16x8*)(qp + 32);
  const bf16_t* kbase = p.Z + 2048 + h * 64;
  const bf16_t* vtbase = p.VT + (size_t)h * 64 * NTOK;
  float m = -INFINITY, lsum = 0.f;
  f32x4 o[4];
#pragma unroll
  for (int dt = 0; dt < 4; ++dt) o[dt] = (f32x4){0.f, 0.f, 0.f, 0.f};
  for (int ch = 0; ch < 4; ++ch) {
    const int t0 = b * 256 + ch * 64;
    attn_chunk<false>(qf0, qf1, kbase, INW, vtbase, NTOK, t0, t0 + 16, t0 + 32, t0 + 48, nullptr, 0, 0, 0, m, lsum, o,
                      lane);
  }
  attn_finish(p.YS + (size_t)qtok * 1536 + 512 + h * 64, lsum, o, lane);
}

DI void attn_lat_unit(const Params& p, int l, int u, int lane) {
  const int b = u >> 9, h = (u >> 6) & 7, r = (u >> 2) & 15, j = u & 3;
  const int fr = lane & 15, fq = lane >> 4;
  const int qc = j * 16 + fr;
  const int qtok = NCTX + b * 1024 + r * 64 + qc;
  const bf16_t* qp = p.Z + (size_t)qtok * INW + 1536 + h * 64 + fq * 8;
  const bf16x8 qf0 = *(const bf16x8*)qp, qf1 = *(const bf16x8*)(qp + 32);
  float m = -INFINITY, lsum = 0.f;
  f32x4 o[4];
#pragma unroll
  for (int dt = 0; dt < 4; ++dt) o[dt] = (f32x4){0.f, 0.f, 0.f, 0.f};
  {
    const bf16_t* kbase = p.Z + 2048 + h * 64;
    const bf16_t* vtbase = p.VT + (size_t)h * 64 * NTOK;
    const float* rpb_h = p.rpb + (size_t)(l * 8 + h) * 15 * 31;
    const int rs = min(max(r - 4, 0), 8);
    const int band = min(max(j * 16 - 8, 0), 32);
    for (int ch = 0; ch < 4; ++ch) {
      const int kr = rs + 2 * ch;
      const int t0 = NCTX + b * 1024 + kr * 64 + band;
      attn_chunk<true>(qf0, qf1, kbase, INW, vtbase, NTOK, t0, t0 + 16, t0 + 64, t0 + 80, rpb_h, kr - r + 7, band, qc,
                       m, lsum, o, lane);
    }
  }
  {
    const bf16_t* kbase = p.KC + (size_t)((b * 2 + l) * 8 + h) * 16384;
    const bf16_t* vtbase = p.VCT + (size_t)((b * 2 + l) * 8 + h) * 16384;
    for (int ch = 0; ch < 4; ++ch) {
      const int t0 = ch * 64;
      attn_chunk<false>(qf0, qf1, kbase, 64, vtbase, 256, t0, t0 + 16, t0 + 32, t0 + 48, nullptr, 0, 0, 0, m, lsum, o,
                        lane);
    }
  }
  attn_finish(p.YS + (size_t)qtok * 1536 + 512 + h * 64, lsum, o, lane);
}

DI void unpack8(u32x4 u, float (&f)[8]) {
#pragma unroll
  for (int j = 0; j < 4; ++j) {
    f[2 * j] = bf_lo(u[j]);
    f[2 * j + 1] = bf_hi(u[j]);
  }
}
DI u32x4 pack8(const float (&f)[8]) {
  u32x4 o;
#pragma unroll
  for (int j = 0; j < 4; ++j) o[j] = cvt_pk_bf16(f[2 * j], f[2 * j + 1]);
  return o;
}

DI void conv_item(const Params& p, int l, int it) {
  const int t = tidx();
  const int row = it * 4 + (t >> 6), ch = (t & 63) * 8;
  const bf16_t* z = p.Z + (size_t)row * INW;
  float bg[8], a[8], b[8], acc[8];
  unpack8(*(const u32x4*)(z + ch), bg);
  const float* cw = p.conv_w + (size_t)l * 3 * 512 + ch;
  unpack8(*(const u32x4*)(z + 512 + ch), a);
  unpack8(*(const u32x4*)(z + 1024 + ch), b);
#pragma unroll
  for (int j = 0; j < 8; ++j) acc[j] = a[j] * b[j] * cw[512 + j];
  if (!seq_first(row)) {
    unpack8(*(const u32x4*)(z - INW + 512 + ch), a);
    unpack8(*(const u32x4*)(z - INW + 1024 + ch), b);
#pragma unroll
    for (int j = 0; j < 8; ++j) acc[j] += a[j] * b[j] * cw[j];
  }
  if (!seq_last(row)) {
    unpack8(*(const u32x4*)(z + INW + 512 + ch), a);
    unpack8(*(const u32x4*)(z + INW + 1024 + ch), b);
#pragma unroll
    for (int j = 0; j < 8; ++j) acc[j] += a[j] * b[j] * cw[1024 + j];
  }
#pragma unroll
  for (int j = 0; j < 8; ++j) acc[j] *= bg[j];
  *(u32x4*)(p.YS + (size_t)row * 1536 + ch) = pack8(acc);
}

DI void pool_item(const Params& p, int it) {
  const int t = tidx();
  const int row = it * 4 + (t >> 6), ch = (t & 63) * 8;
  const int g = ch >> 7, w = 2 << g;
  int seq0, seqn;
  if (row < NCTX) { seq0 = row & ~255; seqn = 256; } else { seq0 = row & ~1023; seqn = 1024; }
  const int tt = row - seq0;
  const int lo = max(tt - w / 2, 0), hi = min(tt - w / 2 + w, seqn);
  float acc[8], f[8];
#pragma unroll
  for (int j = 0; j < 8; ++j) acc[j] = 0.f;
  for (int q = lo; q < hi; ++q) {
    unpack8(*(const u32x4*)(p.Z + (size_t)(seq0 + q) * INW + 3072 + ch), f);
#pragma unroll
    for (int j = 0; j < 8; ++j) acc[j] += f[j];
  }
  unpack8(*(const u32x4*)(p.Z + (size_t)row * INW + 3072 + ch), f);
  const float inv = 1.f / (float)(hi - lo);
#pragma unroll
  for (int j = 0; j < 8; ++j) acc[j] = acc[j] * inv - f[j];
  *(u32x4*)(p.YS + (size_t)row * 1536 + 1024 + ch) = pack8(acc);
}

DI float gelu_tanh(float x) {
  const float y = 0.7978845608028654f * (x + 0.044715f * x * x * x);
  const float e = __expf(2.f * y);
  const float th = 1.f - 2.f / (e + 1.f);
  return 0.5f * x * (1.f + th);
}
DI void act_item(const Params& p, int l, int it) {
  const int id = it * 256 + tidx();
  const int row = id / 352, ch = (id % 352) * 8;
  const bf16_t* u = p.U + (size_t)row * (2 * DFF);
  const float* cw = p.f_conv + (size_t)l * 3 * DFF + ch;
  float a[8], acc[8], val[8];
  unpack8(*(const u32x4*)(u + ch), a);
#pragma unroll
  for (int j = 0; j < 8; ++j) acc[j] = a[j] * cw[DFF + j];
  if (!seq_first(row)) {
    unpack8(*(const u32x4*)(u - 2 * DFF + ch), a);
#pragma unroll
    for (int j = 0; j < 8; ++j) acc[j] += a[j] * cw[j];
  }
  if (!seq_last(row)) {
    unpack8(*(const u32x4*)(u + 2 * DFF + ch), a);
#pragma unroll
    for (int j = 0; j < 8; ++j) acc[j] += a[j] * cw[2 * DFF + j];
  }
  unpack8(*(const u32x4*)(u + DFF + ch), val);
#pragma unroll
  for (int j = 0; j < 8; ++j) acc[j] = gelu_tanh(acc[j]) * val[j];
  *(u32x4*)(p.ACT + (size_t)row * DFF + ch) = pack8(acc);
}

DI void final_row(const Params& p, int row) {
  const int lane = tidx() & 63;
  const float* xr = p.X + (size_t)row * D;
  f32x4 v[4];
  float ss = 0.f;
#pragma unroll
  for (int i = 0; i < 4; ++i) {
    v[i] = *(const f32x4*)(xr + i * 256 + lane * 4);
    ss += v[i][0] * v[i][0] + v[i][1] * v[i][1] + v[i][2] * v[i][2] + v[i][3] * v[i][3];
  }
  ss = wave_sum(ss);
  const float rstd = rsqrtf(ss * (1.f / 1024.f) + 1e-6f);
#pragma unroll
  for (int i = 0; i < 4; ++i) {
    const int col = i * 256 + lane * 4;
    const f32x4 gg = *(const f32x4*)(p.g_final + col);
    f32x4 o;
#pragma unroll
    for (int j = 0; j < 4; ++j) o[j] = v[i][j] * rstd * gg[j];
    *(f32x4*)(p.out + (size_t)row * D + col) = o;
  }
}

constexpr int N_PHASES = 20;
__shared__ __attribute__((aligned(16))) char g_smem[65536];
#define NI __device__ __forceinline__
constexpr size_t KV_OFF = (size_t)NTOK * D;

NI void ph_prep0(const Params& p) {
  char* smem = g_smem;
  const int nb = gridDim.x, bid = bidx();
  const int total = PREP_ITEMS + MOD_ITEMS + CACHE_ITEMS;
  for (int it = bid; it < total; it += nb) {
    if (it < MOD_ITEMS) mod_item(p, it, (float*)smem);
    else if (it < MOD_ITEMS + CACHE_ITEMS) cache_item(p, it - MOD_ITEMS);
    else prep_item(p, 0, it - MOD_ITEMS - CACHE_ITEMS, (float*)smem);
  }
}
NI void ph_final(const Params& p) {
  const int nb = gridDim.x, bid = bidx(), wid = tidx() >> 6;
  for (int row = bid * 4 + wid; row < NTOK; row += nb * 4) final_row(p, row);
}
NI void ph_normmod1(const Params& p, int l) {
  char* smem = g_smem;
  const int nb = gridDim.x, bid = bidx(), wid = tidx() >> 6;
  for (int row = bid * 4 + wid; row < NTOK; row += nb * 4)
    normmod_row(p, l, 0, row, l == 0 ? xin_row(p, row) : p.X + (size_t)row * D);
  if (l == 1)
    for (int it = bid; it < PREP_ITEMS; it += nb) prep_item(p, 1, it, (float*)smem);
}
NI void ph_inproj(const Params& p, int l) {
  char* smem = g_smem;
  const int nb = gridDim.x, bid = bidx();
  EpiZ epi{p.Z, p.VT, p.out + KV_OFF, l};
  for (int t = bid; t < 64 * 52; t += nb)
    gemm_tile<false>(p.H, D, p.WIN, D, D, (t & 63) * 128, (t >> 6) * 128, smem, epi, nullptr);
}
NI void ph_attn(const Params& p, int l) {
  const int nb = gridDim.x, bid = bidx(), wid = tidx() >> 6, lane = tidx() & 63;
  for (int it = bid; it < 1024; it += nb) {
    if (it < 512) attn_lat_unit(p, l, it * 4 + wid, lane);
    else attn_ctx_unit(p, (it - 512) * 4 + wid, lane);
  }
}
NI void ph_convpool(const Params& p, int l) {
  const int nb = gridDim.x, bid = bidx();
  for (int it = bid; it < 4096; it += nb) {
    if (it < 2048) conv_item(p, l, it);
    else pool_item(p, it - 2048);
  }
}
NI void ph_branch(const Params& p) {
  char* smem = g_smem;
  const int nb = gridDim.x, bid = bidx();
  EpiBf16 epi{p.MERGED, D};
  for (int t = bid; t < 64 * 8; t += nb)
    gemm_tile<true>(p.YS, 1536, p.WB, 1536, 1536, (t & 63) * 128, (t >> 6) * 128, smem, epi, p.Z + 3584);
}
NI void ph_outproj(const Params& p, int l) {
  char* smem = g_smem;
  const int nb = gridDim.x, bid = bidx();
  EpiResid epi{&p, l, 2048, l == 0};
  for (int t = bid; t < 64 * 8; t += nb)
    gemm_tile<false>(p.MERGED, D, p.WO, D, D, (t & 63) * 128, (t >> 6) * 128, smem, epi, nullptr);
}
NI void ph_normmod2(const Params& p, int l) {
  const int nb = gridDim.x, bid = bidx(), wid = tidx() >> 6;
  for (int row = bid * 4 + wid; row < NTOK; row += nb * 4) normmod_row(p, l, 1, row, p.X + (size_t)row * D);
}
NI void ph_up(const Params& p) {
  char* smem = g_smem;
  const int nb = gridDim.x, bid = bidx();
  EpiBf16 epi{p.U, 2 * DFF};
  for (int t = bid; t < 64 * 44; t += nb)
    gemm_tile<false>(p.H, D, p.WU, D, D, (t & 63) * 128, (t >> 6) * 128, smem, epi, nullptr);
}
NI void ph_act(const Params& p, int l) {
  const int nb = gridDim.x, bid = bidx();
  for (int it = bid; it < NTOK * 352 / 256; it += nb) act_item(p, l, it);
}
NI void ph_down(const Params& p, int l) {
  char* smem = g_smem;
  const int nb = gridDim.x, bid = bidx();
  EpiResid epi{&p, l, 5120, false};
  for (int t = bid; t < 64 * 8; t += nb)
    gemm_tile<false>(p.ACT, DFF, p.WD, DFF, DFF, (t & 63) * 128, (t >> 6) * 128, smem, epi, nullptr);
}

DI void run_phase(const Params& p, int ph) {
  if (ph == 0) { ph_prep0(p); return; }
  if (ph == 19) { ph_final(p); return; }
  const int l = (ph - 1) / 9, s = (ph - 1) % 9;
  switch (s) {
    case 0: ph_normmod1(p, l); break;
    case 1: ph_inproj(p, l); break;
    case 2: ph_attn(p, l); ph_convpool(p, l); break;
    case 3: ph_branch(p); break;
    case 4: ph_outproj(p, l); break;
    case 5: ph_normmod2(p, l); break;
    case 6: ph_up(p); break;
    case 7: ph_act(p, l); break;
    case 8: ph_down(p, l); break;
  }
}


#define XB_TMO      128
#define XB_XCNT(j)  (256  + 64 * (j))
#define XB_XSUB(j)  (1280 + 64 * (j))
#define XB_XGEN(j)  (2304 + 64 * (j))
#define XB_TOP      3328
#define XB_TOPGEN   3392
#define XCD_BAR_WORDS 3456
#define XB_SPIN_CAP (1u << 20)
DI unsigned xb_ld(unsigned* p) { return __hip_atomic_load(p, __ATOMIC_RELAXED, __HIP_MEMORY_SCOPE_AGENT); }
DI unsigned xb_add(unsigned* p, unsigned v) { return __hip_atomic_fetch_add(p, v, __ATOMIC_RELAXED, __HIP_MEMORY_SCOPE_AGENT); }
DI unsigned xb_xcc_id() { return (unsigned)__builtin_amdgcn_s_getreg((3 << 11) | 20) & 0xFu; }
#define XB_SPIN(cond, bar) do { unsigned _sp = 0; while (cond) { __builtin_amdgcn_s_sleep(1); \
    if ((++_sp & 255u) == 0u) { if (xb_ld(&(bar)[XB_TMO])) break; if (_sp > XB_SPIN_CAP) { atomicAdd(&(bar)[XB_TMO], 1u); break; } } } } while (0)
struct XcdBarrier { unsigned* bar; unsigned x, nloc, nx; };
DI XcdBarrier xcd_barrier_post(unsigned* bar) {
  XcdBarrier b; b.bar = bar; b.x = xb_xcc_id(); b.nloc = 0u; b.nx = 0u;
  if (threadIdx.x == 0) (void)xb_add(&bar[XB_XCNT(b.x)], 1u);
  return b;
}
DI void xcd_barrier_complete(unsigned* bar, unsigned x, unsigned& nloc, unsigned& nx) {
  const unsigned G = gridDim.x;
  unsigned sum, cnt, mine, sp = 0u;
  for (;;) {
    sum = 0u; cnt = 0u; mine = 0u;
#pragma unroll
    for (unsigned j = 0; j < 16; ++j) { const unsigned c = xb_ld(&bar[XB_XCNT(j)]); sum += c; cnt += (c > 0u) ? 1u : 0u; mine = (j == x) ? c : mine; }
    if (sum == G) break;
    __builtin_amdgcn_s_sleep(1);
    if ((++sp & 255u) == 0u) { if (xb_ld(&bar[XB_TMO])) break; if (sp > XB_SPIN_CAP) { atomicAdd(&bar[XB_TMO], 1u); break; } }
  }
  nloc = mine > 0u ? mine : 1u; nx = cnt > 0u ? cnt : 1u;
}
DI void xcd_barrier(XcdBarrier& b) {
  asm volatile("s_waitcnt vmcnt(0)" ::: "memory");
  __syncthreads();
  if (threadIdx.x == 0) {
    unsigned* bar = b.bar;
    __builtin_amdgcn_s_waitcnt(0);
    if (b.nloc == 0u) xcd_barrier_complete(bar, b.x, b.nloc, b.nx);
    const unsigned nloc = b.nloc, nx = b.nx;
    const unsigned old = xb_add(&bar[XB_XSUB(b.x)], 1u);
    const unsigned gen = old / nloc;
    if (old + 1u == (gen + 1u) * nloc) {
      __builtin_amdgcn_fence(__ATOMIC_RELEASE, "agent");
      asm volatile("s_waitcnt vmcnt(0)" ::: "memory");
      const unsigned og = xb_add(&bar[XB_TOP], 1u);
      const unsigned tg = og / nx;
      if (og + 1u == (tg + 1u) * nx) xb_add(&bar[XB_TOPGEN], 1u);
      else XB_SPIN(xb_ld(&bar[XB_TOPGEN]) == tg, bar);
      __builtin_amdgcn_fence(__ATOMIC_ACQUIRE, "agent");
      xb_add(&bar[XB_XGEN(b.x)], 1u);
      asm volatile("s_waitcnt vmcnt(0)" ::: "memory");
    } else {
      XB_SPIN(xb_ld(&bar[XB_XGEN(b.x)]) == gen, bar);
      __builtin_amdgcn_fence(__ATOMIC_ACQUIRE, "agent");
      asm volatile("s_waitcnt vmcnt(0)" ::: "memory");
    }
  }
  __syncthreads();
}

__global__ void __launch_bounds__(NTHREADS, 2) mega_kernel(Params p, int ph_lo, int ph_hi) {
  cg::grid_group grid = cg::this_grid();
  XcdBarrier xb = xcd_barrier_post(p.BAR);
  for (int ph = ph_lo; ph < ph_hi; ++ph) {
    run_phase(p, ph);
    if (ph + 1 < ph_hi) xcd_barrier(xb);
  }
  if (ph_hi > 1000) grid.sync();
}

extern "C" void kernel_launch(void* const* d_in, const int* in_sizes, int n_in, void* d_out, int out_size, void* d_ws,
                              size_t ws_size, hipStream_t stream) {
  static int grid_blocks = 0;
  if (!grid_blocks) {
    int dev = 0, cus = 0, per_cu = 0;
    hipGetDevice(&dev);
    hipDeviceGetAttribute(&cus, hipDeviceAttributeMultiprocessorCount, dev);
    hipOccupancyMaxActiveBlocksPerMultiprocessor(&per_cu, mega_kernel, NTHREADS, 0);
    if (per_cu > 2) per_cu = 2;
    grid_blocks = cus * per_cu;
  }
  Params p{};
  const float** f = (const float**)&p;
  for (int i = 0; i < 20; ++i) f[i] = (const float*)d_in[i];
  p.out = (float*)d_out;
  char* ws = (char*)d_ws;
  size_t off = 0;
  auto take = [&](size_t bytes) { char* r = ws + off; off += (bytes + 255) & ~(size_t)255; return r; };
  p.BAR = (unsigned*)take(XCD_BAR_WORDS * 4);
  p.MOD = (float*)take(2 * 5 * 6144 * 4);
  p.X = (float*)take((size_t)NTOK * D * 4);
  p.KC = (bf16_t*)take((size_t)64 * 16384 * 2);
  p.VCT = (bf16_t*)take((size_t)64 * 16384 * 2);
  p.WIN = (bf16_t*)take((size_t)INW * D * 2);
  p.WB = (bf16_t*)take((size_t)D * 1536 * 2);
  p.WO = (bf16_t*)take((size_t)D * D * 2);
  p.WU = (bf16_t*)take((size_t)2 * DFF * D * 2);
  p.WD = (bf16_t*)take((size_t)D * DFF * 2);
  p.H = (bf16_t*)take((size_t)NTOK * D * 2);
  p.Z = (bf16_t*)take((size_t)NTOK * INW * 2);
  p.U = p.Z;
  char* r2 = take((size_t)NTOK * 1536 * 2 + (size_t)NTOK * D * 2 + (size_t)512 * NTOK * 2);
  p.YS = (bf16_t*)r2;
  p.MERGED = (bf16_t*)(r2 + (size_t)NTOK * 1536 * 2);
  p.VT = (bf16_t*)(r2 + (size_t)NTOK * 1536 * 2 + (size_t)NTOK * D * 2);
  p.ACT = (bf16_t*)r2;
  hipMemsetAsync(p.BAR, 0, XCD_BAR_WORDS * 4, stream);
#ifndef MULTI_LAUNCH
#define MULTI_LAUNCH 0
#endif
#if MULTI_LAUNCH
  for (int ph = 0; ph < N_PHASES; ++ph) mega_kernel<<<dim3(grid_blocks), dim3(NTHREADS), 0, stream>>>(p, ph, ph + 1);
#else
  int lo = 0, hi = N_PHASES;
  void* args[] = {&p, &lo, &hi};
  hipError_t e = hipLaunchCooperativeKernel((void*)mega_kernel, dim3(grid_blocks), dim3(NTHREADS), args, 0, stream);
  if (e != hipSuccess) fprintf(stderr, "cooperative launch failed: %s (grid %d)\n", hipGetErrorString(e), grid_blocks);
#endif
}
```

```cpp
#include <hip/hip_runtime.h>
#include <hip/hip_cooperative_groups.h>
#include <cstdio>
namespace cg = cooperative_groups;

typedef unsigned short bf16_t;
typedef short bf16x8 __attribute__((ext_vector_type(8)));
typedef float f32x4 __attribute__((ext_vector_type(4)));
typedef unsigned u32x4 __attribute__((ext_vector_type(4)));
typedef unsigned u32x2 __attribute__((ext_vector_type(2)));

#define DI __device__ __forceinline__
DI int tidx() { int t = threadIdx.x; asm volatile("" : "+v"(t)); return t; }
DI int bidx() { int b = blockIdx.x; asm volatile("" : "+s"(b)); return b; }

constexpr int D = 1024, NTOK = 8192, NCTX = 4096, INW = 6656, DFF = 2816;
constexpr int NTHREADS = 512, NWAVES = 8;
constexpr int LDS_BYTES = 147456;

struct Params {
  const float *x_prompt, *x_sample, *cache_kv, *c, *c_ctx, *w_mod, *b_mod, *g1, *g2, *w_in, *conv_w, *rpb, *pool_w,
      *pool_scale, *w_branch, *w_out, *w_up, *f_conv, *w_down, *g_final;
  float* out;
  float* MOD;
  float* X;
  unsigned* BAR;
  bf16_t *KC, *VCT, *WIN, *WB, *WO, *WU, *WD, *H, *Z, *U, *YS, *MERGED, *VT, *ACT;
};

typedef float f32x2 __attribute__((ext_vector_type(2)));
typedef __bf16 bf16x2_t __attribute__((ext_vector_type(2)));
DI unsigned cvt_pk_bf16(float lo, float hi) {
  const f32x2 v = {lo, hi};
  return __builtin_bit_cast(unsigned, __builtin_convertvector(v, bf16x2_t));
}
DI float bf_lo(unsigned u) { return __uint_as_float(u << 16); }
DI float bf_hi(unsigned u) { return __uint_as_float(u & 0xffff0000u); }
DI float wave_sum(float v) {
#pragma unroll
  for (int o = 32; o > 0; o >>= 1) v += __shfl_xor(v, o);
  return v;
}
DI const float* xin_row(const Params& p, int row) {
  return row < NCTX ? p.x_prompt + (size_t)row * D : p.x_sample + (size_t)(row - NCTX) * D;
}
DI int vec_of_row(int row) { return row < NCTX ? 0 : 1 + ((row - NCTX) >> 10); }
DI bool seq_first(int row) { return row < NCTX ? ((row & 255) == 0) : ((row & 1023) == 0); }
DI bool seq_last(int row) { return row < NCTX ? ((row & 255) == 255) : ((row & 1023) == 1023); }

DI void transpose_tile(const float* __restrict__ src, int srcld, bf16_t* __restrict__ dst, int dstld, int kt, int nt,
                       float* sm) {
  const int t = tidx();
  const float* s = src + (size_t)(kt * 128) * srcld + nt * 64;
#pragma unroll
  for (int i = 0; i < 4; ++i) {
    const int row = (t >> 4) + 32 * i, c4 = (t & 15) * 4;
    const f32x4 v = *(const f32x4*)(s + (size_t)row * srcld + c4);
    sm[row * 65 + c4 + 0] = v[0];
    sm[row * 65 + c4 + 1] = v[1];
    sm[row * 65 + c4 + 2] = v[2];
    sm[row * 65 + c4 + 3] = v[3];
  }
  __syncthreads();
  const int n = t >> 3, ks = (t & 7) * 16;
  u32x4 w0, w1;
#pragma unroll
  for (int j = 0; j < 4; ++j) {
    w0[j] = cvt_pk_bf16(sm[(ks + 2 * j) * 65 + n], sm[(ks + 2 * j + 1) * 65 + n]);
    w1[j] = cvt_pk_bf16(sm[(ks + 8 + 2 * j) * 65 + n], sm[(ks + 8 + 2 * j + 1) * 65 + n]);
  }
  bf16_t* d = dst + (size_t)(nt * 64 + n) * dstld + kt * 128 + ks;
  *(u32x4*)d = w0;
  *(u32x4*)(d + 8) = w1;
  __syncthreads();
}

constexpr int PREP_T_IN = 8 * 104, PREP_T_BR = 2 * 4 * 16, PREP_T_OUT = 8 * 16, PREP_T_UP = 8 * 88,
              PREP_T_DN = 22 * 16, PREP_WEFF = 128;
constexpr int PREP_ITEMS = PREP_T_IN + PREP_T_BR + PREP_T_OUT + PREP_T_UP + PREP_T_DN + PREP_WEFF;

DI void prep_item(const Params& p, int l, int it, float* sm) {
  if (it < PREP_T_IN) {
    transpose_tile(p.w_in + (size_t)l * D * INW, INW, p.WIN, D, it / 104, it % 104, sm);
    return;
  }
  it -= PREP_T_IN;
  if (it < PREP_T_BR) {
    const int i = it >> 6, r = it & 63;
    transpose_tile(p.w_branch + (size_t)(l * 3 + i) * 512 * D, D, p.WB + i * 512, 1536, r >> 4, r & 15, sm);
    return;
  }
  it -= PREP_T_BR;
  if (it < PREP_T_OUT) {
    transpose_tile(p.w_out + (size_t)l * D * D, D, p.WO, D, it >> 4, it & 15, sm);
    return;
  }
  it -= PREP_T_OUT;
  if (it < PREP_T_UP) {
    transpose_tile(p.w_up + (size_t)l * D * 2 * DFF, 2 * DFF, p.WU, D, it / 88, it % 88, sm);
    return;
  }
  it -= PREP_T_UP;
  if (it < PREP_T_DN) {
    transpose_tile(p.w_down + (size_t)l * DFF * D, D, p.WD, DFF, it >> 4, it & 15, sm);
    return;
  }
  it -= PREP_T_DN;
  {
    const int g = it >> 5, cb = (it >> 1) & 15, db = it & 1;
    const int dd = db * 512 + tidx();
    const float* wb2 = p.w_branch + (size_t)(l * 3 + 2) * 512 * D + (size_t)(g * 128) * D + dd;
    const float* psc = p.pool_scale + l * 512 + g * 128;
    const float* pw = p.pool_w + ((size_t)(l * 4 + g) * 128 + cb * 8) * 128;
    float acc[8];
#pragma unroll
    for (int c = 0; c < 8; ++c) acc[c] = 0.f;
    for (int e = 0; e < 128; ++e) {
      const float w = wb2[(size_t)e * D] * psc[e];
#pragma unroll
      for (int c = 0; c < 8; ++c) acc[c] += pw[c * 128 + e] * w;
    }
    u32x4 o;
#pragma unroll
    for (int j = 0; j < 4; ++j) o[j] = cvt_pk_bf16(acc[2 * j], acc[2 * j + 1]);
    *(u32x4*)(p.WB + (size_t)dd * 1536 + 1024 + g * 128 + cb * 8) = o;
  }
}

constexpr int MOD_ITEMS = 2 * 96;
DI void mod_item(const Params& p, int it, float* sm) {
  const int t = tidx();
  const int l = it / 96, cb = it % 96;
  float* red = sm + 5 * 1024;
  for (int i = t; i < 5 * 1024; i += NTHREADS) {
    const int v = i >> 10, k = i & 1023;
    const float cv = (v == 0) ? p.c_ctx[k] : p.c[(v - 1) * D + k];
    sm[i] = cv / (1.f + __expf(-cv));
  }
  __syncthreads();
  const int kg = t >> 4, ct = t & 15;
  f32x4 acc[5];
#pragma unroll
  for (int v = 0; v < 5; ++v) acc[v] = (f32x4){0.f, 0.f, 0.f, 0.f};
  const float* w = p.w_mod + ((size_t)l * D + kg * 32) * 6144 + cb * 64 + ct * 4;
#pragma unroll 8
  for (int kk = 0; kk < 32; ++kk) {
    const f32x4 wv = *(const f32x4*)(w + (size_t)kk * 6144);
#pragma unroll
    for (int v = 0; v < 5; ++v) acc[v] += sm[v * 1024 + kg * 32 + kk] * wv;
  }
#pragma unroll
  for (int v = 0; v < 5; ++v)
#pragma unroll
    for (int j = 0; j < 4; ++j) red[(kg * 5 + v) * 64 + ct * 4 + j] = acc[v][j];
  __syncthreads();
  for (int i = t; i < 320; i += NTHREADS) {
    const int v = i >> 6, c = i & 63;
    float s = p.b_mod[l * 6144 + cb * 64 + c];
#pragma unroll
    for (int g = 0; g < 32; ++g) s += red[(g * 5 + v) * 64 + c];
    p.MOD[(size_t)(l * 5 + v) * 6144 + cb * 64 + c] = s;
  }
  __syncthreads();
}

constexpr int CACHE_ITEMS = 32;
DI void cache_item(const Params& p, int it) {
  const int t = tidx() & 255;
  it = it * 2 + (tidx() >> 8);
  const int b = it >> 4, l = (it >> 3) & 1, h = it & 7;
  const float* ks = p.cache_kv + ((size_t)(((b * 2 + l) * 2 + 0) * 8 + h)) * 16384;
  const float* vs = p.cache_kv + ((size_t)(((b * 2 + l) * 2 + 1) * 8 + h)) * 16384;
  bf16_t* kd = p.KC + (size_t)((b * 2 + l) * 8 + h) * 16384;
  bf16_t* vd = p.VCT + (size_t)((b * 2 + l) * 8 + h) * 16384;
#pragma unroll 4
  for (int i = 0; i < 16; ++i) {
    const int e = (i * 256 + t) * 4;
    const f32x4 v = *(const f32x4*)(ks + e);
    u32x2 o;
    o[0] = cvt_pk_bf16(v[0], v[1]);
    o[1] = cvt_pk_bf16(v[2], v[3]);
    *(u32x2*)(kd + e) = o;
  }
#pragma unroll 4
  for (int d = 0; d < 64; d += 4) {
    const f32x4 v = *(const f32x4*)(vs + t * 64 + d);
#pragma unroll
    for (int j = 0; j < 4; ++j) vd[(d + j) * 256 + t] = (bf16_t)(cvt_pk_bf16(v[j], 0.f) & 0xffffu);
  }
}

DI void normmod_row(const Params& p, int l, int which, int row, const float* xr) {
  const int lane = tidx() & 63;
  f32x4 v[4];
  float ss = 0.f;
#pragma unroll
  for (int i = 0; i < 4; ++i) {
    v[i] = *(const f32x4*)(xr + i * 256 + lane * 4);
    ss += v[i][0] * v[i][0] + v[i][1] * v[i][1] + v[i][2] * v[i][2] + v[i][3] * v[i][3];
  }
  ss = wave_sum(ss);
  const float rstd = rsqrtf(ss * (1.f / 1024.f) + 1e-6f);
  const float* g = (which == 0 ? p.g1 : p.g2) + l * D;
  const float* mod = p.MOD + (size_t)(l * 5 + vec_of_row(row)) * 6144 + which * 3072;
#pragma unroll
  for (int i = 0; i < 4; ++i) {
    const int col = i * 256 + lane * 4;
    const f32x4 gg = *(const f32x4*)(g + col);
    const f32x4 sh = *(const f32x4*)(mod + col);
    const f32x4 sc = *(const f32x4*)(mod + 1024 + col);
    f32x4 h;
#pragma unroll
    for (int j = 0; j < 4; ++j) h[j] = v[i][j] * rstd * gg[j] * (1.f + sc[j]) + sh[j];
    u32x2 o;
    o[0] = cvt_pk_bf16(h[0], h[1]);
    o[1] = cvt_pk_bf16(h[2], h[3]);
    *(u32x2*)(p.H + (size_t)row * D + col) = o;
  }
}

constexpr int STAGE_BYTES = 49152;
#ifdef EXP_B
#define EXP_B_EXTRA gemm_stage<256>(A, lda, (4 * x + (pj & 3)) * 256, pt * 64, dst, tid); gemm_stage<128>(Bt, ldb, (pj >> 2) * 128, pt * 64, dst + 32768, tid);
#define VM_STAGE "12"
#else
#define EXP_B_EXTRA
#define VM_STAGE "6"
#endif
template <int ROWS>
DI void gemm_stage(const bf16_t* __restrict__ A, int lda, int row0, int k0, char* s, int t) {
  const int cp = t & 7, rr = t >> 3, c = cp ^ (rr & 7);
#pragma unroll
  for (int i = 0; i < ROWS / 64; ++i)
    __builtin_amdgcn_global_load_lds((const unsigned*)(A + (size_t)(row0 + rr + 64 * i) * lda + k0 + c * 8),
                                     (unsigned*)(s + t * 16 + i * 8192), 16, 0, 0);
}
DI void gemm_compute(const char* sA, const char* sB, f32x4 (&acc)[4][4], int wm, int wn, int lane) {
  const int fr = lane & 15, fq = lane >> 4;
#pragma unroll
  for (int ks = 0; ks < 2; ++ks) {
    bf16x8 a[4], b[4];
    const int sw = ((ks * 4 + fq) ^ (fr & 7)) << 4;
#pragma unroll
    for (int ni = 0; ni < 4; ++ni) b[ni] = *(const bf16x8*)(sB + (wn * 64 + ni * 16 + fr) * 128 + sw);
#pragma unroll
    for (int mi = 0; mi < 4; ++mi) a[mi] = *(const bf16x8*)(sA + (wm * 64 + mi * 16 + fr) * 128 + sw);
    __builtin_amdgcn_sched_barrier(0);
#pragma unroll
    for (int mi = 0; mi < 4; ++mi)
#pragma unroll
      for (int ni = 0; ni < 4; ++ni)
        acc[mi][ni] = __builtin_amdgcn_mfma_f32_16x16x32_bf16(b[ni], a[mi], acc[mi][ni], 0, 0, 0);
    __builtin_amdgcn_sched_barrier(0);
  }
}

template <bool GATED, class Epi>
DI void gemm_phase(const bf16_t* __restrict__ A, int lda, const bf16_t* __restrict__ Bt, int ldb, int K, int N,
                   char* smem, const Epi& epi, const bf16_t* gates) {
  const int tid = tidx();
  const int wid = tid >> 6, lane = tid & 63, wm = wid >> 1, wn = wid & 1;
  const int fr = lane & 15, fq = lane >> 4;
  const int bid = bidx(), nb = gridDim.x;
  const int nN = N >> 7, nt = K >> 6;
  const int x = bid & 7, per_x = 4 * nN, cstep = nb >> 3;
  int pj = bid >> 3, pt = 0, ps = 0;
#define GEMM_ISSUE()                                                                                          \
  do {                                                                                                        \
    if (pj < per_x) {                                                                                         \
      char* dst = smem + ps * STAGE_BYTES;                                                                    \
      gemm_stage<256>(A, lda, (4 * x + (pj & 3)) * 256, pt * 64, dst, tid);                                   \
      gemm_stage<128>(Bt, ldb, (pj >> 2) * 128, pt * 64, dst + 32768, tid);                                   \
      EXP_B_EXTRA                                                                                             \
      if (++pt == nt) { pt = 0; pj += cstep; }                                                                \
      ps = (ps == 2) ? 0 : ps + 1;                                                                            \
    }                                                                                                         \
  } while (0)
  GEMM_ISSUE();
  GEMM_ISSUE();
  int cs = 0;
  for (int cj = bid >> 3; cj < per_x; cj += cstep) {
    const int row0 = (4 * x + (cj & 3)) * 256, col0 = (cj >> 2) * 128;
    f32x4 acc[4][4];
    f32x4 tot[4][4];
#pragma unroll
    for (int mi = 0; mi < 4; ++mi)
#pragma unroll
      for (int ni = 0; ni < 4; ++ni) {
        acc[mi][ni] = (f32x4){0.f, 0.f, 0.f, 0.f};
        if (GATED) tot[mi][ni] = (f32x4){0.f, 0.f, 0.f, 0.f};
      }
    const bool last_tile = cj + cstep >= per_x;
    for (int t = 0; t < nt; ++t) {
      if (last_tile && t == nt - 1) asm volatile("s_waitcnt vmcnt(0)" ::: "memory");
      else asm volatile("s_waitcnt vmcnt(" VM_STAGE ")" ::: "memory");
      __builtin_amdgcn_s_barrier();
      GEMM_ISSUE();
      const char* cur = smem + cs * STAGE_BYTES;
      gemm_compute(cur, cur + 32768, acc, wm, wn, lane);
      cs = (cs == 2) ? 0 : cs + 1;
      if (GATED && ((t & 7) == 7)) {
        const int seg = t >> 3;
        int gofs = (row0 + wm * 64 + fr) * INW + seg * 1024 + col0 + wn * 64 + fq * 4;
        asm volatile("" : "+v"(gofs));
#pragma unroll
        for (int mi = 0; mi < 4; ++mi)
#pragma unroll
          for (int ni = 0; ni < 4; ++ni) {
            const u32x2 g = *(const u32x2*)(gates + (gofs + mi * 16 * INW + ni * 16));
            tot[mi][ni][0] += bf_lo(g[0]) * acc[mi][ni][0];
            tot[mi][ni][1] += bf_hi(g[0]) * acc[mi][ni][1];
            tot[mi][ni][2] += bf_lo(g[1]) * acc[mi][ni][2];
            tot[mi][ni][3] += bf_hi(g[1]) * acc[mi][ni][3];
            acc[mi][ni] = (f32x4){0.f, 0.f, 0.f, 0.f};
          }
      }
    }
#pragma unroll
    for (int mi = 0; mi < 4; ++mi)
#pragma unroll
      for (int ni = 0; ni < 4; ++ni) {
        const int row = row0 + wm * 64 + mi * 16 + fr, col = col0 + wn * 64 + ni * 16 + fq * 4;
        epi(row, col, GATED ? tot[mi][ni] : acc[mi][ni]);
      }
  }
#undef GEMM_ISSUE
  __syncthreads();
}

DI void store_bf16x4(bf16_t* d, f32x4 v) {
  u32x2 o;
  o[0] = cvt_pk_bf16(v[0], v[1]);
  o[1] = cvt_pk_bf16(v[2], v[3]);
  *(u32x2*)d = o;
}

struct EpiZ {
  bf16_t* Z; bf16_t* VT; float* kv; int l;
  DI void operator()(int row, int col, f32x4 v) const {
    if (col >= 3584) {
#pragma unroll
      for (int j = 0; j < 4; ++j) v[j] = 1.f / (1.f + __expf(-v[j]));
    }
    store_bf16x4(Z + (size_t)row * INW + col, v);
    if (col >= 2048 && col < 3072) {
      const int which = (col - 2048) >> 9, hd = (col - 2048) & 511;
      if (row < NCTX) {
        const int b = row >> 8, s = row & 255, hh = hd >> 6, d = hd & 63;
        *(f32x4*)(kv + ((size_t)((((b * 2 + l) * 2 + which) * 8 + hh) * 256 + s)) * 64 + d) = v;
      }
      if (which == 1) {
#pragma unroll
        for (int j = 0; j < 4; ++j) VT[(size_t)(hd + j) * NTOK + row] = (bf16_t)(cvt_pk_bf16(v[j], 0.f) & 0xffffu);
      }
    }
  }
};
struct EpiBf16 {
  bf16_t* O; int ld;
  DI void operator()(int row, int col, f32x4 v) const { store_bf16x4(O + (size_t)row * ld + col, v); }
};
struct EpiResid {
  const Params* p; int l; int gate_off; bool from_input;
  DI void operator()(int row, int col, f32x4 v) const {
    const float* xi = from_input ? xin_row(*p, row) + col : p->X + (size_t)row * D + col;
    const f32x4 x = *(const f32x4*)xi;
    const f32x4 g = *(const f32x4*)(p->MOD + (size_t)(l * 5 + vec_of_row(row)) * 6144 + gate_off + col);
    f32x4 o;
#pragma unroll
    for (int j = 0; j < 4; ++j) o[j] = x[j] + g[j] * v[j];
    *(f32x4*)(p->X + (size_t)row * D + col) = o;
  }
};

template <bool LATBIAS>
DI void attn_chunk(const bf16x8 qf0, const bf16x8 qf1, const bf16_t* __restrict__ kbase, int kstride,
                   const bf16_t* __restrict__ vtbase, int vstride, int tk0, int tk1, int tk2, int tk3,
                   const float* __restrict__ rpb_h, int dr0, int band, int qc, float& m, float& lsum,
                   f32x4 (&o)[4], int lane) {
  const int fr = lane & 15, fq = lane >> 4;
  f32x4 s[4];
#pragma unroll
  for (int T = 0; T < 4; ++T) {
    const int tk = (T == 0 ? tk0 : T == 1 ? tk1 : T == 2 ? tk2 : tk3);
    const bf16_t* kp = kbase + (size_t)(tk + fr) * kstride + fq * 8;
    const bf16x8 k0 = *(const bf16x8*)kp;
    const bf16x8 k1 = *(const bf16x8*)(kp + 32);
    f32x4 z = (f32x4){0.f, 0.f, 0.f, 0.f};
    z = __builtin_amdgcn_mfma_f32_16x16x32_bf16(k0, qf0, z, 0, 0, 0);
    z = __builtin_amdgcn_mfma_f32_16x16x32_bf16(k1, qf1, z, 0, 0, 0);
    s[T] = z;
  }
  float cmax = -INFINITY;
#pragma unroll
  for (int T = 0; T < 4; ++T) {
#pragma unroll
    for (int j = 0; j < 4; ++j) {
      float v = s[T][j] * 0.125f;
      if (LATBIAS) {
        const int kc = band + (T & 1) * 16 + fq * 4 + j;
        const int cs = min(max(qc - 8, 0), 48);
        const bool valid = (kc >= cs) && (kc < cs + 16);
        const int dr = dr0 + (T >> 1);
        const int dc = min(max(kc - qc + 15, 0), 30);
        v = valid ? v + rpb_h[dr * 31 + dc] : -INFINITY;
      }
      s[T][j] = v;
      cmax = fmaxf(cmax, v);
    }
  }
  cmax = fmaxf(cmax, __shfl_xor(cmax, 16));
  cmax = fmaxf(cmax, __shfl_xor(cmax, 32));
  const float mnew = fmaxf(m, cmax);
  const float alpha = __expf(m - mnew);
  m = mnew;
  float ps = 0.f;
#pragma unroll
  for (int T = 0; T < 4; ++T)
#pragma unroll
    for (int j = 0; j < 4; ++j) {
      const float pv = __expf(s[T][j] - mnew);
      s[T][j] = pv;
      ps += pv;
    }
  lsum = lsum * alpha + ps;
#pragma unroll
  for (int dt = 0; dt < 4; ++dt) o[dt] *= alpha;
#pragma unroll
  for (int pr = 0; pr < 2; ++pr) {
    u32x4 pk;
    pk[0] = cvt_pk_bf16(s[2 * pr][0], s[2 * pr][1]);
    pk[1] = cvt_pk_bf16(s[2 * pr][2], s[2 * pr][3]);
    pk[2] = cvt_pk_bf16(s[2 * pr + 1][0], s[2 * pr + 1][1]);
    pk[3] = cvt_pk_bf16(s[2 * pr + 1][2], s[2 * pr + 1][3]);
    const bf16x8 pa = __builtin_bit_cast(bf16x8, pk);
    const int ta = (pr == 0 ? tk0 : tk2), tb = (pr == 0 ? tk1 : tk3);
#pragma unroll
    for (int dt = 0; dt < 4; ++dt) {
      const bf16_t* vp = vtbase + (size_t)(dt * 16 + fr) * vstride + fq * 4;
      const u32x2 lo = *(const u32x2*)(vp + ta);
      const u32x2 hi = *(const u32x2*)(vp + tb);
      u32x4 vv;
      vv[0] = lo[0]; vv[1] = lo[1]; vv[2] = hi[0]; vv[3] = hi[1];
      o[dt] = __builtin_amdgcn_mfma_f32_16x16x32_bf16(__builtin_bit_cast(bf16x8, vv), pa, o[dt], 0, 0, 0);
    }
  }
}

DI void attn_finish(bf16_t* ys_row, float lsum, const f32x4 (&o)[4], int lane) {
  const int fq = lane >> 4;
  lsum += __shfl_xor(lsum, 16);
  lsum += __shfl_xor(lsum, 32);
  const float inv = 1.f / lsum;
#pragma unroll
  for (int dt = 0; dt < 4; ++dt) store_bf16x4(ys_row + dt * 16 + fq * 4, o[dt] * inv);
}

constexpr int ATT_VROW = 528, ATT_SV_OFF = 32768;
DI void attn_stage_kv(const bf16_t* __restrict__ kbase, int kstride, int ktok0, const bf16_t* __restrict__ vtbase,
                      int vstride, int vtok0, char* smem, int tid) {
  gemm_stage<256>(kbase, kstride, ktok0, 0, smem, tid);
  const int d = tid >> 3, seg = tid & 7;
  const bf16_t* vp = vtbase + (size_t)d * vstride + vtok0 + seg * 32;
  char* dst = smem + ATT_SV_OFF + d * ATT_VROW + seg * 64;
#pragma unroll
  for (int i = 0; i < 4; ++i) *(u32x4*)(dst + i * 16) = *(const u32x4*)(vp + i * 8);
}
DI void attn_chunk_lds(const bf16x8 qf0, const bf16x8 qf1, const char* sK, const char* sV, int t0, float& m,
                       float& lsum, f32x4 (&o)[4], int lane) {
  const int fr = lane & 15, fq = lane >> 4;
  f32x4 s[4];
#pragma unroll
  for (int T = 0; T < 4; ++T) {
    const char* kp = sK + (t0 + T * 16 + fr) * 128;
    const bf16x8 k0 = *(const bf16x8*)(kp + ((fq ^ (fr & 7)) << 4));
    const bf16x8 k1 = *(const bf16x8*)(kp + (((4 + fq) ^ (fr & 7)) << 4));
    f32x4 z = (f32x4){0.f, 0.f, 0.f, 0.f};
    z = __builtin_amdgcn_mfma_f32_16x16x32_bf16(k0, qf0, z, 0, 0, 0);
    z = __builtin_amdgcn_mfma_f32_16x16x32_bf16(k1, qf1, z, 0, 0, 0);
    s[T] = z;
  }
  float cmax = -INFINITY;
#pragma unroll
  for (int T = 0; T < 4; ++T)
#pragma unroll
    for (int j = 0; j < 4; ++j) {
      s[T][j] *= 0.125f;
      cmax = fmaxf(cmax, s[T][j]);
    }
  cmax = fmaxf(cmax, __shfl_xor(cmax, 16));
  cmax = fmaxf(cmax, __shfl_xor(cmax, 32));
  const float mnew = fmaxf(m, cmax);
  const float alpha = __expf(m - mnew);
  m = mnew;
  float ps = 0.f;
#pragma unroll
  for (int T = 0; T < 4; ++T)
#pragma unroll
    for (int j = 0; j < 4; ++j) {
      const float pv = __expf(s[T][j] - mnew);
      s[T][j] = pv;
      ps += pv;
    }
  lsum = lsum * alpha + ps;
#pragma unroll
  for (int dt = 0; dt < 4; ++dt) o[dt] *= alpha;
#pragma unroll
  for (int pr = 0; pr < 2; ++pr) {
    u32x4 pk;
    pk[0] = cvt_pk_bf16(s[2 * pr][0], s[2 * pr][1]);
    pk[1] = cvt_pk_bf16(s[2 * pr][2], s[2 * pr][3]);
    pk[2] = cvt_pk_bf16(s[2 * pr + 1][0], s[2 * pr + 1][1]);
    pk[3] = cvt_pk_bf16(s[2 * pr + 1][2], s[2 * pr + 1][3]);
    const bf16x8 pa = __builtin_bit_cast(bf16x8, pk);
#pragma unroll
    for (int dt = 0; dt < 4; ++dt) {
      const char* vp = sV + (dt * 16 + fr) * ATT_VROW + (t0 + pr * 32 + fq * 4) * 2;
      const u32x2 lo = *(const u32x2*)vp;
      const u32x2 hi = *(const u32x2*)(vp + 32);
      u32x4 vv;
      vv[0] = lo[0]; vv[1] = lo[1]; vv[2] = hi[0]; vv[3] = hi[1];
      o[dt] = __builtin_amdgcn_mfma_f32_16x16x32_bf16(__builtin_bit_cast(bf16x8, vv), pa, o[dt], 0, 0, 0);
    }
  }
}

DI void attn_ctx_item(const Params& p, int it, char* smem) {
  const int tid = tidx(), wid = tid >> 6, lane = tid & 63;
  const int b = it >> 4, h = (it >> 1) & 7, qt = (it & 1) * 8 + wid;
  const int fr = lane & 15, fq = lane >> 4;
  __syncthreads();
  attn_stage_kv(p.Z + 2048 + h * 64, INW, b * 256, p.VT + (size_t)h * 64 * NTOK, NTOK, b * 256, smem, tid);
  const int qtok = b * 256 + qt * 16 + fr;
  const bf16_t* qp = p.Z + (size_t)qtok * INW + 1536 + h * 64 + fq * 8;
  const bf16x8 qf0 = *(const bf16x8*)qp, qf1 = *(const bf16x8*)(qp + 32);
  float m = -INFINITY, lsum = 0.f;
  f32x4 o[4];
#pragma unroll
  for (int dt = 0; dt < 4; ++dt) o[dt] = (f32x4){0.f, 0.f, 0.f, 0.f};
  __syncthreads();
  for (int ch = 0; ch < 4; ++ch) attn_chunk_lds(qf0, qf1, smem, smem + ATT_SV_OFF, ch * 64, m, lsum, o, lane);
  attn_finish(p.YS + (size_t)qtok * 1536 + 512 + h * 64, lsum, o, lane);
}

DI void attn_lat_item(const Params& p, int l, int it, char* smem) {
  const int tid = tidx(), wid = tid >> 6, lane = tid & 63;
  const int b = it >> 6, h = (it >> 3) & 7, r = (it & 7) * 2 + (wid >> 2), j = wid & 3;
  const int fr = lane & 15, fq = lane >> 4;
  __syncthreads();
  {
    const size_t cb = (size_t)((b * 2 + l) * 8 + h) * 16384;
    attn_stage_kv(p.KC + cb, 64, 0, p.VCT + cb, 256, 0, smem, tid);
  }
  const int qc = j * 16 + fr;
  const int qtok = NCTX + b * 1024 + r * 64 + qc;
  const bf16_t* qp = p.Z + (size_t)qtok * INW + 1536 + h * 64 + fq * 8;
  const bf16x8 qf0 = *(const bf16x8*)qp, qf1 = *(const bf16x8*)(qp + 32);
  float m = -INFINITY, lsum = 0.f;
  f32x4 o[4];
#pragma unroll
  for (int dt = 0; dt < 4; ++dt) o[dt] = (f32x4){0.f, 0.f, 0.f, 0.f};
  {
    const bf16_t* kbase = p.Z + 2048 + h * 64;
    const bf16_t* vtbase = p.VT + (size_t)h * 64 * NTOK;
    const float* rpb_h = p.rpb + (size_t)(l * 8 + h) * 15 * 31;
    const int rs = min(max(r - 4, 0), 8);
    const int band = min(max(j * 16 - 8, 0), 32);
    for (int ch = 0; ch < 4; ++ch) {
      const int kr = rs + 2 * ch;
      const int t0 = NCTX + b * 1024 + kr * 64 + band;
      attn_chunk<true>(qf0, qf1, kbase, INW, vtbase, NTOK, t0, t0 + 16, t0 + 64, t0 + 80, rpb_h, kr - r + 7, band, qc,
                       m, lsum, o, lane);
    }
  }
  __syncthreads();
  for (int ch = 0; ch < 4; ++ch) attn_chunk_lds(qf0, qf1, smem, smem + ATT_SV_OFF, ch * 64, m, lsum, o, lane);
  attn_finish(p.YS + (size_t)qtok * 1536 + 512 + h * 64, lsum, o, lane);
}

DI void attn_ctx_unit(const Params& p, int u, int lane) {
  const int b = u >> 7, h = (u >> 4) & 7, qt = u & 15;
  const int fr = lane & 15, fq = lane >> 4;
  const int qtok = b * 256 + qt * 16 + fr;
  const bf16_t* qp = p.Z + (size_t)qtok * INW + 1536 + h * 64 + fq * 8;
  const bf16x8 qf0 = *(const bf16x8*)qp, qf1 = *(const bf16x8*)(qp + 32);
  const bf16_t* kbase = p.Z + 2048 + h * 64;
  const bf16_t* vtbase = p.VT + (size_t)h * 64 * NTOK;
  float m = -INFINITY, lsum = 0.f;
  f32x4 o[4];
#pragma unroll
  for (int dt = 0; dt < 4; ++dt) o[dt] = (f32x4){0.f, 0.f, 0.f, 0.f};
  for (int ch = 0; ch < 4; ++ch) {
    const int t0 = b * 256 + ch * 64;
    attn_chunk<false>(qf0, qf1, kbase, INW, vtbase, NTOK, t0, t0 + 16, t0 + 32, t0 + 48, nullptr, 0, 0, 0, m, lsum, o,
                      lane);
  }
  attn_finish(p.YS + (size_t)qtok * 1536 + 512 + h * 64, lsum, o, lane);
}

DI void attn_lat_unit(const Params& p, int l, int u, int lane) {
  const int b = u >> 9, h = (u >> 6) & 7, r = (u >> 2) & 15, j = u & 3;
  const int fr = lane & 15, fq = lane >> 4;
  const int qc = j * 16 + fr;
  const int qtok = NCTX + b * 1024 + r * 64 + qc;
  const bf16_t* qp = p.Z + (size_t)qtok * INW + 1536 + h * 64 + fq * 8;
  const bf16x8 qf0 = *(const bf16x8*)qp, qf1 = *(const bf16x8*)(qp + 32);
  float m = -INFINITY, lsum = 0.f;
  f32x4 o[4];
#pragma unroll
  for (int dt = 0; dt < 4; ++dt) o[dt] = (f32x4){0.f, 0.f, 0.f, 0.f};
  {
    const bf16_t* kbase = p.Z + 2048 + h * 64;
    const bf16_t* vtbase = p.VT + (size_t)h * 64 * NTOK;
    const float* rpb_h = p.rpb + (size_t)(l * 8 + h) * 15 * 31;
    const int rs = min(max(r - 4, 0), 8);
    const int band = min(max(j * 16 - 8, 0), 32);
    for (int ch = 0; ch < 4; ++ch) {
      const int kr = rs + 2 * ch;
      const int t0 = NCTX + b * 1024 + kr * 64 + band;
      attn_chunk<true>(qf0, qf1, kbase, INW, vtbase, NTOK, t0, t0 + 16, t0 + 64, t0 + 80, rpb_h, kr - r + 7, band, qc,
                       m, lsum, o, lane);
    }
  }
  {
    const bf16_t* kbase = p.KC + (size_t)((b * 2 + l) * 8 + h) * 16384;
    const bf16_t* vtbase = p.VCT + (size_t)((b * 2 + l) * 8 + h) * 16384;
    for (int ch = 0; ch < 4; ++ch) {
      const int t0 = ch * 64;
      attn_chunk<false>(qf0, qf1, kbase, 64, vtbase, 256, t0, t0 + 16, t0 + 32, t0 + 48, nullptr, 0, 0, 0, m, lsum, o,
                        lane);
    }
  }
  attn_finish(p.YS + (size_t)qtok * 1536 + 512 + h * 64, lsum, o, lane);
}

DI void unpack8(u32x4 u, float (&f)[8]) {
#pragma unroll
  for (int j = 0; j < 4; ++j) {
    f[2 * j] = bf_lo(u[j]);
    f[2 * j + 1] = bf_hi(u[j]);
  }
}
DI u32x4 pack8(const float (&f)[8]) {
  u32x4 o;
#pragma unroll
  for (int j = 0; j < 4; ++j) o[j] = cvt_pk_bf16(f[2 * j], f[2 * j + 1]);
  return o;
}

DI void conv_item(const Params& p, int l, int it) {
  const int t = tidx();
  const int row = it * 8 + (t >> 6), ch = (t & 63) * 8;
  const bf16_t* z = p.Z + (size_t)row * INW;
  float bg[8], a[8], b[8], acc[8];
  unpack8(*(const u32x4*)(z + ch), bg);
  const float* cw = p.conv_w + (size_t)l * 3 * 512 + ch;
  unpack8(*(const u32x4*)(z + 512 + ch), a);
  unpack8(*(const u32x4*)(z + 1024 + ch), b);
#pragma unroll
  for (int j = 0; j < 8; ++j) acc[j] = a[j] * b[j] * cw[512 + j];
  if (!seq_first(row)) {
    unpack8(*(const u32x4*)(z - INW + 512 + ch), a);
    unpack8(*(const u32x4*)(z - INW + 1024 + ch), b);
#pragma unroll
    for (int j = 0; j < 8; ++j) acc[j] += a[j] * b[j] * cw[j];
  }
  if (!seq_last(row)) {
    unpack8(*(const u32x4*)(z + INW + 512 + ch), a);
    unpack8(*(const u32x4*)(z + INW + 1024 + ch), b);
#pragma unroll
    for (int j = 0; j < 8; ++j) acc[j] += a[j] * b[j] * cw[1024 + j];
  }
#pragma unroll
  for (int j = 0; j < 8; ++j) acc[j] *= bg[j];
  *(u32x4*)(p.YS + (size_t)row * 1536 + ch) = pack8(acc);
}

DI void pool_item(const Params& p, int it) {
  const int t = tidx();
  const int row = it * 8 + (t >> 6), ch = (t & 63) * 8;
  const int g = ch >> 7, w = 2 << g;
  int seq0, seqn;
  if (row < NCTX) { seq0 = row & ~255; seqn = 256; } else { seq0 = row & ~1023; seqn = 1024; }
  const int tt = row - seq0;
  const int lo = max(tt - w / 2, 0), hi = min(tt - w / 2 + w, seqn);
  float acc[8], f[8];
#pragma unroll
  for (int j = 0; j < 8; ++j) acc[j] = 0.f;
  for (int q = lo; q < hi; ++q) {
    unpack8(*(const u32x4*)(p.Z + (size_t)(seq0 + q) * INW + 3072 + ch), f);
#pragma unroll
    for (int j = 0; j < 8; ++j) acc[j] += f[j];
  }
  unpack8(*(const u32x4*)(p.Z + (size_t)row * INW + 3072 + ch), f);
  const float inv = 1.f / (float)(hi - lo);
#pragma unroll
  for (int j = 0; j < 8; ++j) acc[j] = acc[j] * inv - f[j];
  *(u32x4*)(p.YS + (size_t)row * 1536 + 1024 + ch) = pack8(acc);
}

DI float gelu_tanh(float x) {
  const float y = 0.7978845608028654f * (x + 0.044715f * x * x * x);
  const float e = __expf(2.f * y);
  const float th = 1.f - 2.f / (e + 1.f);
  return 0.5f * x * (1.f + th);
}
DI void act_item(const Params& p, int l, int it) {
  const int id = it * NTHREADS + tidx();
  const int row = id / 352, ch = (id % 352) * 8;
  const bf16_t* u = p.U + (size_t)row * (2 * DFF);
  const float* cw = p.f_conv + (size_t)l * 3 * DFF + ch;
  float a[8], acc[8], val[8];
  unpack8(*(const u32x4*)(u + ch), a);
#pragma unroll
  for (int j = 0; j < 8; ++j) acc[j] = a[j] * cw[DFF + j];
  if (!seq_first(row)) {
    unpack8(*(const u32x4*)(u - 2 * DFF + ch), a);
#pragma unroll
    for (int j = 0; j < 8; ++j) acc[j] += a[j] * cw[j];
  }
  if (!seq_last(row)) {
    unpack8(*(const u32x4*)(u + 2 * DFF + ch), a);
#pragma unroll
    for (int j = 0; j < 8; ++j) acc[j] += a[j] * cw[2 * DFF + j];
  }
  unpack8(*(const u32x4*)(u + DFF + ch), val);
#pragma unroll
  for (int j = 0; j < 8; ++j) acc[j] = gelu_tanh(acc[j]) * val[j];
  *(u32x4*)(p.ACT + (size_t)row * DFF + ch) = pack8(acc);
}

DI void final_row(const Params& p, int row) {
  const int lane = tidx() & 63;
  const float* xr = p.X + (size_t)row * D;
  f32x4 v[4];
  float ss = 0.f;
#pragma unroll
  for (int i = 0; i < 4; ++i) {
    v[i] = *(const f32x4*)(xr + i * 256 + lane * 4);
    ss += v[i][0] * v[i][0] + v[i][1] * v[i][1] + v[i][2] * v[i][2] + v[i][3] * v[i][3];
  }
  ss = wave_sum(ss);
  const float rstd = rsqrtf(ss * (1.f / 1024.f) + 1e-6f);
#pragma unroll
  for (int i = 0; i < 4; ++i) {
    const int col = i * 256 + lane * 4;
    const f32x4 gg = *(const f32x4*)(p.g_final + col);
    f32x4 o;
#pragma unroll
    for (int j = 0; j < 4; ++j) o[j] = v[i][j] * rstd * gg[j];
    *(f32x4*)(p.out + (size_t)row * D + col) = o;
  }
}

constexpr int N_PHASES = 20;
extern __shared__ __attribute__((aligned(16))) char g_smem[];
#define NI __device__ __forceinline__
constexpr size_t KV_OFF = (size_t)NTOK * D;

NI void ph_prep0(const Params& p) {
  char* smem = g_smem;
  const int nb = gridDim.x, bid = bidx();
  const int total = PREP_ITEMS + MOD_ITEMS + CACHE_ITEMS;
  for (int it = bid; it < total; it += nb) {
    if (it < MOD_ITEMS) mod_item(p, it, (float*)smem);
    else if (it < MOD_ITEMS + CACHE_ITEMS) cache_item(p, it - MOD_ITEMS);
    else prep_item(p, 0, it - MOD_ITEMS - CACHE_ITEMS, (float*)smem);
  }
}
NI void ph_final(const Params& p) {
  const int nb = gridDim.x, bid = bidx(), wid = tidx() >> 6;
  for (int row = bid * NWAVES + wid; row < NTOK; row += nb * NWAVES) final_row(p, row);
}
NI void ph_normmod1(const Params& p, int l) {
  char* smem = g_smem;
  const int nb = gridDim.x, bid = bidx(), wid = tidx() >> 6;
  for (int row = bid * NWAVES + wid; row < NTOK; row += nb * NWAVES)
    normmod_row(p, l, 0, row, l == 0 ? xin_row(p, row) : p.X + (size_t)row * D);
  if (l == 1)
    for (int it = bid; it < PREP_ITEMS; it += nb) prep_item(p, 1, it, (float*)smem);
}
NI void ph_inproj(const Params& p, int l) {
  EpiZ epi{p.Z, p.VT, p.out + KV_OFF, l};
  gemm_phase<false>(p.H, D, p.WIN, D, D, INW, g_smem, epi, nullptr);
}
NI void ph_attn(const Params& p, int l) {
  const int nb = gridDim.x, bid = bidx();
  for (int it = bid; it < 512; it += nb) {
    if (it < 256) attn_lat_item(p, l, it, g_smem);
    else attn_ctx_item(p, it - 256, g_smem);
  }
  __syncthreads();
}
NI void ph_convpool(const Params& p, int l) {
  const int nb = gridDim.x, bid = bidx();
  for (int it = bid; it < 2048; it += nb) {
    if (it < 1024) conv_item(p, l, it);
    else pool_item(p, it - 1024);
  }
}
NI void ph_branch(const Params& p) {
  EpiBf16 epi{p.MERGED, D};
  gemm_phase<true>(p.YS, 1536, p.WB, 1536, 1536, D, g_smem, epi, p.Z + 3584);
}
NI void ph_outproj(const Params& p, int l) {
  EpiResid epi{&p, l, 2048, l == 0};
  gemm_phase<false>(p.MERGED, D, p.WO, D, D, D, g_smem, epi, nullptr);
}
NI void ph_normmod2(const Params& p, int l) {
  const int nb = gridDim.x, bid = bidx(), wid = tidx() >> 6;
  for (int row = bid * NWAVES + wid; row < NTOK; row += nb * NWAVES) normmod_row(p, l, 1, row, p.X + (size_t)row * D);
}
NI void ph_up(const Params& p) {
  EpiBf16 epi{p.U, 2 * DFF};
  gemm_phase<false>(p.H, D, p.WU, D, D, 2 * DFF, g_smem, epi, nullptr);
}
NI void ph_act(const Params& p, int l) {
  const int nb = gridDim.x, bid = bidx();
  for (int it = bid; it < NTOK * 352 / NTHREADS; it += nb) act_item(p, l, it);
}
NI void ph_down(const Params& p, int l) {
  EpiResid epi{&p, l, 5120, false};
  gemm_phase<false>(p.ACT, DFF, p.WD, DFF, DFF, D, g_smem, epi, nullptr);
}

DI void run_phase(const Params& p, int ph) {
  if (ph == 0) { ph_prep0(p); return; }
  if (ph == 19) { ph_final(p); return; }
  const int l = (ph - 1) / 9, s = (ph - 1) % 9;
  switch (s) {
    case 0: ph_normmod1(p, l); break;
    case 1: ph_inproj(p, l); break;
    case 2: ph_attn(p, l); ph_convpool(p, l); break;
    case 3: ph_branch(p); break;
    case 4: ph_outproj(p, l); break;
    case 5: ph_normmod2(p, l); break;
    case 6: ph_up(p); break;
    case 7: ph_act(p, l); break;
    case 8: ph_down(p, l); break;
  }
}


#define XB_TMO      128
#define XB_XCNT(j)  (256  + 64 * (j))
#define XB_XSUB(j)  (1280 + 64 * (j))
#define XB_XGEN(j)  (2304 + 64 * (j))
#define XB_TOP      3328
#define XB_TOPGEN   3392
#define XCD_BAR_WORDS 3456
#define XB_SPIN_CAP (1u << 20)
DI unsigned xb_ld(unsigned* p) { return __hip_atomic_load(p, __ATOMIC_RELAXED, __HIP_MEMORY_SCOPE_AGENT); }
DI unsigned xb_add(unsigned* p, unsigned v) { return __hip_atomic_fetch_add(p, v, __ATOMIC_RELAXED, __HIP_MEMORY_SCOPE_AGENT); }
DI unsigned xb_xcc_id() { return (unsigned)__builtin_amdgcn_s_getreg((3 << 11) | 20) & 0xFu; }
#define XB_SPIN(cond, bar) do { unsigned _sp = 0; while (cond) { __builtin_amdgcn_s_sleep(1); \
    if ((++_sp & 255u) == 0u) { if (xb_ld(&(bar)[XB_TMO])) break; if (_sp > XB_SPIN_CAP) { atomicAdd(&(bar)[XB_TMO], 1u); break; } } } } while (0)
struct XcdBarrier { unsigned* bar; unsigned x, nloc, nx; };
DI XcdBarrier xcd_barrier_post(unsigned* bar) {
  XcdBarrier b; b.bar = bar; b.x = xb_xcc_id(); b.nloc = 0u; b.nx = 0u;
  if (threadIdx.x == 0) (void)xb_add(&bar[XB_XCNT(b.x)], 1u);
  return b;
}
DI void xcd_barrier_complete(unsigned* bar, unsigned x, unsigned& nloc, unsigned& nx) {
  const unsigned G = gridDim.x;
  unsigned sum, cnt, mine, sp = 0u;
  for (;;) {
    sum = 0u; cnt = 0u; mine = 0u;
#pragma unroll
    for (unsigned j = 0; j < 16; ++j) { const unsigned c = xb_ld(&bar[XB_XCNT(j)]); sum += c; cnt += (c > 0u) ? 1u : 0u; mine = (j == x) ? c : mine; }
    if (sum == G) break;
    __builtin_amdgcn_s_sleep(1);
    if ((++sp & 255u) == 0u) { if (xb_ld(&bar[XB_TMO])) break; if (sp > XB_SPIN_CAP) { atomicAdd(&bar[XB_TMO], 1u); break; } }
  }
  nloc = mine > 0u ? mine : 1u; nx = cnt > 0u ? cnt : 1u;
}
DI void xcd_barrier(XcdBarrier& b) {
  asm volatile("s_waitcnt vmcnt(0)" ::: "memory");
  __syncthreads();
  if (threadIdx.x == 0) {
    unsigned* bar = b.bar;
    __builtin_amdgcn_s_waitcnt(0);
    if (b.nloc == 0u) xcd_barrier_complete(bar, b.x, b.nloc, b.nx);
    const unsigned nloc = b.nloc, nx = b.nx;
    const unsigned old = xb_add(&bar[XB_XSUB(b.x)], 1u);
    const unsigned gen = old / nloc;
    if (old + 1u == (gen + 1u) * nloc) {
      __builtin_amdgcn_fence(__ATOMIC_RELEASE, "agent");
      asm volatile("s_waitcnt vmcnt(0)" ::: "memory");
      const unsigned og = xb_add(&bar[XB_TOP], 1u);
      const unsigned tg = og / nx;
      if (og + 1u == (tg + 1u) * nx) xb_add(&bar[XB_TOPGEN], 1u);
      else XB_SPIN(xb_ld(&bar[XB_TOPGEN]) == tg, bar);
      __builtin_amdgcn_fence(__ATOMIC_ACQUIRE, "agent");
      xb_add(&bar[XB_XGEN(b.x)], 1u);
      asm volatile("s_waitcnt vmcnt(0)" ::: "memory");
    } else {
      XB_SPIN(xb_ld(&bar[XB_XGEN(b.x)]) == gen, bar);
      __builtin_amdgcn_fence(__ATOMIC_ACQUIRE, "agent");
      asm volatile("s_waitcnt vmcnt(0)" ::: "memory");
    }
  }
  __syncthreads();
}

__global__ void __launch_bounds__(NTHREADS, 2) mega_kernel(Params p, int ph_lo, int ph_hi) {
  cg::grid_group grid = cg::this_grid();
  XcdBarrier xb = xcd_barrier_post(p.BAR);
#ifndef REPEAT_MASK
#define REPEAT_MASK 0u
#endif
  for (int ph = ph_lo; ph < ph_hi; ++ph) {
    run_phase(p, ph);
    if ((REPEAT_MASK >> ph) & 1u) {
      xcd_barrier(xb);
      run_phase(p, ph);
    }
    if (ph + 1 < ph_hi) xcd_barrier(xb);
  }
  if (ph_hi > 1000) grid.sync();
}

extern "C" void kernel_launch(void* const* d_in, const int* in_sizes, int n_in, void* d_out, int out_size, void* d_ws,
                              size_t ws_size, hipStream_t stream) {
  static int grid_blocks = 0;
  if (!grid_blocks) {
    int dev = 0, cus = 0, per_cu = 0;
    (void)hipGetDevice(&dev);
    (void)hipDeviceGetAttribute(&cus, hipDeviceAttributeMultiprocessorCount, dev);
    (void)hipFuncSetAttribute((const void*)mega_kernel, hipFuncAttributeMaxDynamicSharedMemorySize, LDS_BYTES);
    (void)hipOccupancyMaxActiveBlocksPerMultiprocessor(&per_cu, mega_kernel, NTHREADS, LDS_BYTES);
    if (per_cu < 1) fprintf(stderr, "occupancy query reports %d blocks/CU\n", per_cu);
    grid_blocks = cus;
  }
  Params p{};
  const float** f = (const float**)&p;
  for (int i = 0; i < 20; ++i) f[i] = (const float*)d_in[i];
  p.out = (float*)d_out;
  char* ws = (char*)d_ws;
  size_t off = 0;
  auto take = [&](size_t bytes) { char* r = ws + off; off += (bytes + 255) & ~(size_t)255; return r; };
  p.BAR = (unsigned*)take(XCD_BAR_WORDS * 4);
  p.MOD = (float*)take(2 * 5 * 6144 * 4);
  p.X = (float*)take((size_t)NTOK * D * 4);
  p.KC = (bf16_t*)take((size_t)64 * 16384 * 2);
  p.VCT = (bf16_t*)take((size_t)64 * 16384 * 2);
  p.WIN = (bf16_t*)take((size_t)INW * D * 2);
  p.WB = (bf16_t*)take((size_t)D * 1536 * 2);
  p.WO = (bf16_t*)take((size_t)D * D * 2);
  p.WU = (bf16_t*)take((size_t)2 * DFF * D * 2);
  p.WD = (bf16_t*)take((size_t)D * DFF * 2);
  p.H = (bf16_t*)take((size_t)NTOK * D * 2);
  p.Z = (bf16_t*)take((size_t)NTOK * INW * 2);
  p.U = p.Z;
  char* r2 = take((size_t)NTOK * 1536 * 2 + (size_t)NTOK * D * 2 + (size_t)512 * NTOK * 2);
  p.YS = (bf16_t*)r2;
  p.MERGED = (bf16_t*)(r2 + (size_t)NTOK * 1536 * 2);
  p.VT = (bf16_t*)(r2 + (size_t)NTOK * 1536 * 2 + (size_t)NTOK * D * 2);
  p.ACT = (bf16_t*)r2;
  (void)hipMemsetAsync(p.BAR, 0, XCD_BAR_WORDS * 4, stream);
#ifndef MULTI_LAUNCH
#define MULTI_LAUNCH 0
#endif
#if MULTI_LAUNCH
  for (int ph = 0; ph < N_PHASES; ++ph) mega_kernel<<<dim3(grid_blocks), dim3(NTHREADS), LDS_BYTES, stream>>>(p, ph, ph + 1);
#else
  int lo = 0, hi = N_PHASES;
  void* args[] = {&p, &lo, &hi};
  hipError_t e = hipLaunchCooperativeKernel((void*)mega_kernel, dim3(grid_blocks), dim3(NTHREADS), args, LDS_BYTES, stream);
  if (e != hipSuccess) fprintf(stderr, "cooperative launch failed: %s (grid %d)\n", hipGetErrorString(e), grid_blocks);
#endif
}
```

```cpp
#include <hip/hip_runtime.h>
#include <hip/hip_cooperative_groups.h>
#include <cstdio>
namespace cg = cooperative_groups;

typedef unsigned short bf16_t;
typedef short bf16x8 __attribute__((ext_vector_type(8)));
typedef float f32x4 __attribute__((ext_vector_type(4)));
typedef unsigned u32x4 __attribute__((ext_vector_type(4)));
typedef unsigned u32x2 __attribute__((ext_vector_type(2)));

#define DI __device__ __forceinline__
DI int tidx() { int t = threadIdx.x; asm volatile("" : "+v"(t)); return t; }
DI int bidx() { int b = blockIdx.x; asm volatile("" : "+s"(b)); return b; }

constexpr int D = 1024, NTOK = 8192, NCTX = 4096, INW = 6656, DFF = 2816;
constexpr int NTHREADS = 512, NWAVES = 8;
constexpr int LDS_BYTES = 147456;

struct Params {
  const float *x_prompt, *x_sample, *cache_kv, *c, *c_ctx, *w_mod, *b_mod, *g1, *g2, *w_in, *conv_w, *rpb, *pool_w,
      *pool_scale, *w_branch, *w_out, *w_up, *f_conv, *w_down, *g_final;
  float* out;
  float* MOD;
  float* X;
  unsigned* BAR;
  bf16_t *KC, *VCT, *WIN, *WB, *WO, *WU, *WD, *H, *Z, *U, *YS, *MERGED, *VT, *ACT;
};

typedef float f32x2 __attribute__((ext_vector_type(2)));
typedef __bf16 bf16x2_t __attribute__((ext_vector_type(2)));
DI unsigned cvt_pk_bf16(float lo, float hi) {
  const f32x2 v = {lo, hi};
  return __builtin_bit_cast(unsigned, __builtin_convertvector(v, bf16x2_t));
}
DI float bf_lo(unsigned u) { return __uint_as_float(u << 16); }
DI float bf_hi(unsigned u) { return __uint_as_float(u & 0xffff0000u); }
DI float wave_sum(float v) {
#pragma unroll
  for (int o = 32; o > 0; o >>= 1) v += __shfl_xor(v, o);
  return v;
}
DI const float* xin_row(const Params& p, int row) {
  return row < NCTX ? p.x_prompt + (size_t)row * D : p.x_sample + (size_t)(row - NCTX) * D;
}
DI int vec_of_row(int row) { return row < NCTX ? 0 : 1 + ((row - NCTX) >> 10); }
DI bool seq_first(int row) { return row < NCTX ? ((row & 255) == 0) : ((row & 1023) == 0); }
DI bool seq_last(int row) { return row < NCTX ? ((row & 255) == 255) : ((row & 1023) == 1023); }

DI void transpose_tile(const float* __restrict__ src, int srcld, bf16_t* __restrict__ dst, int dstld, int kt, int nt,
                       float* sm) {
  const int t = tidx();
  const float* s = src + (size_t)(kt * 128) * srcld + nt * 64;
#pragma unroll
  for (int i = 0; i < 4; ++i) {
    const int row = (t >> 4) + 32 * i, c4 = (t & 15) * 4;
    const f32x4 v = *(const f32x4*)(s + (size_t)row * srcld + c4);
    sm[row * 65 + c4 + 0] = v[0];
    sm[row * 65 + c4 + 1] = v[1];
    sm[row * 65 + c4 + 2] = v[2];
    sm[row * 65 + c4 + 3] = v[3];
  }
  __syncthreads();
  const int n = t >> 3, ks = (t & 7) * 16;
  u32x4 w0, w1;
#pragma unroll
  for (int j = 0; j < 4; ++j) {
    w0[j] = cvt_pk_bf16(sm[(ks + 2 * j) * 65 + n], sm[(ks + 2 * j + 1) * 65 + n]);
    w1[j] = cvt_pk_bf16(sm[(ks + 8 + 2 * j) * 65 + n], sm[(ks + 8 + 2 * j + 1) * 65 + n]);
  }
  bf16_t* d = dst + (size_t)(nt * 64 + n) * dstld + kt * 128 + ks;
  *(u32x4*)d = w0;
  *(u32x4*)(d + 8) = w1;
  __syncthreads();
}

constexpr int PREP_T_IN = 8 * 104, PREP_T_BR = 2 * 4 * 16, PREP_T_OUT = 8 * 16, PREP_T_UP = 8 * 88,
              PREP_T_DN = 22 * 16, PREP_WEFF = 128;
constexpr int PREP_ITEMS = PREP_T_IN + PREP_T_BR + PREP_T_OUT + PREP_T_UP + PREP_T_DN + PREP_WEFF;

DI void prep_transposes(const Params& p, int l, int it, float* sm) {
  if (it < PREP_T_IN) {
    transpose_tile(p.w_in + (size_t)l * D * INW, INW, p.WIN, D, it / 104, it % 104, sm);
    return;
  }
  it -= PREP_T_IN;
  if (it < PREP_T_BR) {
    const int i = it >> 6, r = it & 63;
    transpose_tile(p.w_branch + (size_t)(l * 3 + i) * 512 * D, D, p.WB + i * 512, 1536, r >> 4, r & 15, sm);
    return;
  }
  it -= PREP_T_BR;
  if (it < PREP_T_OUT) {
    transpose_tile(p.w_out + (size_t)l * D * D, D, p.WO, D, it >> 4, it & 15, sm);
    return;
  }
  it -= PREP_T_OUT;
  if (it < PREP_T_UP) {
    transpose_tile(p.w_up + (size_t)l * D * 2 * DFF, 2 * DFF, p.WU, D, it / 88, it % 88, sm);
    return;
  }
  it -= PREP_T_UP;
  if (it < PREP_T_DN) {
    transpose_tile(p.w_down + (size_t)l * DFF * D, D, p.WD, DFF, it >> 4, it & 15, sm);
    return;
  }
}

DI void prep_item(const Params& p, int l, int it, float* sm) {
  if (it < PREP_WEFF) {
    const int g = it >> 5, cb = (it >> 1) & 15, db = it & 1;
    const int t = tidx();
    const int dd = db * 512 + t;
    const float* wb2 = p.w_branch + (size_t)(l * 3 + 2) * 512 * D + (size_t)(g * 128) * D + dd;
    for (int i = t; i < 1024; i += NTHREADS) {
      const int e = i >> 3, c = i & 7;
      sm[i] = p.pool_w[((size_t)(l * 4 + g) * 128 + cb * 8 + c) * 128 + e] * p.pool_scale[l * 512 + g * 128 + e];
    }
    __syncthreads();
    float acc[8];
#pragma unroll
    for (int c = 0; c < 8; ++c) acc[c] = 0.f;
#pragma unroll 16
    for (int e = 0; e < 128; ++e) {
      const float w = wb2[(size_t)e * D];
      const f32x4 s0 = *(const f32x4*)(sm + e * 8), s1 = *(const f32x4*)(sm + e * 8 + 4);
#pragma unroll
      for (int c = 0; c < 4; ++c) { acc[c] += s0[c] * w; acc[4 + c] += s1[c] * w; }
    }
    u32x4 o;
#pragma unroll
    for (int j = 0; j < 4; ++j) o[j] = cvt_pk_bf16(acc[2 * j], acc[2 * j + 1]);
    *(u32x4*)(p.WB + (size_t)dd * 1536 + 1024 + g * 128 + cb * 8) = o;
    __syncthreads();
  }
  else {
    it -= PREP_WEFF;
    prep_transposes(p, l, it, sm);
  }
}

constexpr int MOD_ITEMS = 2 * 96;
DI void mod_item(const Params& p, int it, float* sm) {
  const int t = tidx();
  const int l = it / 96, cb = it % 96;
  float* red = sm + 5 * 1024;
  for (int i = t; i < 5 * 1024; i += NTHREADS) {
    const int v = i >> 10, k = i & 1023;
    const float cv = (v == 0) ? p.c_ctx[k] : p.c[(v - 1) * D + k];
    sm[i] = cv / (1.f + __expf(-cv));
  }
  __syncthreads();
  const int kg = t >> 4, ct = t & 15;
  f32x4 acc[5];
#pragma unroll
  for (int v = 0; v < 5; ++v) acc[v] = (f32x4){0.f, 0.f, 0.f, 0.f};
  const float* w = p.w_mod + ((size_t)l * D + kg * 32) * 6144 + cb * 64 + ct * 4;
#pragma unroll 8
  for (int kk = 0; kk < 32; ++kk) {
    const f32x4 wv = *(const f32x4*)(w + (size_t)kk * 6144);
#pragma unroll
    for (int v = 0; v < 5; ++v) acc[v] += sm[v * 1024 + kg * 32 + kk] * wv;
  }
#pragma unroll
  for (int v = 0; v < 5; ++v)
#pragma unroll
    for (int j = 0; j < 4; ++j) red[(kg * 5 + v) * 64 + ct * 4 + j] = acc[v][j];
  __syncthreads();
  for (int i = t; i < 320; i += NTHREADS) {
    const int v = i >> 6, c = i & 63;
    float s = p.b_mod[l * 6144 + cb * 64 + c];
#pragma unroll
    for (int g = 0; g < 32; ++g) s += red[(g * 5 + v) * 64 + c];
    p.MOD[(size_t)(l * 5 + v) * 6144 + cb * 64 + c] = s;
  }
  __syncthreads();
}

constexpr int CACHE_ITEMS = 32;
DI void cache_item(const Params& p, int it) {
  const int t = tidx() & 255;
  it = it * 2 + (tidx() >> 8);
  const int b = it >> 4, l = (it >> 3) & 1, h = it & 7;
  const float* ks = p.cache_kv + ((size_t)(((b * 2 + l) * 2 + 0) * 8 + h)) * 16384;
  const float* vs = p.cache_kv + ((size_t)(((b * 2 + l) * 2 + 1) * 8 + h)) * 16384;
  bf16_t* kd = p.KC + (size_t)((b * 2 + l) * 8 + h) * 16384;
  bf16_t* vd = p.VCT + (size_t)((b * 2 + l) * 8 + h) * 16384;
#pragma unroll 4
  for (int i = 0; i < 16; ++i) {
    const int e = (i * 256 + t) * 4;
    const f32x4 v = *(const f32x4*)(ks + e);
    u32x2 o;
    o[0] = cvt_pk_bf16(v[0], v[1]);
    o[1] = cvt_pk_bf16(v[2], v[3]);
    *(u32x2*)(kd + e) = o;
  }
#pragma unroll 4
  for (int d = 0; d < 64; d += 4) {
    const f32x4 v = *(const f32x4*)(vs + t * 64 + d);
#pragma unroll
    for (int j = 0; j < 4; ++j) vd[(d + j) * 256 + t] = (bf16_t)(cvt_pk_bf16(v[j], 0.f) & 0xffffu);
  }
}

DI void normmod_row(const Params& p, int l, int which, int row, const float* xr) {
  const int lane = tidx() & 63;
  f32x4 v[4];
  float ss = 0.f;
#pragma unroll
  for (int i = 0; i < 4; ++i) {
    v[i] = *(const f32x4*)(xr + i * 256 + lane * 4);
    ss += v[i][0] * v[i][0] + v[i][1] * v[i][1] + v[i][2] * v[i][2] + v[i][3] * v[i][3];
  }
  ss = wave_sum(ss);
  const float rstd = rsqrtf(ss * (1.f / 1024.f) + 1e-6f);
  const float* g = (which == 0 ? p.g1 : p.g2) + l * D;
  const float* mod = p.MOD + (size_t)(l * 5 + vec_of_row(row)) * 6144 + which * 3072;
#pragma unroll
  for (int i = 0; i < 4; ++i) {
    const int col = i * 256 + lane * 4;
    const f32x4 gg = *(const f32x4*)(g + col);
    const f32x4 sh = *(const f32x4*)(mod + col);
    const f32x4 sc = *(const f32x4*)(mod + 1024 + col);
    f32x4 h;
#pragma unroll
    for (int j = 0; j < 4; ++j) h[j] = v[i][j] * rstd * gg[j] * (1.f + sc[j]) + sh[j];
    u32x2 o;
    o[0] = cvt_pk_bf16(h[0], h[1]);
    o[1] = cvt_pk_bf16(h[2], h[3]);
    *(u32x2*)(p.H + (size_t)row * D + col) = o;
  }
}

constexpr int STAGE_BYTES = 49152;
#ifdef EXP_B
#define EXP_B_EXTRA gemm_stage<256>(A, lda, (4 * x + (pj & 3)) * 256, pt * 64, dst, tid); gemm_stage<128>(Bt, ldb, (pj >> 2) * 128, pt * 64, dst + 32768, tid);
#define VM_STAGE "12"
#else
#define EXP_B_EXTRA
#define VM_STAGE "6"
#endif
template <int ROWS>
DI void gemm_stage(const bf16_t* __restrict__ A, int lda, int row0, int k0, char* s, int t) {
  const int cp = t & 7, rr = t >> 3, c = cp ^ (rr & 7);
#pragma unroll
  for (int i = 0; i < ROWS / 64; ++i)
    __builtin_amdgcn_global_load_lds((const unsigned*)(A + (size_t)(row0 + rr + 64 * i) * lda + k0 + c * 8),
                                     (unsigned*)(s + t * 16 + i * 8192), 16, 0, 0);
}
DI void gemm_compute(const char* sA, const char* sB, f32x4 (&acc)[4][4], int wm, int wn, int lane) {
  const int fr = lane & 15, fq = lane >> 4;
#pragma unroll
  for (int ks = 0; ks < 2; ++ks) {
    bf16x8 a[4], b[4];
    const int sw = ((ks * 4 + fq) ^ (fr & 7)) << 4;
#pragma unroll
    for (int ni = 0; ni < 4; ++ni) b[ni] = *(const bf16x8*)(sB + (wn * 64 + ni * 16 + fr) * 128 + sw);
#pragma unroll
    for (int mi = 0; mi < 4; ++mi) a[mi] = *(const bf16x8*)(sA + (wm * 64 + mi * 16 + fr) * 128 + sw);
    __builtin_amdgcn_sched_barrier(0);
#pragma unroll
    for (int mi = 0; mi < 4; ++mi)
#pragma unroll
      for (int ni = 0; ni < 4; ++ni)
        acc[mi][ni] = __builtin_amdgcn_mfma_f32_16x16x32_bf16(b[ni], a[mi], acc[mi][ni], 0, 0, 0);
    __builtin_amdgcn_sched_barrier(0);
  }
}

template <bool GATED, class Epi>
DI void gemm_phase(const bf16_t* __restrict__ A, int lda, const bf16_t* __restrict__ Bt, int ldb, int K, int N,
                   char* smem, const Epi& epi, const bf16_t* gates) {
  const int tid = tidx();
  const int wid = tid >> 6, lane = tid & 63, wm = wid >> 1, wn = wid & 1;
  const int fr = lane & 15, fq = lane >> 4;
  const int bid = bidx(), nb = gridDim.x;
  const int nN = N >> 7, nt = K >> 6;
  const int x = bid & 7, per_x = 4 * nN, cstep = nb >> 3;
  int pj = bid >> 3, pt = 0, ps = 0;
#define GEMM_ISSUE()                                                                                          \
  do {                                                                                                        \
    if (pj < per_x) {                                                                                         \
      char* dst = smem + ps * STAGE_BYTES;                                                                    \
      gemm_stage<256>(A, lda, (4 * x + (pj & 3)) * 256, pt * 64, dst, tid);                                   \
      gemm_stage<128>(Bt, ldb, (pj >> 2) * 128, pt * 64, dst + 32768, tid);                                   \
      EXP_B_EXTRA                                                                                             \
      if (++pt == nt) { pt = 0; pj += cstep; }                                                                \
      ps = (ps == 2) ? 0 : ps + 1;                                                                            \
    }                                                                                                         \
  } while (0)
  GEMM_ISSUE();
  GEMM_ISSUE();
  int cs = 0;
  for (int cj = bid >> 3; cj < per_x; cj += cstep) {
    const int row0 = (4 * x + (cj & 3)) * 256, col0 = (cj >> 2) * 128;
    f32x4 acc[4][4];
    f32x4 tot[4][4];
#pragma unroll
    for (int mi = 0; mi < 4; ++mi)
#pragma unroll
      for (int ni = 0; ni < 4; ++ni) {
        acc[mi][ni] = (f32x4){0.f, 0.f, 0.f, 0.f};
        if (GATED) tot[mi][ni] = (f32x4){0.f, 0.f, 0.f, 0.f};
      }
    const bool last_tile = cj + cstep >= per_x;
    for (int t = 0; t < nt; ++t) {
      if (last_tile && t == nt - 1) asm volatile("s_waitcnt vmcnt(0)" ::: "memory");
      else asm volatile("s_waitcnt vmcnt(" VM_STAGE ")" ::: "memory");
      __builtin_amdgcn_s_barrier();
      GEMM_ISSUE();
      const char* cur = smem + cs * STAGE_BYTES;
      gemm_compute(cur, cur + 32768, acc, wm, wn, lane);
      cs = (cs == 2) ? 0 : cs + 1;
      if (GATED && ((t & 7) == 7)) {
        const int seg = t >> 3;
        int gofs = (row0 + wm * 64 + fr) * INW + seg * 1024 + col0 + wn * 64 + fq * 4;
        asm volatile("" : "+v"(gofs));
#pragma unroll
        for (int mi = 0; mi < 4; ++mi)
#pragma unroll
          for (int ni = 0; ni < 4; ++ni) {
            const u32x2 g = *(const u32x2*)(gates + (gofs + mi * 16 * INW + ni * 16));
            tot[mi][ni][0] += bf_lo(g[0]) * acc[mi][ni][0];
            tot[mi][ni][1] += bf_hi(g[0]) * acc[mi][ni][1];
            tot[mi][ni][2] += bf_lo(g[1]) * acc[mi][ni][2];
            tot[mi][ni][3] += bf_hi(g[1]) * acc[mi][ni][3];
            acc[mi][ni] = (f32x4){0.f, 0.f, 0.f, 0.f};
          }
      }
    }
#pragma unroll
    for (int mi = 0; mi < 4; ++mi)
#pragma unroll
      for (int ni = 0; ni < 4; ++ni) {
        const int row = row0 + wm * 64 + mi * 16 + fr, col = col0 + wn * 64 + ni * 16 + fq * 4;
        epi(row, col, GATED ? tot[mi][ni] : acc[mi][ni]);
      }
  }
#undef GEMM_ISSUE
  __syncthreads();
}

DI void store_bf16x4(bf16_t* d, f32x4 v) {
  u32x2 o;
  o[0] = cvt_pk_bf16(v[0], v[1]);
  o[1] = cvt_pk_bf16(v[2], v[3]);
  *(u32x2*)d = o;
}

struct EpiZ {
  bf16_t* Z; bf16_t* VT; float* kv; int l;
  DI void operator()(int row, int col, f32x4 v) const {
    if (col >= 3584) {
#pragma unroll
      for (int j = 0; j < 4; ++j) v[j] = 1.f / (1.f + __expf(-v[j]));
    }
    store_bf16x4(Z + (size_t)row * INW + col, v);
    if (col >= 2048 && col < 3072) {
      const int which = (col - 2048) >> 9, hd = (col - 2048) & 511;
      if (row < NCTX) {
        const int b = row >> 8, s = row & 255, hh = hd >> 6, d = hd & 63;
        *(f32x4*)(kv + ((size_t)((((b * 2 + l) * 2 + which) * 8 + hh) * 256 + s)) * 64 + d) = v;
      }
      if (which == 1) {
#pragma unroll
        for (int j = 0; j < 4; ++j)
          VT[(((size_t)(hd >> 6) * 256 + (row >> 5)) * 64 + (hd & 63) + j) * 32 + (row & 31)] = (bf16_t)(cvt_pk_bf16(v[j], 0.f) & 0xffffu);
      }
    }
  }
};
struct EpiBf16 {
  bf16_t* O; int ld;
  DI void operator()(int row, int col, f32x4 v) const { store_bf16x4(O + (size_t)row * ld + col, v); }
};
struct EpiResid {
  const Params* p; int l; int gate_off; bool from_input;
  DI void operator()(int row, int col, f32x4 v) const {
    const float* xi = from_input ? xin_row(*p, row) + col : p->X + (size_t)row * D + col;
    const f32x4 x = *(const f32x4*)xi;
    const f32x4 g = *(const f32x4*)(p->MOD + (size_t)(l * 5 + vec_of_row(row)) * 6144 + gate_off + col);
    f32x4 o;
#pragma unroll
    for (int j = 0; j < 4; ++j) o[j] = x[j] + g[j] * v[j];
    *(f32x4*)(p->X + (size_t)row * D + col) = o;
  }
};

template <bool LATBIAS>
DI void attn_chunk(const bf16x8 qf0, const bf16x8 qf1, const bf16_t* __restrict__ kbase, int kstride,
                   const bf16_t* __restrict__ vtbase, int vstride, int tk0, int tk1, int tk2, int tk3,
                   const float* __restrict__ rpb_h, int dr0, int band, int qc, float& m, float& lsum,
                   f32x4 (&o)[4], int lane) {
  const int fr = lane & 15, fq = lane >> 4;
  f32x4 s[4];
#pragma unroll
  for (int T = 0; T < 4; ++T) {
    const int tk = (T == 0 ? tk0 : T == 1 ? tk1 : T == 2 ? tk2 : tk3);
    const bf16_t* kp = kbase + (size_t)(tk + fr) * kstride + fq * 8;
    const bf16x8 k0 = *(const bf16x8*)kp;
    const bf16x8 k1 = *(const bf16x8*)(kp + 32);
    f32x4 z = (f32x4){0.f, 0.f, 0.f, 0.f};
    z = __builtin_amdgcn_mfma_f32_16x16x32_bf16(k0, qf0, z, 0, 0, 0);
    z = __builtin_amdgcn_mfma_f32_16x16x32_bf16(k1, qf1, z, 0, 0, 0);
    s[T] = z;
  }
  float cmax = -INFINITY;
#pragma unroll
  for (int T = 0; T < 4; ++T) {
#pragma unroll
    for (int j = 0; j < 4; ++j) {
      float v = s[T][j] * 0.125f;
      if (LATBIAS) {
        const int kc = band + (T & 1) * 16 + fq * 4 + j;
        const int cs = min(max(qc - 8, 0), 48);
        const bool valid = (kc >= cs) && (kc < cs + 16);
        const int dr = dr0 + (T >> 1);
        const int dc = min(max(kc - qc + 15, 0), 30);
        v = valid ? v + rpb_h[dr * 31 + dc] : -INFINITY;
      }
      s[T][j] = v;
      cmax = fmaxf(cmax, v);
    }
  }
  cmax = fmaxf(cmax, __shfl_xor(cmax, 16));
  cmax = fmaxf(cmax, __shfl_xor(cmax, 32));
  const float mnew = fmaxf(m, cmax);
  const float alpha = __expf(m - mnew);
  m = mnew;
  float ps = 0.f;
#pragma unroll
  for (int T = 0; T < 4; ++T)
#pragma unroll
    for (int j = 0; j < 4; ++j) {
      const float pv = __expf(s[T][j] - mnew);
      s[T][j] = pv;
      ps += pv;
    }
  lsum = lsum * alpha + ps;
#pragma unroll
  for (int dt = 0; dt < 4; ++dt) o[dt] *= alpha;
#pragma unroll
  for (int pr = 0; pr < 2; ++pr) {
    u32x4 pk;
    pk[0] = cvt_pk_bf16(s[2 * pr][0], s[2 * pr][1]);
    pk[1] = cvt_pk_bf16(s[2 * pr][2], s[2 * pr][3]);
    pk[2] = cvt_pk_bf16(s[2 * pr + 1][0], s[2 * pr + 1][1]);
    pk[3] = cvt_pk_bf16(s[2 * pr + 1][2], s[2 * pr + 1][3]);
    const bf16x8 pa = __builtin_bit_cast(bf16x8, pk);
    const int ta = (pr == 0 ? tk0 : tk2) + fq * 4, tb = (pr == 0 ? tk1 : tk3) + fq * 4;
#pragma unroll
    for (int dt = 0; dt < 4; ++dt) {
      const bf16_t* vp = vtbase + (dt * 16 + fr) * 32;
      const u32x2 lo = *(const u32x2*)(vp + (size_t)(ta >> 5) * 2048 + (ta & 31));
      const u32x2 hi = *(const u32x2*)(vp + (size_t)(tb >> 5) * 2048 + (tb & 31));
      u32x4 vv;
      vv[0] = lo[0]; vv[1] = lo[1]; vv[2] = hi[0]; vv[3] = hi[1];
      o[dt] = __builtin_amdgcn_mfma_f32_16x16x32_bf16(__builtin_bit_cast(bf16x8, vv), pa, o[dt], 0, 0, 0);
    }
  }
}

DI void attn_finish(bf16_t* ys_row, float lsum, const f32x4 (&o)[4], int lane) {
  const int fq = lane >> 4;
  lsum += __shfl_xor(lsum, 16);
  lsum += __shfl_xor(lsum, 32);
  const float inv = 1.f / lsum;
#pragma unroll
  for (int dt = 0; dt < 4; ++dt) store_bf16x4(ys_row + dt * 16 + fq * 4, o[dt] * inv);
}

constexpr int ATT_VROW = 528, ATT_SV_OFF = 32768;
template <bool VTILED>
DI void attn_stage_kv(const bf16_t* __restrict__ kbase, int kstride, int ktok0, const bf16_t* __restrict__ vtbase,
                      int vstride, int vtok0, char* smem, int tid) {
  gemm_stage<256>(kbase, kstride, ktok0, 0, smem, tid);
  const int d = tid >> 3, seg = tid & 7;
  const bf16_t* vp = VTILED ? vtbase + ((size_t)((vtok0 >> 5) + seg) * 64 + d) * 32
                            : vtbase + (size_t)d * vstride + vtok0 + seg * 32;
  char* dst = smem + ATT_SV_OFF + d * ATT_VROW + seg * 64;
#pragma unroll
  for (int i = 0; i < 4; ++i) *(u32x4*)(dst + i * 16) = *(const u32x4*)(vp + i * 8);
}
DI void attn_chunk_lds(const bf16x8 qf0, const bf16x8 qf1, const char* sK, const char* sV, int t0, float& m,
                       float& lsum, f32x4 (&o)[4], int lane) {
  const int fr = lane & 15, fq = lane >> 4;
  f32x4 s[4];
#pragma unroll
  for (int T = 0; T < 4; ++T) {
    const char* kp = sK + (t0 + T * 16 + fr) * 128;
    const bf16x8 k0 = *(const bf16x8*)(kp + ((fq ^ (fr & 7)) << 4));
    const bf16x8 k1 = *(const bf16x8*)(kp + (((4 + fq) ^ (fr & 7)) << 4));
    f32x4 z = (f32x4){0.f, 0.f, 0.f, 0.f};
    z = __builtin_amdgcn_mfma_f32_16x16x32_bf16(k0, qf0, z, 0, 0, 0);
    z = __builtin_amdgcn_mfma_f32_16x16x32_bf16(k1, qf1, z, 0, 0, 0);
    s[T] = z;
  }
  float cmax = -INFINITY;
#pragma unroll
  for (int T = 0; T < 4; ++T)
#pragma unroll
    for (int j = 0; j < 4; ++j) {
      s[T][j] *= 0.125f;
      cmax = fmaxf(cmax, s[T][j]);
    }
  cmax = fmaxf(cmax, __shfl_xor(cmax, 16));
  cmax = fmaxf(cmax, __shfl_xor(cmax, 32));
  const float mnew = fmaxf(m, cmax);
  const float alpha = __expf(m - mnew);
  m = mnew;
  float ps = 0.f;
#pragma unroll
  for (int T = 0; T < 4; ++T)
#pragma unroll
    for (int j = 0; j < 4; ++j) {
      const float pv = __expf(s[T][j] - mnew);
      s[T][j] = pv;
      ps += pv;
    }
  lsum = lsum * alpha + ps;
#pragma unroll
  for (int dt = 0; dt < 4; ++dt) o[dt] *= alpha;
#pragma unroll
  for (int pr = 0; pr < 2; ++pr) {
    u32x4 pk;
    pk[0] = cvt_pk_bf16(s[2 * pr][0], s[2 * pr][1]);
    pk[1] = cvt_pk_bf16(s[2 * pr][2], s[2 * pr][3]);
    pk[2] = cvt_pk_bf16(s[2 * pr + 1][0], s[2 * pr + 1][1]);
    pk[3] = cvt_pk_bf16(s[2 * pr + 1][2], s[2 * pr + 1][3]);
    const bf16x8 pa = __builtin_bit_cast(bf16x8, pk);
#pragma unroll
    for (int dt = 0; dt < 4; ++dt) {
      const char* vp = sV + (dt * 16 + fr) * ATT_VROW + (t0 + pr * 32 + fq * 4) * 2;
      const u32x2 lo = *(const u32x2*)vp;
      const u32x2 hi = *(const u32x2*)(vp + 32);
      u32x4 vv;
      vv[0] = lo[0]; vv[1] = lo[1]; vv[2] = hi[0]; vv[3] = hi[1];
      o[dt] = __builtin_amdgcn_mfma_f32_16x16x32_bf16(__builtin_bit_cast(bf16x8, vv), pa, o[dt], 0, 0, 0);
    }
  }
}

DI void attn_ctx_item(const Params& p, int it, char* smem) {
  const int tid = tidx(), wid = tid >> 6, lane = tid & 63;
  const int b = it >> 4, h = (it >> 1) & 7, qt = (it & 1) * 8 + wid;
  const int fr = lane & 15, fq = lane >> 4;
  __syncthreads();
  attn_stage_kv<true>(p.Z + 2048 + h * 64, INW, b * 256, p.VT + (size_t)h * 256 * 2048, NTOK, b * 256, smem, tid);
  const int qtok = b * 256 + qt * 16 + fr;
  const bf16_t* qp = p.Z + (size_t)qtok * INW + 1536 + h * 64 + fq * 8;
  const bf16x8 qf0 = *(const bf16x8*)qp, qf1 = *(const bf16x8*)(qp + 32);
  float m = -INFINITY, lsum = 0.f;
  f32x4 o[4];
#pragma unroll
  for (int dt = 0; dt < 4; ++dt) o[dt] = (f32x4){0.f, 0.f, 0.f, 0.f};
  __syncthreads();
  for (int ch = 0; ch < 4; ++ch) attn_chunk_lds(qf0, qf1, smem, smem + ATT_SV_OFF, ch * 64, m, lsum, o, lane);
  attn_finish(p.YS + (size_t)qtok * 1536 + 512 + h * 64, lsum, o, lane);
}

DI void attn_lat_item(const Params& p, int l, int it, char* smem) {
  const int tid = tidx(), wid = tid >> 6, lane = tid & 63;
  const int b = it >> 6, h = (it >> 3) & 7, r = (it & 7) * 2 + (wid >> 2), j = wid & 3;
  const int fr = lane & 15, fq = lane >> 4;
  __syncthreads();
  {
    const size_t cb = (size_t)((b * 2 + l) * 8 + h) * 16384;
    attn_stage_kv<false>(p.KC + cb, 64, 0, p.VCT + cb, 256, 0, smem, tid);
  }
  const int qc = j * 16 + fr;
  const int qtok = NCTX + b * 1024 + r * 64 + qc;
  const bf16_t* qp = p.Z + (size_t)qtok * INW + 1536 + h * 64 + fq * 8;
  const bf16x8 qf0 = *(const bf16x8*)qp, qf1 = *(const bf16x8*)(qp + 32);
  float m = -INFINITY, lsum = 0.f;
  f32x4 o[4];
#pragma unroll
  for (int dt = 0; dt < 4; ++dt) o[dt] = (f32x4){0.f, 0.f, 0.f, 0.f};
  {
    const bf16_t* kbase = p.Z + 2048 + h * 64;
    const bf16_t* vtbase = p.VT + (size_t)h * 256 * 2048;
    const float* rpb_h = p.rpb + (size_t)(l * 8 + h) * 15 * 31;
    const int rs = min(max(r - 4, 0), 8);
    const int band = min(max(j * 16 - 8, 0), 32);
    for (int ch = 0; ch < 4; ++ch) {
      const int kr = rs + 2 * ch;
      const int t0 = NCTX + b * 1024 + kr * 64 + band;
      attn_chunk<true>(qf0, qf1, kbase, INW, vtbase, NTOK, t0, t0 + 16, t0 + 64, t0 + 80, rpb_h, kr - r + 7, band, qc,
                       m, lsum, o, lane);
    }
  }
  __syncthreads();
  for (int ch = 0; ch < 4; ++ch) attn_chunk_lds(qf0, qf1, smem, smem + ATT_SV_OFF, ch * 64, m, lsum, o, lane);
  attn_finish(p.YS + (size_t)qtok * 1536 + 512 + h * 64, lsum, o, lane);
}

DI void attn_ctx_unit(const Params& p, int u, int lane) {
  const int b = u >> 7, h = (u >> 4) & 7, qt = u & 15;
  const int fr = lane & 15, fq = lane >> 4;
  const int qtok = b * 256 + qt * 16 + fr;
  const bf16_t* qp = p.Z + (size_t)qtok * INW + 1536 + h * 64 + fq * 8;
  const bf16x8 qf0 = *(const bf16x8*)qp, qf1 = *(const bf16x8*)(qp + 32);
  const bf16_t* kbase = p.Z + 2048 + h * 64;
  const bf16_t* vtbase = p.VT + (size_t)h * 64 * NTOK;
  float m = -INFINITY, lsum = 0.f;
  f32x4 o[4];
#pragma unroll
  for (int dt = 0; dt < 4; ++dt) o[dt] = (f32x4){0.f, 0.f, 0.f, 0.f};
  for (int ch = 0; ch < 4; ++ch) {
    const int t0 = b * 256 + ch * 64;
    attn_chunk<false>(qf0, qf1, kbase, INW, vtbase, NTOK, t0, t0 + 16, t0 + 32, t0 + 48, nullptr, 0, 0, 0, m, lsum, o,
                      lane);
  }
  attn_finish(p.YS + (size_t)qtok * 1536 + 512 + h * 64, lsum, o, lane);
}

DI void attn_lat_unit(const Params& p, int l, int u, int lane) {
  const int b = u >> 9, h = (u >> 6) & 7, r = (u >> 2) & 15, j = u & 3;
  const int fr = lane & 15, fq = lane >> 4;
  const int qc = j * 16 + fr;
  const int qtok = NCTX + b * 1024 + r * 64 + qc;
  const bf16_t* qp = p.Z + (size_t)qtok * INW + 1536 + h * 64 + fq * 8;
  const bf16x8 qf0 = *(const bf16x8*)qp, qf1 = *(const bf16x8*)(qp + 32);
  float m = -INFINITY, lsum = 0.f;
  f32x4 o[4];
#pragma unroll
  for (int dt = 0; dt < 4; ++dt) o[dt] = (f32x4){0.f, 0.f, 0.f, 0.f};
  {
    const bf16_t* kbase = p.Z + 2048 + h * 64;
    const bf16_t* vtbase = p.VT + (size_t)h * 64 * NTOK;
    const float* rpb_h = p.rpb + (size_t)(l * 8 + h) * 15 * 31;
    const int rs = min(max(r - 4, 0), 8);
    const int band = min(max(j * 16 - 8, 0), 32);
    for (int ch = 0; ch < 4; ++ch) {
      const int kr = rs + 2 * ch;
      const int t0 = NCTX + b * 1024 + kr * 64 + band;
      attn_chunk<true>(qf0, qf1, kbase, INW, vtbase, NTOK, t0, t0 + 16, t0 + 64, t0 + 80, rpb_h, kr - r + 7, band, qc,
                       m, lsum, o, lane);
    }
  }
  {
    const bf16_t* kbase = p.KC + (size_t)((b * 2 + l) * 8 + h) * 16384;
    const bf16_t* vtbase = p.VCT + (size_t)((b * 2 + l) * 8 + h) * 16384;
    for (int ch = 0; ch < 4; ++ch) {
      const int t0 = ch * 64;
      attn_chunk<false>(qf0, qf1, kbase, 64, vtbase, 256, t0, t0 + 16, t0 + 32, t0 + 48, nullptr, 0, 0, 0, m, lsum, o,
                        lane);
    }
  }
  attn_finish(p.YS + (size_t)qtok * 1536 + 512 + h * 64, lsum, o, lane);
}

DI void unpack8(u32x4 u, float (&f)[8]) {
#pragma unroll
  for (int j = 0; j < 4; ++j) {
    f[2 * j] = bf_lo(u[j]);
    f[2 * j + 1] = bf_hi(u[j]);
  }
}
DI u32x4 pack8(const float (&f)[8]) {
  u32x4 o;
#pragma unroll
  for (int j = 0; j < 4; ++j) o[j] = cvt_pk_bf16(f[2 * j], f[2 * j + 1]);
  return o;
}

DI void conv_item(const Params& p, int l, int it) {
  const int t = tidx();
  const int row = it * 8 + (t >> 6), ch = (t & 63) * 8;
  const bf16_t* z = p.Z + (size_t)row * INW;
  float bg[8], a[8], b[8], acc[8];
  unpack8(*(const u32x4*)(z + ch), bg);
  const float* cw = p.conv_w + (size_t)l * 3 * 512 + ch;
  unpack8(*(const u32x4*)(z + 512 + ch), a);
  unpack8(*(const u32x4*)(z + 1024 + ch), b);
#pragma unroll
  for (int j = 0; j < 8; ++j) acc[j] = a[j] * b[j] * cw[512 + j];
  if (!seq_first(row)) {
    unpack8(*(const u32x4*)(z - INW + 512 + ch), a);
    unpack8(*(const u32x4*)(z - INW + 1024 + ch), b);
#pragma unroll
    for (int j = 0; j < 8; ++j) acc[j] += a[j] * b[j] * cw[j];
  }
  if (!seq_last(row)) {
    unpack8(*(const u32x4*)(z + INW + 512 + ch), a);
    unpack8(*(const u32x4*)(z + INW + 1024 + ch), b);
#pragma unroll
    for (int j = 0; j < 8; ++j) acc[j] += a[j] * b[j] * cw[1024 + j];
  }
#pragma unroll
  for (int j = 0; j < 8; ++j) acc[j] *= bg[j];
  *(u32x4*)(p.YS + (size_t)row * 1536 + ch) = pack8(acc);
}

DI void pool_item(const Params& p, int it) {
  const int t = tidx();
  const int row = it * 8 + (t >> 6), ch = (t & 63) * 8;
  const int g = ch >> 7, w = 2 << g;
  int seq0, seqn;
  if (row < NCTX) { seq0 = row & ~255; seqn = 256; } else { seq0 = row & ~1023; seqn = 1024; }
  const int tt = row - seq0;
  const int lo = max(tt - w / 2, 0), hi = min(tt - w / 2 + w, seqn);
  float acc[8], f[8];
#pragma unroll
  for (int j = 0; j < 8; ++j) acc[j] = 0.f;
  const bf16_t* zp = p.Z + (size_t)(seq0 + lo) * INW + 3072 + ch;
  const int cnt = hi - lo;
  u32x4 wv[16];
#pragma unroll
  for (int q = 0; q < 16; ++q) wv[q] = (q < cnt) ? *(const u32x4*)(zp + (size_t)q * INW) : (u32x4){0u, 0u, 0u, 0u};
#pragma unroll
  for (int q = 0; q < 16; ++q) {
    unpack8(wv[q], f);
#pragma unroll
    for (int j = 0; j < 8; ++j) acc[j] += f[j];
  }
  unpack8(*(const u32x4*)(p.Z + (size_t)row * INW + 3072 + ch), f);
  const float inv = 1.f / (float)(hi - lo);
#pragma unroll
  for (int j = 0; j < 8; ++j) acc[j] = acc[j] * inv - f[j];
  *(u32x4*)(p.YS + (size_t)row * 1536 + 1024 + ch) = pack8(acc);
}

DI float gelu_tanh(float x) {
  const float y = 0.7978845608028654f * (x + 0.044715f * x * x * x);
  const float e = __expf(2.f * y);
  const float th = 1.f - 2.f / (e + 1.f);
  return 0.5f * x * (1.f + th);
}
DI void act_item(const Params& p, int l, int it) {
  const int id = it * NTHREADS + tidx();
  const int row = (id / 352) * 4, ch = (id % 352) * 8;
  const bf16_t* u = p.U + (size_t)row * (2 * DFF) + ch;
  const float* cw = p.f_conv + (size_t)l * 3 * DFF + ch;
  const bool first = seq_first(row), last = seq_last(row + 3);
  u32x4 ur[6], vr[4];
#pragma unroll
  for (int i = 0; i < 6; ++i) {
    const bool ok = (i == 0) ? !first : (i == 5) ? !last : true;
    ur[i] = ok ? *(const u32x4*)(u + (ptrdiff_t)(i - 1) * (2 * DFF)) : (u32x4){0u, 0u, 0u, 0u};
  }
#pragma unroll
  for (int i = 0; i < 4; ++i) vr[i] = *(const u32x4*)(u + (size_t)i * (2 * DFF) + DFF);
  float w0[8], w1[8], w2[8];
#pragma unroll
  for (int j = 0; j < 8; ++j) { w0[j] = cw[j]; w1[j] = cw[DFF + j]; w2[j] = cw[2 * DFF + j]; }
#pragma unroll
  for (int i = 0; i < 4; ++i) {
    float a[8], b[8], c[8], val[8], acc[8];
    unpack8(ur[i], a);
    unpack8(ur[i + 1], b);
    unpack8(ur[i + 2], c);
    unpack8(vr[i], val);
#pragma unroll
    for (int j = 0; j < 8; ++j) acc[j] = gelu_tanh(a[j] * w0[j] + b[j] * w1[j] + c[j] * w2[j]) * val[j];
    *(u32x4*)(p.ACT + (size_t)(row + i) * DFF + ch) = pack8(acc);
  }
}

DI void final_row(const Params& p, int row) {
  const int lane = tidx() & 63;
  const float* xr = p.X + (size_t)row * D;
  f32x4 v[4];
  float ss = 0.f;
#pragma unroll
  for (int i = 0; i < 4; ++i) {
    v[i] = *(const f32x4*)(xr + i * 256 + lane * 4);
    ss += v[i][0] * v[i][0] + v[i][1] * v[i][1] + v[i][2] * v[i][2] + v[i][3] * v[i][3];
  }
  ss = wave_sum(ss);
  const float rstd = rsqrtf(ss * (1.f / 1024.f) + 1e-6f);
#pragma unroll
  for (int i = 0; i < 4; ++i) {
    const int col = i * 256 + lane * 4;
    const f32x4 gg = *(const f32x4*)(p.g_final + col);
    f32x4 o;
#pragma unroll
    for (int j = 0; j < 4; ++j) o[j] = v[i][j] * rstd * gg[j];
    *(f32x4*)(p.out + (size_t)row * D + col) = o;
  }
}

constexpr int N_PHASES = 20;
extern __shared__ __attribute__((aligned(16))) char g_smem[];
#define NI __device__ __forceinline__
constexpr size_t KV_OFF = (size_t)NTOK * D;

NI void ph_prep0(const Params& p) {
  char* smem = g_smem;
  const int nb = gridDim.x, bid = bidx();
  const int total = PREP_ITEMS + MOD_ITEMS + CACHE_ITEMS;
  for (int it = bid; it < total; it += nb) {
    if (it < MOD_ITEMS) mod_item(p, it, (float*)smem);
    else if (it < MOD_ITEMS + CACHE_ITEMS) cache_item(p, it - MOD_ITEMS);
    else prep_item(p, 0, it - MOD_ITEMS - CACHE_ITEMS, (float*)smem);
  }
#ifdef REP_MOD
  for (int it = bid; it < MOD_ITEMS; it += nb) mod_item(p, it, (float*)smem);
#endif
#ifdef REP_WEFF
  for (int it = bid; it < PREP_WEFF; it += nb) prep_item(p, 0, it, (float*)smem);
#endif
#ifdef REP_TRANS
  for (int it = PREP_WEFF + bid; it < PREP_ITEMS; it += nb) prep_item(p, 0, it, (float*)smem);
#endif
}
NI void ph_final(const Params& p) {
  const int nb = gridDim.x, bid = bidx(), wid = tidx() >> 6;
  for (int row = bid * NWAVES + wid; row < NTOK; row += nb * NWAVES) final_row(p, row);
}
NI void ph_normmod1(const Params& p, int l) {
  char* smem = g_smem;
  const int nb = gridDim.x, bid = bidx(), wid = tidx() >> 6;
  for (int row = bid * NWAVES + wid; row < NTOK; row += nb * NWAVES)
    normmod_row(p, l, 0, row, l == 0 ? xin_row(p, row) : p.X + (size_t)row * D);
  if (l == 1)
    for (int it = bid; it < PREP_ITEMS; it += nb) prep_item(p, 1, it, (float*)smem);
}
NI void ph_inproj(const Params& p, int l) {
  EpiZ epi{p.Z, p.VT, p.out + KV_OFF, l};
  gemm_phase<false>(p.H, D, p.WIN, D, D, INW, g_smem, epi, nullptr);
}
NI void ph_attn(const Params& p, int l) {
  const int nb = gridDim.x, bid = bidx();
  for (int it = bid; it < 512; it += nb) {
    if (it < 256) attn_lat_item(p, l, it, g_smem);
    else attn_ctx_item(p, it - 256, g_smem);
  }
  __syncthreads();
}
NI void ph_convpool(const Params& p, int l) {
  const int nb = gridDim.x, bid = bidx();
  for (int it = bid; it < 2048; it += nb) {
    if (it < 1024) conv_item(p, l, it);
    else pool_item(p, it - 1024);
  }
}
NI void ph_branch(const Params& p) {
  EpiBf16 epi{p.MERGED, D};
  gemm_phase<true>(p.YS, 1536, p.WB, 1536, 1536, D, g_smem, epi, p.Z + 3584);
}
NI void ph_outproj(const Params& p, int l) {
  EpiResid epi{&p, l, 2048, l == 0};
  gemm_phase<false>(p.MERGED, D, p.WO, D, D, D, g_smem, epi, nullptr);
}
NI void ph_normmod2(const Params& p, int l) {
  const int nb = gridDim.x, bid = bidx(), wid = tidx() >> 6;
  for (int row = bid * NWAVES + wid; row < NTOK; row += nb * NWAVES) normmod_row(p, l, 1, row, p.X + (size_t)row * D);
}
NI void ph_up(const Params& p) {
  EpiBf16 epi{p.U, 2 * DFF};
  gemm_phase<false>(p.H, D, p.WU, D, D, 2 * DFF, g_smem, epi, nullptr);
}
NI void ph_act(const Params& p, int l) {
  const int nb = gridDim.x, bid = bidx();
  for (int it = bid; it < (NTOK / 4) * 352 / NTHREADS; it += nb) act_item(p, l, it);
}
NI void ph_down(const Params& p, int l) {
  EpiResid epi{&p, l, 5120, false};
  gemm_phase<false>(p.ACT, DFF, p.WD, DFF, DFF, D, g_smem, epi, nullptr);
}

DI void run_phase(const Params& p, int ph) {
  if (ph == 0) { ph_prep0(p); return; }
  if (ph == 19) { ph_final(p); return; }
  const int l = (ph - 1) / 9, s = (ph - 1) % 9;
  switch (s) {
    case 0: ph_normmod1(p, l); break;
    case 1: ph_inproj(p, l); break;
    case 2:
      ph_attn(p, l);
#ifdef REP_ATTN
      if (l == 0) ph_attn(p, l);
#endif
      ph_convpool(p, l);
#ifdef REP_CONVPOOL
      if (l == 0) ph_convpool(p, l);
#endif
      break;
    case 3: ph_branch(p); break;
    case 4: ph_outproj(p, l); break;
    case 5: ph_normmod2(p, l); break;
    case 6: ph_up(p); break;
    case 7: ph_act(p, l); break;
    case 8: ph_down(p, l); break;
  }
}


#define XB_TMO      128
#define XB_XCNT(j)  (256  + 64 * (j))
#define XB_XSUB(j)  (1280 + 64 * (j))
#define XB_XGEN(j)  (2304 + 64 * (j))
#define XB_TOP      3328
#define XB_TOPGEN   3392
#define XCD_BAR_WORDS 3456
#define XB_SPIN_CAP (1u << 20)
DI unsigned xb_ld(unsigned* p) { return __hip_atomic_load(p, __ATOMIC_RELAXED, __HIP_MEMORY_SCOPE_AGENT); }
DI unsigned xb_add(unsigned* p, unsigned v) { return __hip_atomic_fetch_add(p, v, __ATOMIC_RELAXED, __HIP_MEMORY_SCOPE_AGENT); }
DI unsigned xb_xcc_id() { return (unsigned)__builtin_amdgcn_s_getreg((3 << 11) | 20) & 0xFu; }
#define XB_SPIN(cond, bar) do { unsigned _sp = 0; while (cond) { __builtin_amdgcn_s_sleep(1); \
    if ((++_sp & 255u) == 0u) { if (xb_ld(&(bar)[XB_TMO])) break; if (_sp > XB_SPIN_CAP) { atomicAdd(&(bar)[XB_TMO], 1u); break; } } } } while (0)
struct XcdBarrier { unsigned* bar; unsigned x, nloc, nx; };
DI XcdBarrier xcd_barrier_post(unsigned* bar) {
  XcdBarrier b; b.bar = bar; b.x = xb_xcc_id(); b.nloc = 0u; b.nx = 0u;
  if (threadIdx.x == 0) (void)xb_add(&bar[XB_XCNT(b.x)], 1u);
  return b;
}
DI void xcd_barrier_complete(unsigned* bar, unsigned x, unsigned& nloc, unsigned& nx) {
  const unsigned G = gridDim.x;
  unsigned sum, cnt, mine, sp = 0u;
  for (;;) {
    sum = 0u; cnt = 0u; mine = 0u;
#pragma unroll
    for (unsigned j = 0; j < 16; ++j) { const unsigned c = xb_ld(&bar[XB_XCNT(j)]); sum += c; cnt += (c > 0u) ? 1u : 0u; mine = (j == x) ? c : mine; }
    if (sum == G) break;
    __builtin_amdgcn_s_sleep(1);
    if ((++sp & 255u) == 0u) { if (xb_ld(&bar[XB_TMO])) break; if (sp > XB_SPIN_CAP) { atomicAdd(&bar[XB_TMO], 1u); break; } }
  }
  nloc = mine > 0u ? mine : 1u; nx = cnt > 0u ? cnt : 1u;
}
DI void xcd_barrier(XcdBarrier& b) {
  asm volatile("s_waitcnt vmcnt(0)" ::: "memory");
  __syncthreads();
  if (threadIdx.x == 0) {
    unsigned* bar = b.bar;
    __builtin_amdgcn_s_waitcnt(0);
    if (b.nloc == 0u) xcd_barrier_complete(bar, b.x, b.nloc, b.nx);
    const unsigned nloc = b.nloc, nx = b.nx;
    const unsigned old = xb_add(&bar[XB_XSUB(b.x)], 1u);
    const unsigned gen = old / nloc;
    if (old + 1u == (gen + 1u) * nloc) {
      __builtin_amdgcn_fence(__ATOMIC_RELEASE, "agent");
      asm volatile("s_waitcnt vmcnt(0)" ::: "memory");
      const unsigned og = xb_add(&bar[XB_TOP], 1u);
      const unsigned tg = og / nx;
      if (og + 1u == (tg + 1u) * nx) xb_add(&bar[XB_TOPGEN], 1u);
      else XB_SPIN(xb_ld(&bar[XB_TOPGEN]) == tg, bar);
      __builtin_amdgcn_fence(__ATOMIC_ACQUIRE, "agent");
      xb_add(&bar[XB_XGEN(b.x)], 1u);
      asm volatile("s_waitcnt vmcnt(0)" ::: "memory");
    } else {
      XB_SPIN(xb_ld(&bar[XB_XGEN(b.x)]) == gen, bar);
      __builtin_amdgcn_fence(__ATOMIC_ACQUIRE, "agent");
      asm volatile("s_waitcnt vmcnt(0)" ::: "memory");
    }
  }
  __syncthreads();
}

__global__ void __launch_bounds__(NTHREADS, 2) mega_kernel(Params p, int ph_lo, int ph_hi) {
  cg::grid_group grid = cg::this_grid();
  XcdBarrier xb = xcd_barrier_post(p.BAR);
#ifndef REPEAT_MASK
#define REPEAT_MASK 0u
#endif
  for (int ph = ph_lo; ph < ph_hi; ++ph) {
    run_phase(p, ph);
    if ((REPEAT_MASK >> ph) & 1u) {
      xcd_barrier(xb);
      run_phase(p, ph);
    }
    if (ph + 1 < ph_hi) xcd_barrier(xb);
  }
  if (ph_hi > 1000) grid.sync();
}

extern "C" void kernel_launch(void* const* d_in, const int* in_sizes, int n_in, void* d_out, int out_size, void* d_ws,
                              size_t ws_size, hipStream_t stream) {
  static int grid_blocks = 0;
  if (!grid_blocks) {
    int dev = 0, cus = 0, per_cu = 0;
    (void)hipGetDevice(&dev);
    (void)hipDeviceGetAttribute(&cus, hipDeviceAttributeMultiprocessorCount, dev);
    (void)hipFuncSetAttribute((const void*)mega_kernel, hipFuncAttributeMaxDynamicSharedMemorySize, LDS_BYTES);
    (void)hipOccupancyMaxActiveBlocksPerMultiprocessor(&per_cu, mega_kernel, NTHREADS, LDS_BYTES);
    if (per_cu < 1) fprintf(stderr, "occupancy query reports %d blocks/CU\n", per_cu);
    grid_blocks = cus;
  }
  Params p{};
  const float** f = (const float**)&p;
  for (int i = 0; i < 20; ++i) f[i] = (const float*)d_in[i];
  p.out = (float*)d_out;
  char* ws = (char*)d_ws;
  size_t off = 0;
  auto take = [&](size_t bytes) { char* r = ws + off; off += (bytes + 255) & ~(size_t)255; return r; };
  p.BAR = (unsigned*)take(XCD_BAR_WORDS * 4);
  p.MOD = (float*)take(2 * 5 * 6144 * 4);
  p.X = (float*)take((size_t)NTOK * D * 4);
  p.KC = (bf16_t*)take((size_t)64 * 16384 * 2);
  p.VCT = (bf16_t*)take((size_t)64 * 16384 * 2);
  p.WIN = (bf16_t*)take((size_t)INW * D * 2);
  p.WB = (bf16_t*)take((size_t)D * 1536 * 2);
  p.WO = (bf16_t*)take((size_t)D * D * 2);
  p.WU = (bf16_t*)take((size_t)2 * DFF * D * 2);
  p.WD = (bf16_t*)take((size_t)D * DFF * 2);
  p.H = (bf16_t*)take((size_t)NTOK * D * 2);
  p.Z = (bf16_t*)take((size_t)NTOK * INW * 2);
  p.U = p.Z;
  char* r2 = take((size_t)NTOK * 1536 * 2 + (size_t)NTOK * D * 2 + (size_t)512 * NTOK * 2);
  p.YS = (bf16_t*)r2;
  p.MERGED = (bf16_t*)(r2 + (size_t)NTOK * 1536 * 2);
  p.VT = (bf16_t*)(r2 + (size_t)NTOK * 1536 * 2 + (size_t)NTOK * D * 2);
  p.ACT = (bf16_t*)r2;
  (void)hipMemsetAsync(p.BAR, 0, XCD_BAR_WORDS * 4, stream);
#ifndef MULTI_LAUNCH
#define MULTI_LAUNCH 0
#endif
#if MULTI_LAUNCH
  for (int ph = 0; ph < N_PHASES; ++ph) mega_kernel<<<dim3(grid_blocks), dim3(NTHREADS), LDS_BYTES, stream>>>(p, ph, ph + 1);
#else
  int lo = 0, hi = N_PHASES;
  void* args[] = {&p, &lo, &hi};
  hipError_t e = hipLaunchCooperativeKernel((void*)mega_kernel, dim3(grid_blocks), dim3(NTHREADS), args, LDS_BYTES, stream);
  if (e != hipSuccess) fprintf(stderr, "cooperative launch failed: %s (grid %d)\n", hipGetErrorString(e), grid_blocks);
#endif
}
```

```cpp
#include <hip/hip_runtime.h>
#include <hip/hip_cooperative_groups.h>
#include <cstdio>
namespace cg = cooperative_groups;

typedef unsigned short bf16_t;
typedef short bf16x8 __attribute__((ext_vector_type(8)));
typedef float f32x4 __attribute__((ext_vector_type(4)));
typedef unsigned u32x4 __attribute__((ext_vector_type(4)));
typedef unsigned u32x2 __attribute__((ext_vector_type(2)));

#define DI __device__ __forceinline__
DI int tidx() { int t = threadIdx.x; asm volatile("" : "+v"(t)); return t; }
DI int bidx() { int b = blockIdx.x; asm volatile("" : "+s"(b)); return b; }

constexpr int D = 1024, NTOK = 8192, NCTX = 4096, INW = 6656, DFF = 2816;
constexpr int NTHREADS = 512, NWAVES = 8;
constexpr int LDS_BYTES = 147456;

struct Params {
  const float *x_prompt, *x_sample, *cache_kv, *c, *c_ctx, *w_mod, *b_mod, *g1, *g2, *w_in, *conv_w, *rpb, *pool_w,
      *pool_scale, *w_branch, *w_out, *w_up, *f_conv, *w_down, *g_final;
  float* out;
  float* MOD;
  float* X;
  unsigned* BAR;
  bf16_t *KC, *VCT, *WIN, *WB, *WO, *WU, *WD, *H, *Z, *U, *YS, *MERGED, *VT, *ACT;
};

typedef float f32x2 __attribute__((ext_vector_type(2)));
typedef __bf16 bf16x2_t __attribute__((ext_vector_type(2)));
DI unsigned cvt_pk_bf16(float lo, float hi) {
  const f32x2 v = {lo, hi};
  return __builtin_bit_cast(unsigned, __builtin_convertvector(v, bf16x2_t));
}
DI float bf_lo(unsigned u) { return __uint_as_float(u << 16); }
DI float bf_hi(unsigned u) { return __uint_as_float(u & 0xffff0000u); }
DI float wave_sum(float v) {
#pragma unroll
  for (int o = 32; o > 0; o >>= 1) v += __shfl_xor(v, o);
  return v;
}
DI const float* xin_row(const Params& p, int row) {
  return row < NCTX ? p.x_prompt + (size_t)row * D : p.x_sample + (size_t)(row - NCTX) * D;
}
DI int vec_of_row(int row) { return row < NCTX ? 0 : 1 + ((row - NCTX) >> 10); }
DI bool seq_first(int row) { return row < NCTX ? ((row & 255) == 0) : ((row & 1023) == 0); }
DI bool seq_last(int row) { return row < NCTX ? ((row & 255) == 255) : ((row & 1023) == 1023); }

DI void transpose_tile(const float* __restrict__ src, int srcld, bf16_t* __restrict__ dst, int dstld, int kt, int nt,
                       float* sm) {
  const int t = tidx();
  const float* s = src + (size_t)(kt * 128) * srcld + nt * 64;
#pragma unroll
  for (int i = 0; i < 4; ++i) {
    const int row = (t >> 4) + 32 * i, c4 = (t & 15) * 4;
    const f32x4 v = *(const f32x4*)(s + (size_t)row * srcld + c4);
    sm[row * 65 + c4 + 0] = v[0];
    sm[row * 65 + c4 + 1] = v[1];
    sm[row * 65 + c4 + 2] = v[2];
    sm[row * 65 + c4 + 3] = v[3];
  }
  __syncthreads();
  const int n = t >> 3, ks = (t & 7) * 16;
  u32x4 w0, w1;
#pragma unroll
  for (int j = 0; j < 4; ++j) {
    w0[j] = cvt_pk_bf16(sm[(ks + 2 * j) * 65 + n], sm[(ks + 2 * j + 1) * 65 + n]);
    w1[j] = cvt_pk_bf16(sm[(ks + 8 + 2 * j) * 65 + n], sm[(ks + 8 + 2 * j + 1) * 65 + n]);
  }
  bf16_t* d = dst + (size_t)(nt * 64 + n) * dstld + kt * 128 + ks;
  *(u32x4*)d = w0;
  *(u32x4*)(d + 8) = w1;
  __syncthreads();
}

constexpr int PREP_T_IN = 8 * 104, PREP_T_BR = 2 * 4 * 16, PREP_T_OUT = 8 * 16, PREP_T_UP = 8 * 88,
              PREP_T_DN = 22 * 16, PREP_WEFF = 128;
constexpr int PREP_ITEMS = PREP_T_IN + PREP_T_BR + PREP_T_OUT + PREP_T_UP + PREP_T_DN + PREP_WEFF;

DI void prep_transposes(const Params& p, int l, int it, float* sm) {
  if (it < PREP_T_IN) {
    transpose_tile(p.w_in + (size_t)l * D * INW, INW, p.WIN, D, it / 104, it % 104, sm);
    return;
  }
  it -= PREP_T_IN;
  if (it < PREP_T_BR) {
    const int i = it >> 6, r = it & 63;
    transpose_tile(p.w_branch + (size_t)(l * 3 + i) * 512 * D, D, p.WB + i * 512, 1536, r >> 4, r & 15, sm);
    return;
  }
  it -= PREP_T_BR;
  if (it < PREP_T_OUT) {
    transpose_tile(p.w_out + (size_t)l * D * D, D, p.WO, D, it >> 4, it & 15, sm);
    return;
  }
  it -= PREP_T_OUT;
  if (it < PREP_T_UP) {
    transpose_tile(p.w_up + (size_t)l * D * 2 * DFF, 2 * DFF, p.WU, D, it / 88, it % 88, sm);
    return;
  }
  it -= PREP_T_UP;
  if (it < PREP_T_DN) {
    transpose_tile(p.w_down + (size_t)l * DFF * D, D, p.WD, DFF, it >> 4, it & 15, sm);
    return;
  }
}

DI void prep_item(const Params& p, int l, int it, float* sm) {
  if (it < PREP_WEFF) {
    const int g = it >> 5, cb = (it >> 1) & 15, db = it & 1;
    const int t = tidx();
    const int dd = db * 512 + t;
    const float* wb2 = p.w_branch + (size_t)(l * 3 + 2) * 512 * D + (size_t)(g * 128) * D + dd;
    for (int i = t; i < 1024; i += NTHREADS) {
      const int e = i >> 3, c = i & 7;
      sm[i] = p.pool_w[((size_t)(l * 4 + g) * 128 + cb * 8 + c) * 128 + e] * p.pool_scale[l * 512 + g * 128 + e];
    }
    __syncthreads();
    float acc[8];
#pragma unroll
    for (int c = 0; c < 8; ++c) acc[c] = 0.f;
#pragma unroll 16
    for (int e = 0; e < 128; ++e) {
      const float w = wb2[(size_t)e * D];
      const f32x4 s0 = *(const f32x4*)(sm + e * 8), s1 = *(const f32x4*)(sm + e * 8 + 4);
#pragma unroll
      for (int c = 0; c < 4; ++c) { acc[c] += s0[c] * w; acc[4 + c] += s1[c] * w; }
    }
    u32x4 o;
#pragma unroll
    for (int j = 0; j < 4; ++j) o[j] = cvt_pk_bf16(acc[2 * j], acc[2 * j + 1]);
    *(u32x4*)(p.WB + (size_t)dd * 1536 + 1024 + g * 128 + cb * 8) = o;
    __syncthreads();
  }
  else {
    it -= PREP_WEFF;
    prep_transposes(p, l, it, sm);
  }
}

constexpr int MOD_ITEMS = 2 * 96;
DI void mod_item(const Params& p, int it, float* sm) {
  const int t = tidx();
  const int l = it / 96, cb = it % 96;
  float* red = sm + 5 * 1024;
  for (int i = t; i < 5 * 1024; i += NTHREADS) {
    const int v = i >> 10, k = i & 1023;
    const float cv = (v == 0) ? p.c_ctx[k] : p.c[(v - 1) * D + k];
    sm[i] = cv / (1.f + __expf(-cv));
  }
  __syncthreads();
  const int kg = t >> 4, ct = t & 15;
  f32x4 acc[5];
#pragma unroll
  for (int v = 0; v < 5; ++v) acc[v] = (f32x4){0.f, 0.f, 0.f, 0.f};
  const float* w = p.w_mod + ((size_t)l * D + kg * 32) * 6144 + cb * 64 + ct * 4;
#pragma unroll 8
  for (int kk = 0; kk < 32; ++kk) {
    const f32x4 wv = *(const f32x4*)(w + (size_t)kk * 6144);
#pragma unroll
    for (int v = 0; v < 5; ++v) acc[v] += sm[v * 1024 + kg * 32 + kk] * wv;
  }
#pragma unroll
  for (int v = 0; v < 5; ++v)
#pragma unroll
    for (int j = 0; j < 4; ++j) red[(kg * 5 + v) * 64 + ct * 4 + j] = acc[v][j];
  __syncthreads();
  for (int i = t; i < 320; i += NTHREADS) {
    const int v = i >> 6, c = i & 63;
    float s = p.b_mod[l * 6144 + cb * 64 + c];
#pragma unroll
    for (int g = 0; g < 32; ++g) s += red[(g * 5 + v) * 64 + c];
    p.MOD[(size_t)(l * 5 + v) * 6144 + cb * 64 + c] = s;
  }
  __syncthreads();
}

constexpr int CACHE_ITEMS = 32;
DI void cache_item(const Params& p, int it) {
  const int t = tidx() & 255;
  it = it * 2 + (tidx() >> 8);
  const int b = it >> 4, l = (it >> 3) & 1, h = it & 7;
  const float* ks = p.cache_kv + ((size_t)(((b * 2 + l) * 2 + 0) * 8 + h)) * 16384;
  const float* vs = p.cache_kv + ((size_t)(((b * 2 + l) * 2 + 1) * 8 + h)) * 16384;
  bf16_t* kd = p.KC + (size_t)((b * 2 + l) * 8 + h) * 16384;
  bf16_t* vd = p.VCT + (size_t)((b * 2 + l) * 8 + h) * 16384;
#pragma unroll 4
  for (int i = 0; i < 16; ++i) {
    const int e = (i * 256 + t) * 4;
    const f32x4 v = *(const f32x4*)(ks + e);
    u32x2 o;
    o[0] = cvt_pk_bf16(v[0], v[1]);
    o[1] = cvt_pk_bf16(v[2], v[3]);
    *(u32x2*)(kd + e) = o;
  }
#pragma unroll 4
  for (int d = 0; d < 64; d += 4) {
    const f32x4 v = *(const f32x4*)(vs + t * 64 + d);
#pragma unroll
    for (int j = 0; j < 4; ++j) vd[(d + j) * 256 + t] = (bf16_t)(cvt_pk_bf16(v[j], 0.f) & 0xffffu);
  }
}

DI void normmod_row2(const Params& p, int l, int which, int row, const float* xr) {
  const int lane = tidx() & 63;
  f32x4 v[2][4];
  float ss[2] = {0.f, 0.f};
#pragma unroll
  for (int r = 0; r < 2; ++r)
#pragma unroll
    for (int i = 0; i < 4; ++i) v[r][i] = *(const f32x4*)(xr + r * D + i * 256 + lane * 4);
#pragma unroll
  for (int r = 0; r < 2; ++r) {
#pragma unroll
    for (int i = 0; i < 4; ++i)
      ss[r] += v[r][i][0] * v[r][i][0] + v[r][i][1] * v[r][i][1] + v[r][i][2] * v[r][i][2] + v[r][i][3] * v[r][i][3];
    ss[r] = wave_sum(ss[r]);
  }
  const float* g = (which == 0 ? p.g1 : p.g2) + l * D;
  const float* mod = p.MOD + (size_t)(l * 5 + vec_of_row(row)) * 6144 + which * 3072;
#pragma unroll
  for (int i = 0; i < 4; ++i) {
    const int col = i * 256 + lane * 4;
    const f32x4 gg = *(const f32x4*)(g + col);
    const f32x4 sh = *(const f32x4*)(mod + col);
    const f32x4 sc = *(const f32x4*)(mod + 1024 + col);
#pragma unroll
    for (int r = 0; r < 2; ++r) {
      const float rstd = rsqrtf(ss[r] * (1.f / 1024.f) + 1e-6f);
      f32x4 h;
#pragma unroll
      for (int j = 0; j < 4; ++j) h[j] = v[r][i][j] * rstd * gg[j] * (1.f + sc[j]) + sh[j];
      u32x2 o;
      o[0] = cvt_pk_bf16(h[0], h[1]);
      o[1] = cvt_pk_bf16(h[2], h[3]);
      *(u32x2*)(p.H + (size_t)(row + r) * D + col) = o;
    }
  }
}

constexpr int STAGE_BYTES = 49152;
#ifdef EXP_B
#define EXP_B_EXTRA gemm_stage<256>(A, lda, (4 * x + (pj & 3)) * 256, pt * 64, dst, tid); gemm_stage<128>(Bt, ldb, (pj >> 2) * 128, pt * 64, dst + 32768, tid);
#define VM_STAGE "12"
#else
#define EXP_B_EXTRA
#define VM_STAGE "6"
#endif
template <int ROWS>
DI void gemm_stage(const bf16_t* __restrict__ A, int lda, int row0, int k0, char* s, int t) {
  const int cp = t & 7, rr = t >> 3, c = cp ^ (rr & 7);
#pragma unroll
  for (int i = 0; i < ROWS / 64; ++i)
    __builtin_amdgcn_global_load_lds((const unsigned*)(A + (size_t)(row0 + rr + 64 * i) * lda + k0 + c * 8),
                                     (unsigned*)(s + t * 16 + i * 8192), 16, 0, 0);
}
DI void gemm_compute(const char* sA, const char* sB, f32x4 (&acc)[4][4], int wm, int wn, int lane) {
  const int fr = lane & 15, fq = lane >> 4;
#pragma unroll
  for (int ks = 0; ks < 2; ++ks) {
    bf16x8 a[4], b[4];
    const int sw = ((ks * 4 + fq) ^ (fr & 7)) << 4;
#pragma unroll
    for (int ni = 0; ni < 4; ++ni) b[ni] = *(const bf16x8*)(sB + (wn * 64 + ni * 16 + fr) * 128 + sw);
#pragma unroll
    for (int mi = 0; mi < 4; ++mi) a[mi] = *(const bf16x8*)(sA + (wm * 64 + mi * 16 + fr) * 128 + sw);
    __builtin_amdgcn_sched_barrier(0);
#pragma unroll
    for (int mi = 0; mi < 4; ++mi)
#pragma unroll
      for (int ni = 0; ni < 4; ++ni)
        acc[mi][ni] = __builtin_amdgcn_mfma_f32_16x16x32_bf16(b[ni], a[mi], acc[mi][ni], 0, 0, 0);
    __builtin_amdgcn_sched_barrier(0);
  }
}

template <bool GATED, class Epi>
DI void gemm_phase(const bf16_t* __restrict__ A, int lda, const bf16_t* __restrict__ Bt, int ldb, int K, int N,
                   char* smem, const Epi& epi, const bf16_t* gates) {
  const int tid = tidx();
  const int wid = tid >> 6, lane = tid & 63, wm = wid >> 1, wn = wid & 1;
  const int fr = lane & 15, fq = lane >> 4;
  const int bid = bidx(), nb = gridDim.x;
  const int nN = N >> 7, nt = K >> 6;
  const int x = bid & 7, per_x = 4 * nN, cstep = nb >> 3;
  int pj = bid >> 3, pt = 0, ps = 0;
#define GEMM_ISSUE()                                                                                          \
  do {                                                                                                        \
    if (pj < per_x) {                                                                                         \
      char* dst = smem + ps * STAGE_BYTES;                                                                    \
      gemm_stage<256>(A, lda, (4 * x + (pj & 3)) * 256, pt * 64, dst, tid);                                   \
      gemm_stage<128>(Bt, ldb, (pj >> 2) * 128, pt * 64, dst + 32768, tid);                                   \
      EXP_B_EXTRA                                                                                             \
      if (++pt == nt) { pt = 0; pj += cstep; }                                                                \
      ps = (ps == 2) ? 0 : ps + 1;                                                                            \
    }                                                                                                         \
  } while (0)
  GEMM_ISSUE();
  GEMM_ISSUE();
  int cs = 0;
  for (int cj = bid >> 3; cj < per_x; cj += cstep) {
    const int row0 = (4 * x + (cj & 3)) * 256, col0 = (cj >> 2) * 128;
    f32x4 acc[4][4];
    f32x4 tot[4][4];
#pragma unroll
    for (int mi = 0; mi < 4; ++mi)
#pragma unroll
      for (int ni = 0; ni < 4; ++ni) {
        acc[mi][ni] = (f32x4){0.f, 0.f, 0.f, 0.f};
        if (GATED) tot[mi][ni] = (f32x4){0.f, 0.f, 0.f, 0.f};
      }
    const bool last_tile = cj + cstep >= per_x;
    for (int t = 0; t < nt; ++t) {
      if (last_tile && t == nt - 1) asm volatile("s_waitcnt vmcnt(0)" ::: "memory");
      else asm volatile("s_waitcnt vmcnt(" VM_STAGE ")" ::: "memory");
      __builtin_amdgcn_s_barrier();
      GEMM_ISSUE();
      const char* cur = smem + cs * STAGE_BYTES;
      gemm_compute(cur, cur + 32768, acc, wm, wn, lane);
      cs = (cs == 2) ? 0 : cs + 1;
      if (GATED && ((t & 7) == 7)) {
        const int seg = t >> 3;
        int gofs = (row0 + wm * 64 + fr) * INW + seg * 1024 + col0 + wn * 64 + fq * 4;
        asm volatile("" : "+v"(gofs));
#pragma unroll
        for (int mi = 0; mi < 4; ++mi)
#pragma unroll
          for (int ni = 0; ni < 4; ++ni) {
            const u32x2 g = *(const u32x2*)(gates + (gofs + mi * 16 * INW + ni * 16));
            tot[mi][ni][0] += bf_lo(g[0]) * acc[mi][ni][0];
            tot[mi][ni][1] += bf_hi(g[0]) * acc[mi][ni][1];
            tot[mi][ni][2] += bf_lo(g[1]) * acc[mi][ni][2];
            tot[mi][ni][3] += bf_hi(g[1]) * acc[mi][ni][3];
            acc[mi][ni] = (f32x4){0.f, 0.f, 0.f, 0.f};
          }
      }
    }
#pragma unroll
    for (int mi = 0; mi < 4; ++mi)
#pragma unroll
      for (int ni = 0; ni < 4; ++ni) {
        const int row = row0 + wm * 64 + mi * 16 + fr, col = col0 + wn * 64 + ni * 16 + fq * 4;
        epi(row, col, GATED ? tot[mi][ni] : acc[mi][ni]);
      }
  }
#undef GEMM_ISSUE
  __syncthreads();
}

DI void store_bf16x4(bf16_t* d, f32x4 v) {
  u32x2 o;
  o[0] = cvt_pk_bf16(v[0], v[1]);
  o[1] = cvt_pk_bf16(v[2], v[3]);
  *(u32x2*)d = o;
}

struct EpiZ {
  bf16_t* Z; bf16_t* VT; float* kv; int l;
  DI void operator()(int row, int col, f32x4 v) const {
    if (col >= 3584) {
#pragma unroll
      for (int j = 0; j < 4; ++j) v[j] = __builtin_amdgcn_rcpf(1.f + __expf(-v[j]));
    }
    store_bf16x4(Z + (size_t)row * INW + col, v);
    if (col >= 2048 && col < 3072) {
      const int which = (col - 2048) >> 9, hd = (col - 2048) & 511;
      if (row < NCTX) {
        const int b = row >> 8, s = row & 255, hh = hd >> 6, d = hd & 63;
        *(f32x4*)(kv + ((size_t)((((b * 2 + l) * 2 + which) * 8 + hh) * 256 + s)) * 64 + d) = v;
      }
      if (which == 1) {
#pragma unroll
        for (int j = 0; j < 4; ++j)
          VT[(((size_t)(hd >> 6) * 256 + (row >> 5)) * 64 + (hd & 63) + j) * 32 + (row & 31)] = (bf16_t)(cvt_pk_bf16(v[j], 0.f) & 0xffffu);
      }
    }
  }
};
struct EpiBf16 {
  bf16_t* O; int ld;
  DI void operator()(int row, int col, f32x4 v) const { store_bf16x4(O + (size_t)row * ld + col, v); }
};
struct EpiResid {
  const Params* p; int l; int gate_off; bool from_input;
  DI void operator()(int row, int col, f32x4 v) const {
    const float* xi = from_input ? xin_row(*p, row) + col : p->X + (size_t)row * D + col;
    const f32x4 x = *(const f32x4*)xi;
    const f32x4 g = *(const f32x4*)(p->MOD + (size_t)(l * 5 + vec_of_row(row)) * 6144 + gate_off + col);
    f32x4 o;
#pragma unroll
    for (int j = 0; j < 4; ++j) o[j] = x[j] + g[j] * v[j];
    *(f32x4*)(p->X + (size_t)row * D + col) = o;
  }
};

template <bool LATBIAS>
DI void attn_chunk(const bf16x8 qf0, const bf16x8 qf1, const bf16_t* __restrict__ kbase, int kstride,
                   const bf16_t* __restrict__ vtbase, int vstride, int tk0, int tk1, int tk2, int tk3,
                   const float* __restrict__ rpb_h, int dr0, int band, int qc, float& m, float& lsum,
                   f32x4 (&o)[4], int lane) {
  const int fr = lane & 15, fq = lane >> 4;
  f32x4 s[4];
#pragma unroll
  for (int T = 0; T < 4; ++T) {
    const int tk = (T == 0 ? tk0 : T == 1 ? tk1 : T == 2 ? tk2 : tk3);
    const bf16_t* kp = kbase + (size_t)(tk + fr) * kstride + fq * 8;
    const bf16x8 k0 = *(const bf16x8*)kp;
    const bf16x8 k1 = *(const bf16x8*)(kp + 32);
    f32x4 z = (f32x4){0.f, 0.f, 0.f, 0.f};
    z = __builtin_amdgcn_mfma_f32_16x16x32_bf16(k0, qf0, z, 0, 0, 0);
    z = __builtin_amdgcn_mfma_f32_16x16x32_bf16(k1, qf1, z, 0, 0, 0);
    s[T] = z;
  }
  float cmax = -INFINITY;
#pragma unroll
  for (int T = 0; T < 4; ++T) {
#pragma unroll
    for (int j = 0; j < 4; ++j) {
      float v = s[T][j] * 0.125f;
      if (LATBIAS) {
        const int kc = band + (T & 1) * 16 + fq * 4 + j;
        const int cs = min(max(qc - 8, 0), 48);
        const bool valid = (kc >= cs) && (kc < cs + 16);
        const int dr = dr0 + (T >> 1);
        const int dc = min(max(kc - qc + 15, 0), 30);
        v = valid ? v + rpb_h[dr * 31 + dc] : -INFINITY;
      }
      s[T][j] = v;
      cmax = fmaxf(cmax, v);
    }
  }
  cmax = fmaxf(cmax, __shfl_xor(cmax, 16));
  cmax = fmaxf(cmax, __shfl_xor(cmax, 32));
  const float mnew = fmaxf(m, cmax);
  const float alpha = __expf(m - mnew);
  m = mnew;
  float ps = 0.f;
#pragma unroll
  for (int T = 0; T < 4; ++T)
#pragma unroll
    for (int j = 0; j < 4; ++j) {
      const float pv = __expf(s[T][j] - mnew);
      s[T][j] = pv;
      ps += pv;
    }
  lsum = lsum * alpha + ps;
#pragma unroll
  for (int dt = 0; dt < 4; ++dt) o[dt] *= alpha;
#pragma unroll
  for (int pr = 0; pr < 2; ++pr) {
    u32x4 pk;
    pk[0] = cvt_pk_bf16(s[2 * pr][0], s[2 * pr][1]);
    pk[1] = cvt_pk_bf16(s[2 * pr][2], s[2 * pr][3]);
    pk[2] = cvt_pk_bf16(s[2 * pr + 1][0], s[2 * pr + 1][1]);
    pk[3] = cvt_pk_bf16(s[2 * pr + 1][2], s[2 * pr + 1][3]);
    const bf16x8 pa = __builtin_bit_cast(bf16x8, pk);
    const int ta = (pr == 0 ? tk0 : tk2) + fq * 4, tb = (pr == 0 ? tk1 : tk3) + fq * 4;
#pragma unroll
    for (int dt = 0; dt < 4; ++dt) {
      const bf16_t* vp = vtbase + (dt * 16 + fr) * 32;
      const u32x2 lo = *(const u32x2*)(vp + (size_t)(ta >> 5) * 2048 + (ta & 31));
      const u32x2 hi = *(const u32x2*)(vp + (size_t)(tb >> 5) * 2048 + (tb & 31));
      u32x4 vv;
      vv[0] = lo[0]; vv[1] = lo[1]; vv[2] = hi[0]; vv[3] = hi[1];
      o[dt] = __builtin_amdgcn_mfma_f32_16x16x32_bf16(__builtin_bit_cast(bf16x8, vv), pa, o[dt], 0, 0, 0);
    }
  }
}

DI void attn_finish(bf16_t* ys_row, float lsum, const f32x4 (&o)[4], int lane) {
  const int fq = lane >> 4;
  lsum += __shfl_xor(lsum, 16);
  lsum += __shfl_xor(lsum, 32);
  const float inv = 1.f / lsum;
#pragma unroll
  for (int dt = 0; dt < 4; ++dt) store_bf16x4(ys_row + dt * 16 + fq * 4, o[dt] * inv);
}

constexpr int ATT_VROW = 528, ATT_SV_OFF = 32768;
template <bool VTILED>
DI void attn_stage_kv(const bf16_t* __restrict__ kbase, int kstride, int ktok0, const bf16_t* __restrict__ vtbase,
                      int vstride, int vtok0, char* smem, int tid) {
  gemm_stage<256>(kbase, kstride, ktok0, 0, smem, tid);
  const int d = tid >> 3, seg = tid & 7;
  const bf16_t* vp = VTILED ? vtbase + ((size_t)((vtok0 >> 5) + seg) * 64 + d) * 32
                            : vtbase + (size_t)d * vstride + vtok0 + seg * 32;
  char* dst = smem + ATT_SV_OFF + d * ATT_VROW + seg * 64;
#pragma unroll
  for (int i = 0; i < 4; ++i) *(u32x4*)(dst + i * 16) = *(const u32x4*)(vp + i * 8);
}
DI void attn_chunk_lds(const bf16x8 qf0, const bf16x8 qf1, const char* sK, const char* sV, int t0, float& m,
                       float& lsum, f32x4 (&o)[4], int lane) {
  const int fr = lane & 15, fq = lane >> 4;
  f32x4 s[4];
#pragma unroll
  for (int T = 0; T < 4; ++T) {
    const char* kp = sK + (t0 + T * 16 + fr) * 128;
    const bf16x8 k0 = *(const bf16x8*)(kp + ((fq ^ (fr & 7)) << 4));
    const bf16x8 k1 = *(const bf16x8*)(kp + (((4 + fq) ^ (fr & 7)) << 4));
    f32x4 z = (f32x4){0.f, 0.f, 0.f, 0.f};
    z = __builtin_amdgcn_mfma_f32_16x16x32_bf16(k0, qf0, z, 0, 0, 0);
    z = __builtin_amdgcn_mfma_f32_16x16x32_bf16(k1, qf1, z, 0, 0, 0);
    s[T] = z;
  }
  float cmax = -INFINITY;
#pragma unroll
  for (int T = 0; T < 4; ++T)
#pragma unroll
    for (int j = 0; j < 4; ++j) {
      s[T][j] *= 0.125f;
      cmax = fmaxf(cmax, s[T][j]);
    }
  cmax = fmaxf(cmax, __shfl_xor(cmax, 16));
  cmax = fmaxf(cmax, __shfl_xor(cmax, 32));
  const float mnew = fmaxf(m, cmax);
  const float alpha = __expf(m - mnew);
  m = mnew;
  float ps = 0.f;
#pragma unroll
  for (int T = 0; T < 4; ++T)
#pragma unroll
    for (int j = 0; j < 4; ++j) {
      const float pv = __expf(s[T][j] - mnew);
      s[T][j] = pv;
      ps += pv;
    }
  lsum = lsum * alpha + ps;
#pragma unroll
  for (int dt = 0; dt < 4; ++dt) o[dt] *= alpha;
#pragma unroll
  for (int pr = 0; pr < 2; ++pr) {
    u32x4 pk;
    pk[0] = cvt_pk_bf16(s[2 * pr][0], s[2 * pr][1]);
    pk[1] = cvt_pk_bf16(s[2 * pr][2], s[2 * pr][3]);
    pk[2] = cvt_pk_bf16(s[2 * pr + 1][0], s[2 * pr + 1][1]);
    pk[3] = cvt_pk_bf16(s[2 * pr + 1][2], s[2 * pr + 1][3]);
    const bf16x8 pa = __builtin_bit_cast(bf16x8, pk);
#pragma unroll
    for (int dt = 0; dt < 4; ++dt) {
      const char* vp = sV + (dt * 16 + fr) * ATT_VROW + (t0 + pr * 32 + fq * 4) * 2;
      const u32x2 lo = *(const u32x2*)vp;
      const u32x2 hi = *(const u32x2*)(vp + 32);
      u32x4 vv;
      vv[0] = lo[0]; vv[1] = lo[1]; vv[2] = hi[0]; vv[3] = hi[1];
      o[dt] = __builtin_amdgcn_mfma_f32_16x16x32_bf16(__builtin_bit_cast(bf16x8, vv), pa, o[dt], 0, 0, 0);
    }
  }
}

DI void attn_ctx_item(const Params& p, int it, char* smem) {
  const int tid = tidx(), wid = tid >> 6, lane = tid & 63;
  const int b = it >> 4, h = (it >> 1) & 7, qt = (it & 1) * 8 + wid;
  const int fr = lane & 15, fq = lane >> 4;
  __syncthreads();
  attn_stage_kv<true>(p.Z + 2048 + h * 64, INW, b * 256, p.VT + (size_t)h * 256 * 2048, NTOK, b * 256, smem, tid);
  const int qtok = b * 256 + qt * 16 + fr;
  const bf16_t* qp = p.Z + (size_t)qtok * INW + 1536 + h * 64 + fq * 8;
  const bf16x8 qf0 = *(const bf16x8*)qp, qf1 = *(const bf16x8*)(qp + 32);
  float m = -INFINITY, lsum = 0.f;
  f32x4 o[4];
#pragma unroll
  for (int dt = 0; dt < 4; ++dt) o[dt] = (f32x4){0.f, 0.f, 0.f, 0.f};
  __syncthreads();
  for (int ch = 0; ch < 4; ++ch) attn_chunk_lds(qf0, qf1, smem, smem + ATT_SV_OFF, ch * 64, m, lsum, o, lane);
  attn_finish(p.YS + (size_t)qtok * 1536 + 512 + h * 64, lsum, o, lane);
}

DI void attn_lat_item(const Params& p, int l, int it, char* smem) {
  const int tid = tidx(), wid = tid >> 6, lane = tid & 63;
  const int b = it >> 6, h = (it >> 3) & 7, r = (it & 7) * 2 + (wid >> 2), j = wid & 3;
  const int fr = lane & 15, fq = lane >> 4;
  __syncthreads();
  {
    const size_t cb = (size_t)((b * 2 + l) * 8 + h) * 16384;
    attn_stage_kv<false>(p.KC + cb, 64, 0, p.VCT + cb, 256, 0, smem, tid);
  }
  const int qc = j * 16 + fr;
  const int qtok = NCTX + b * 1024 + r * 64 + qc;
  const bf16_t* qp = p.Z + (size_t)qtok * INW + 1536 + h * 64 + fq * 8;
  const bf16x8 qf0 = *(const bf16x8*)qp, qf1 = *(const bf16x8*)(qp + 32);
  float m = -INFINITY, lsum = 0.f;
  f32x4 o[4];
#pragma unroll
  for (int dt = 0; dt < 4; ++dt) o[dt] = (f32x4){0.f, 0.f, 0.f, 0.f};
  {
    const bf16_t* kbase = p.Z + 2048 + h * 64;
    const bf16_t* vtbase = p.VT + (size_t)h * 256 * 2048;
    const float* rpb_h = p.rpb + (size_t)(l * 8 + h) * 15 * 31;
    const int rs = min(max(r - 4, 0), 8);
    const int band = min(max(j * 16 - 8, 0), 32);
    for (int ch = 0; ch < 4; ++ch) {
      const int kr = rs + 2 * ch;
      const int t0 = NCTX + b * 1024 + kr * 64 + band;
      attn_chunk<true>(qf0, qf1, kbase, INW, vtbase, NTOK, t0, t0 + 16, t0 + 64, t0 + 80, rpb_h, kr - r + 7, band, qc,
                       m, lsum, o, lane);
    }
  }
  __syncthreads();
  for (int ch = 0; ch < 4; ++ch) attn_chunk_lds(qf0, qf1, smem, smem + ATT_SV_OFF, ch * 64, m, lsum, o, lane);
  attn_finish(p.YS + (size_t)qtok * 1536 + 512 + h * 64, lsum, o, lane);
}

DI void attn_ctx_unit(const Params& p, int u, int lane) {
  const int b = u >> 7, h = (u >> 4) & 7, qt = u & 15;
  const int fr = lane & 15, fq = lane >> 4;
  const int qtok = b * 256 + qt * 16 + fr;
  const bf16_t* qp = p.Z + (size_t)qtok * INW + 1536 + h * 64 + fq * 8;
  const bf16x8 qf0 = *(const bf16x8*)qp, qf1 = *(const bf16x8*)(qp + 32);
  const bf16_t* kbase = p.Z + 2048 + h * 64;
  const bf16_t* vtbase = p.VT + (size_t)h * 64 * NTOK;
  float m = -INFINITY, lsum = 0.f;
  f32x4 o[4];
#pragma unroll
  for (int dt = 0; dt < 4; ++dt) o[dt] = (f32x4){0.f, 0.f, 0.f, 0.f};
  for (int ch = 0; ch < 4; ++ch) {
    const int t0 = b * 256 + ch * 64;
    attn_chunk<false>(qf0, qf1, kbase, INW, vtbase, NTOK, t0, t0 + 16, t0 + 32, t0 + 48, nullptr, 0, 0, 0, m, lsum, o,
                      lane);
  }
  attn_finish(p.YS + (size_t)qtok * 1536 + 512 + h * 64, lsum, o, lane);
}

DI void attn_lat_unit(const Params& p, int l, int u, int lane) {
  const int b = u >> 9, h = (u >> 6) & 7, r = (u >> 2) & 15, j = u & 3;
  const int fr = lane & 15, fq = lane >> 4;
  const int qc = j * 16 + fr;
  const int qtok = NCTX + b * 1024 + r * 64 + qc;
  const bf16_t* qp = p.Z + (size_t)qtok * INW + 1536 + h * 64 + fq * 8;
  const bf16x8 qf0 = *(const bf16x8*)qp, qf1 = *(const bf16x8*)(qp + 32);
  float m = -INFINITY, lsum = 0.f;
  f32x4 o[4];
#pragma unroll
  for (int dt = 0; dt < 4; ++dt) o[dt] = (f32x4){0.f, 0.f, 0.f, 0.f};
  {
    const bf16_t* kbase = p.Z + 2048 + h * 64;
    const bf16_t* vtbase = p.VT + (size_t)h * 64 * NTOK;
    const float* rpb_h = p.rpb + (size_t)(l * 8 + h) * 15 * 31;
    const int rs = min(max(r - 4, 0), 8);
    const int band = min(max(j * 16 - 8, 0), 32);
    for (int ch = 0; ch < 4; ++ch) {
      const int kr = rs + 2 * ch;
      const int t0 = NCTX + b * 1024 + kr * 64 + band;
      attn_chunk<true>(qf0, qf1, kbase, INW, vtbase, NTOK, t0, t0 + 16, t0 + 64, t0 + 80, rpb_h, kr - r + 7, band, qc,
                       m, lsum, o, lane);
    }
  }
  {
    const bf16_t* kbase = p.KC + (size_t)((b * 2 + l) * 8 + h) * 16384;
    const bf16_t* vtbase = p.VCT + (size_t)((b * 2 + l) * 8 + h) * 16384;
    for (int ch = 0; ch < 4; ++ch) {
      const int t0 = ch * 64;
      attn_chunk<false>(qf0, qf1, kbase, 64, vtbase, 256, t0, t0 + 16, t0 + 32, t0 + 48, nullptr, 0, 0, 0, m, lsum, o,
                        lane);
    }
  }
  attn_finish(p.YS + (size_t)qtok * 1536 + 512 + h * 64, lsum, o, lane);
}

DI void unpack8(u32x4 u, float (&f)[8]) {
#pragma unroll
  for (int j = 0; j < 4; ++j) {
    f[2 * j] = bf_lo(u[j]);
    f[2 * j + 1] = bf_hi(u[j]);
  }
}
DI u32x4 pack8(const float (&f)[8]) {
  u32x4 o;
#pragma unroll
  for (int j = 0; j < 4; ++j) o[j] = cvt_pk_bf16(f[2 * j], f[2 * j + 1]);
  return o;
}

DI void conv_item(const Params& p, int l, int it) {
  const int t = tidx();
  const int row = it * 8 + (t >> 6), ch = (t & 63) * 8;
  const bf16_t* z = p.Z + (size_t)row * INW;
  float bg[8], a[8], b[8], acc[8];
  unpack8(*(const u32x4*)(z + ch), bg);
  const float* cw = p.conv_w + (size_t)l * 3 * 512 + ch;
  unpack8(*(const u32x4*)(z + 512 + ch), a);
  unpack8(*(const u32x4*)(z + 1024 + ch), b);
#pragma unroll
  for (int j = 0; j < 8; ++j) acc[j] = a[j] * b[j] * cw[512 + j];
  if (!seq_first(row)) {
    unpack8(*(const u32x4*)(z - INW + 512 + ch), a);
    unpack8(*(const u32x4*)(z - INW + 1024 + ch), b);
#pragma unroll
    for (int j = 0; j < 8; ++j) acc[j] += a[j] * b[j] * cw[j];
  }
  if (!seq_last(row)) {
    unpack8(*(const u32x4*)(z + INW + 512 + ch), a);
    unpack8(*(const u32x4*)(z + INW + 1024 + ch), b);
#pragma unroll
    for (int j = 0; j < 8; ++j) acc[j] += a[j] * b[j] * cw[1024 + j];
  }
#pragma unroll
  for (int j = 0; j < 8; ++j) acc[j] *= bg[j];
  *(u32x4*)(p.YS + (size_t)row * 1536 + ch) = pack8(acc);
}

DI void pool_item(const Params& p, int it) {
  const int t = tidx();
  const int row = it * 8 + (t >> 6), ch = (t & 63) * 8;
  const int g = ch >> 7, w = 2 << g;
  int seq0, seqn;
  if (row < NCTX) { seq0 = row & ~255; seqn = 256; } else { seq0 = row & ~1023; seqn = 1024; }
  const int tt = row - seq0;
  const int lo = max(tt - w / 2, 0), hi = min(tt - w / 2 + w, seqn);
  float acc[8], f[8];
#pragma unroll
  for (int j = 0; j < 8; ++j) acc[j] = 0.f;
  const bf16_t* zp = p.Z + (size_t)(seq0 + lo) * INW + 3072 + ch;
  const int cnt = hi - lo;
  u32x4 wv[16];
#pragma unroll
  for (int q = 0; q < 16; ++q) wv[q] = (q < cnt) ? *(const u32x4*)(zp + (size_t)q * INW) : (u32x4){0u, 0u, 0u, 0u};
#pragma unroll
  for (int q = 0; q < 16; ++q) {
    unpack8(wv[q], f);
#pragma unroll
    for (int j = 0; j < 8; ++j) acc[j] += f[j];
  }
  unpack8(*(const u32x4*)(p.Z + (size_t)row * INW + 3072 + ch), f);
  const float inv = 1.f / (float)(hi - lo);
#pragma unroll
  for (int j = 0; j < 8; ++j) acc[j] = acc[j] * inv - f[j];
  *(u32x4*)(p.YS + (size_t)row * 1536 + 1024 + ch) = pack8(acc);
}

DI float gelu_tanh(float x) {
  const float y = 0.7978845608028654f * (x + 0.044715f * x * x * x);
  const float e = __expf(2.f * y);
  const float th = 1.f - 2.f / (e + 1.f);
  return 0.5f * x * (1.f + th);
}
DI void act_item(const Params& p, int l, int it) {
  const int id = it * NTHREADS + tidx();
  const int row = (id / 352) * 4, ch = (id % 352) * 8;
  const bf16_t* u = p.U + (size_t)row * (2 * DFF) + ch;
  const float* cw = p.f_conv + (size_t)l * 3 * DFF + ch;
  const bool first = seq_first(row), last = seq_last(row + 3);
  u32x4 ur[6], vr[4];
#pragma unroll
  for (int i = 0; i < 6; ++i) {
    const bool ok = (i == 0) ? !first : (i == 5) ? !last : true;
    ur[i] = ok ? *(const u32x4*)(u + (ptrdiff_t)(i - 1) * (2 * DFF)) : (u32x4){0u, 0u, 0u, 0u};
  }
#pragma unroll
  for (int i = 0; i < 4; ++i) vr[i] = *(const u32x4*)(u + (size_t)i * (2 * DFF) + DFF);
  float w0[8], w1[8], w2[8];
#pragma unroll
  for (int j = 0; j < 8; ++j) { w0[j] = cw[j]; w1[j] = cw[DFF + j]; w2[j] = cw[2 * DFF + j]; }
#pragma unroll
  for (int i = 0; i < 4; ++i) {
    float a[8], b[8], c[8], val[8], acc[8];
    unpack8(ur[i], a);
    unpack8(ur[i + 1], b);
    unpack8(ur[i + 2], c);
    unpack8(vr[i], val);
#pragma unroll
    for (int j = 0; j < 8; ++j) acc[j] = gelu_tanh(a[j] * w0[j] + b[j] * w1[j] + c[j] * w2[j]) * val[j];
    *(u32x4*)(p.ACT + (size_t)(row + i) * DFF + ch) = pack8(acc);
  }
}

DI void final_row(const Params& p, int row) {
  const int lane = tidx() & 63;
  const float* xr = p.X + (size_t)row * D;
  f32x4 v[4];
  float ss = 0.f;
#pragma unroll
  for (int i = 0; i < 4; ++i) {
    v[i] = *(const f32x4*)(xr + i * 256 + lane * 4);
    ss += v[i][0] * v[i][0] + v[i][1] * v[i][1] + v[i][2] * v[i][2] + v[i][3] * v[i][3];
  }
  ss = wave_sum(ss);
  const float rstd = rsqrtf(ss * (1.f / 1024.f) + 1e-6f);
#pragma unroll
  for (int i = 0; i < 4; ++i) {
    const int col = i * 256 + lane * 4;
    const f32x4 gg = *(const f32x4*)(p.g_final + col);
    f32x4 o;
#pragma unroll
    for (int j = 0; j < 4; ++j) o[j] = v[i][j] * rstd * gg[j];
    *(f32x4*)(p.out + (size_t)row * D + col) = o;
  }
}

constexpr int N_PHASES = 20;
extern __shared__ __attribute__((aligned(16))) char g_smem[];
#define NI __device__ __forceinline__
constexpr size_t KV_OFF = (size_t)NTOK * D;

NI void ph_prep0(const Params& p) {
  char* smem = g_smem;
  const int nb = gridDim.x, bid = bidx();
  const int total = PREP_ITEMS + MOD_ITEMS + CACHE_ITEMS;
  for (int it = bid; it < total; it += nb) {
    if (it < MOD_ITEMS) mod_item(p, it, (float*)smem);
    else if (it < MOD_ITEMS + CACHE_ITEMS) cache_item(p, it - MOD_ITEMS);
    else prep_item(p, 0, it - MOD_ITEMS - CACHE_ITEMS, (float*)smem);
  }
#ifdef REP_MOD
  for (int it = bid; it < MOD_ITEMS; it += nb) mod_item(p, it, (float*)smem);
#endif
#ifdef REP_WEFF
  for (int it = bid; it < PREP_WEFF; it += nb) prep_item(p, 0, it, (float*)smem);
#endif
#ifdef REP_TRANS
  for (int it = PREP_WEFF + bid; it < PREP_ITEMS; it += nb) prep_item(p, 0, it, (float*)smem);
#endif
}
NI void ph_final(const Params& p) {
  const int nb = gridDim.x, bid = bidx(), wid = tidx() >> 6;
  for (int row = bid * NWAVES + wid; row < NTOK; row += nb * NWAVES) final_row(p, row);
}
NI void ph_normmod1(const Params& p, int l) {
  char* smem = g_smem;
  const int nb = gridDim.x, bid = bidx(), wid = tidx() >> 6;
  for (int row = (bid * NWAVES + wid) * 2; row < NTOK; row += nb * NWAVES * 2)
    normmod_row2(p, l, 0, row, l == 0 ? xin_row(p, row) : p.X + (size_t)row * D);
  if (l == 1)
    for (int it = bid; it < PREP_ITEMS; it += nb) prep_item(p, 1, it, (float*)smem);
}
NI void ph_inproj(const Params& p, int l) {
  EpiZ epi{p.Z, p.VT, p.out + KV_OFF, l};
  gemm_phase<false>(p.H, D, p.WIN, D, D, INW, g_smem, epi, nullptr);
}
NI void ph_attn(const Params& p, int l) {
  const int nb = gridDim.x, bid = bidx();
  for (int it = bid; it < 512; it += nb) {
    if (it < 256) attn_lat_item(p, l, it, g_smem);
    else attn_ctx_item(p, it - 256, g_smem);
  }
  __syncthreads();
}
NI void ph_convpool(const Params& p, int l) {
  const int nb = gridDim.x, bid = bidx();
  for (int it = bid; it < 2048; it += nb) {
    if (it < 1024) conv_item(p, l, it);
    else pool_item(p, it - 1024);
  }
}
NI void ph_branch(const Params& p) {
  EpiBf16 epi{p.MERGED, D};
  gemm_phase<true>(p.YS, 1536, p.WB, 1536, 1536, D, g_smem, epi, p.Z + 3584);
}
NI void ph_outproj(const Params& p, int l) {
  EpiResid epi{&p, l, 2048, l == 0};
  gemm_phase<false>(p.MERGED, D, p.WO, D, D, D, g_smem, epi, nullptr);
}
NI void ph_normmod2(const Params& p, int l) {
  const int nb = gridDim.x, bid = bidx(), wid = tidx() >> 6;
  for (int row = (bid * NWAVES + wid) * 2; row < NTOK; row += nb * NWAVES * 2) normmod_row2(p, l, 1, row, p.X + (size_t)row * D);
}
NI void ph_up(const Params& p) {
  EpiBf16 epi{p.U, 2 * DFF};
  gemm_phase<false>(p.H, D, p.WU, D, D, 2 * DFF, g_smem, epi, nullptr);
}
NI void ph_act(const Params& p, int l) {
  const int nb = gridDim.x, bid = bidx();
  for (int it = bid; it < (NTOK / 4) * 352 / NTHREADS; it += nb) act_item(p, l, it);
}
NI void ph_down(const Params& p, int l) {
  EpiResid epi{&p, l, 5120, false};
  gemm_phase<false>(p.ACT, DFF, p.WD, DFF, DFF, D, g_smem, epi, nullptr);
}

DI void run_phase(const Params& p, int ph) {
  if (ph == 0) { ph_prep0(p); return; }
  if (ph == 19) { ph_final(p); return; }
  const int l = (ph - 1) / 9, s = (ph - 1) % 9;
  switch (s) {
    case 0: ph_normmod1(p, l); break;
    case 1: ph_inproj(p, l); break;
    case 2:
      ph_attn(p, l);
#ifdef REP_ATTN
      if (l == 0) ph_attn(p, l);
#endif
      ph_convpool(p, l);
#ifdef REP_CONVPOOL
      if (l == 0) ph_convpool(p, l);
#endif
      break;
    case 3: ph_branch(p); break;
    case 4: ph_outproj(p, l); break;
    case 5: ph_normmod2(p, l); break;
    case 6: ph_up(p); break;
    case 7: ph_act(p, l); break;
    case 8: ph_down(p, l); break;
  }
}


#define XB_TMO      128
#define XB_XCNT(j)  (256  + 64 * (j))
#define XB_XSUB(j)  (1280 + 64 * (j))
#define XB_XGEN(j)  (2304 + 64 * (j))
#define XB_TOP      3328
#define XB_TOPGEN   3392
#define XCD_BAR_WORDS 3456
#define XB_SPIN_CAP (1u << 20)
DI unsigned xb_ld(unsigned* p) { return __hip_atomic_load(p, __ATOMIC_RELAXED, __HIP_MEMORY_SCOPE_AGENT); }
DI unsigned xb_add(unsigned* p, unsigned v) { return __hip_atomic_fetch_add(p, v, __ATOMIC_RELAXED, __HIP_MEMORY_SCOPE_AGENT); }
DI unsigned xb_xcc_id() { return (unsigned)__builtin_amdgcn_s_getreg((3 << 11) | 20) & 0xFu; }
#define XB_SPIN(cond, bar) do { unsigned _sp = 0; while (cond) { __builtin_amdgcn_s_sleep(1); \
    if ((++_sp & 255u) == 0u) { if (xb_ld(&(bar)[XB_TMO])) break; if (_sp > XB_SPIN_CAP) { atomicAdd(&(bar)[XB_TMO], 1u); break; } } } } while (0)
struct XcdBarrier { unsigned* bar; unsigned x, nloc, nx; };
DI XcdBarrier xcd_barrier_post(unsigned* bar) {
  XcdBarrier b; b.bar = bar; b.x = xb_xcc_id(); b.nloc = 0u; b.nx = 0u;
  if (threadIdx.x == 0) (void)xb_add(&bar[XB_XCNT(b.x)], 1u);
  return b;
}
DI void xcd_barrier_complete(unsigned* bar, unsigned x, unsigned& nloc, unsigned& nx) {
  const unsigned G = gridDim.x;
  unsigned sum, cnt, mine, sp = 0u;
  for (;;) {
    sum = 0u; cnt = 0u; mine = 0u;
#pragma unroll
    for (unsigned j = 0; j < 16; ++j) { const unsigned c = xb_ld(&bar[XB_XCNT(j)]); sum += c; cnt += (c > 0u) ? 1u : 0u; mine = (j == x) ? c : mine; }
    if (sum == G) break;
    __builtin_amdgcn_s_sleep(1);
    if ((++sp & 255u) == 0u) { if (xb_ld(&bar[XB_TMO])) break; if (sp > XB_SPIN_CAP) { atomicAdd(&bar[XB_TMO], 1u); break; } }
  }
  nloc = mine > 0u ? mine : 1u; nx = cnt > 0u ? cnt : 1u;
}
DI void xcd_barrier(XcdBarrier& b) {
  asm volatile("s_waitcnt vmcnt(0)" ::: "memory");
  __syncthreads();
  if (threadIdx.x == 0) {
    unsigned* bar = b.bar;
    __builtin_amdgcn_s_waitcnt(0);
    if (b.nloc == 0u) xcd_barrier_complete(bar, b.x, b.nloc, b.nx);
    const unsigned nloc = b.nloc, nx = b.nx;
    const unsigned old = xb_add(&bar[XB_XSUB(b.x)], 1u);
    const unsigned gen = old / nloc;
    if (old + 1u == (gen + 1u) * nloc) {
      __builtin_amdgcn_fence(__ATOMIC_RELEASE, "agent");
      asm volatile("s_waitcnt vmcnt(0)" ::: "memory");
      const unsigned og = xb_add(&bar[XB_TOP], 1u);
      const unsigned tg = og / nx;
      if (og + 1u == (tg + 1u) * nx) xb_add(&bar[XB_TOPGEN], 1u);
      else XB_SPIN(xb_ld(&bar[XB_TOPGEN]) == tg, bar);
      __builtin_amdgcn_fence(__ATOMIC_ACQUIRE, "agent");
      xb_add(&bar[XB_XGEN(b.x)], 1u);
      asm volatile("s_waitcnt vmcnt(0)" ::: "memory");
    } else {
      XB_SPIN(xb_ld(&bar[XB_XGEN(b.x)]) == gen, bar);
      __builtin_amdgcn_fence(__ATOMIC_ACQUIRE, "agent");
      asm volatile("s_waitcnt vmcnt(0)" ::: "memory");
    }
  }
  __syncthreads();
}

__global__ void __launch_bounds__(NTHREADS, 2) mega_kernel(Params p, int ph_lo, int ph_hi) {
  cg::grid_group grid = cg::this_grid();
  XcdBarrier xb = xcd_barrier_post(p.BAR);
#ifndef REPEAT_MASK
#define REPEAT_MASK 0u
#endif
  for (int ph = ph_lo; ph < ph_hi; ++ph) {
    run_phase(p, ph);
    if ((REPEAT_MASK >> ph) & 1u) {
      xcd_barrier(xb);
      run_phase(p, ph);
    }
    if (ph + 1 < ph_hi) xcd_barrier(xb);
  }
  if (ph_hi > 1000) grid.sync();
}

extern "C" void kernel_launch(void* const* d_in, const int* in_sizes, int n_in, void* d_out, int out_size, void* d_ws,
                              size_t ws_size, hipStream_t stream) {
  static int grid_blocks = 0;
  if (!grid_blocks) {
    int dev = 0, cus = 0, per_cu = 0;
    (void)hipGetDevice(&dev);
    (void)hipDeviceGetAttribute(&cus, hipDeviceAttributeMultiprocessorCount, dev);
    (void)hipFuncSetAttribute((const void*)mega_kernel, hipFuncAttributeMaxDynamicSharedMemorySize, LDS_BYTES);
    (void)hipOccupancyMaxActiveBlocksPerMultiprocessor(&per_cu, mega_kernel, NTHREADS, LDS_BYTES);
    if (per_cu < 1) fprintf(stderr, "occupancy query reports %d blocks/CU\n", per_cu);
    grid_blocks = cus;
  }
  Params p{};
  const float** f = (const float**)&p;
  for (int i = 0; i < 20; ++i) f[i] = (const float*)d_in[i];
  p.out = (float*)d_out;
  char* ws = (char*)d_ws;
  size_t off = 0;
  auto take = [&](size_t bytes) { char* r = ws + off; off += (bytes + 255) & ~(size_t)255; return r; };
  p.BAR = (unsigned*)take(XCD_BAR_WORDS * 4);
  p.MOD = (float*)take(2 * 5 * 6144 * 4);
  p.X = (float*)take((size_t)NTOK * D * 4);
  p.KC = (bf16_t*)take((size_t)64 * 16384 * 2);
  p.VCT = (bf16_t*)take((size_t)64 * 16384 * 2);
  p.WIN = (bf16_t*)take((size_t)INW * D * 2);
  p.WB = (bf16_t*)take((size_t)D * 1536 * 2);
  p.WO = (bf16_t*)take((size_t)D * D * 2);
  p.WU = (bf16_t*)take((size_t)2 * DFF * D * 2);
  p.WD = (bf16_t*)take((size_t)D * DFF * 2);
  p.H = (bf16_t*)take((size_t)NTOK * D * 2);
  p.Z = (bf16_t*)take((size_t)NTOK * INW * 2);
  p.U = p.Z;
  char* r2 = take((size_t)NTOK * 1536 * 2 + (size_t)NTOK * D * 2 + (size_t)512 * NTOK * 2);
  p.YS = (bf16_t*)r2;
  p.MERGED = (bf16_t*)(r2 + (size_t)NTOK * 1536 * 2);
  p.VT = (bf16_t*)(r2 + (size_t)NTOK * 1536 * 2 + (size_t)NTOK * D * 2);
  p.ACT = (bf16_t*)r2;
  (void)hipMemsetAsync(p.BAR, 0, XCD_BAR_WORDS * 4, stream);
#ifndef MULTI_LAUNCH
#define MULTI_LAUNCH 0
#endif
#if MULTI_LAUNCH
  for (int ph = 0; ph < N_PHASES; ++ph) mega_kernel<<<dim3(grid_blocks), dim3(NTHREADS), LDS_BYTES, stream>>>(p, ph, ph + 1);
#else
  int lo = 0, hi = N_PHASES;
  void* args[] = {&p, &lo, &hi};
  hipError_t e = hipLaunchCooperativeKernel((void*)mega_kernel, dim3(grid_blocks), dim3(NTHREADS), args, LDS_BYTES, stream);
  if (e != hipSuccess) fprintf(stderr, "cooperative launch failed: %s (grid %d)\n", hipGetErrorString(e), grid_blocks);
#endif
}
```

```cpp
#include <hip/hip_runtime.h>
#include <hip/hip_cooperative_groups.h>
#include <cstdio>
namespace cg = cooperative_groups;

typedef unsigned short bf16_t;
typedef short bf16x8 __attribute__((ext_vector_type(8)));
typedef float f32x4 __attribute__((ext_vector_type(4)));
typedef unsigned u32x4 __attribute__((ext_vector_type(4)));
typedef unsigned u32x2 __attribute__((ext_vector_type(2)));

#define DI __device__ __forceinline__
DI int tidx() { int t = threadIdx.x; asm volatile("" : "+v"(t)); return t; }
DI int bidx() { int b = blockIdx.x; asm volatile("" : "+s"(b)); return b; }

constexpr int D = 1024, NTOK = 8192, NCTX = 4096, INW = 6656, DFF = 2816;
constexpr int NTHREADS = 512, NWAVES = 8;
constexpr int LDS_BYTES = 147456;

struct Params {
  const float *x_prompt, *x_sample, *cache_kv, *c, *c_ctx, *w_mod, *b_mod, *g1, *g2, *w_in, *conv_w, *rpb, *pool_w,
      *pool_scale, *w_branch, *w_out, *w_up, *f_conv, *w_down, *g_final;
  float* out;
  float* MOD;
  float* X;
  unsigned* BAR;
  bf16_t *KC, *VCT, *WIN, *WB, *WO, *WU, *WD, *H, *Z, *U, *YS, *MERGED, *VT, *ACT;
};

typedef float f32x2 __attribute__((ext_vector_type(2)));
typedef __bf16 bf16x2_t __attribute__((ext_vector_type(2)));
DI unsigned cvt_pk_bf16(float lo, float hi) {
  const f32x2 v = {lo, hi};
  return __builtin_bit_cast(unsigned, __builtin_convertvector(v, bf16x2_t));
}
DI float bf_lo(unsigned u) { return __uint_as_float(u << 16); }
DI float bf_hi(unsigned u) { return __uint_as_float(u & 0xffff0000u); }
DI float wave_sum(float v) {
#pragma unroll
  for (int o = 32; o > 0; o >>= 1) v += __shfl_xor(v, o);
  return v;
}
DI const float* xin_row(const Params& p, int row) {
  return row < NCTX ? p.x_prompt + (size_t)row * D : p.x_sample + (size_t)(row - NCTX) * D;
}
DI int vec_of_row(int row) { return row < NCTX ? 0 : 1 + ((row - NCTX) >> 10); }
DI bool seq_first(int row) { return row < NCTX ? ((row & 255) == 0) : ((row & 1023) == 0); }
DI bool seq_last(int row) { return row < NCTX ? ((row & 255) == 255) : ((row & 1023) == 1023); }

DI void transpose_tile(const float* __restrict__ src, int srcld, bf16_t* __restrict__ dst, int dstld, int kt, int nt,
                       float* sm) {
  const int t = tidx();
  const float* s = src + (size_t)(kt * 128) * srcld + nt * 64;
#pragma unroll
  for (int i = 0; i < 4; ++i) {
    const int row = (t >> 4) + 32 * i, c4 = (t & 15) * 4;
    const f32x4 v = *(const f32x4*)(s + (size_t)row * srcld + c4);
    sm[row * 65 + c4 + 0] = v[0];
    sm[row * 65 + c4 + 1] = v[1];
    sm[row * 65 + c4 + 2] = v[2];
    sm[row * 65 + c4 + 3] = v[3];
  }
  __syncthreads();
  const int n = t >> 3, ks = (t & 7) * 16;
  u32x4 w0, w1;
#pragma unroll
  for (int j = 0; j < 4; ++j) {
    w0[j] = cvt_pk_bf16(sm[(ks + 2 * j) * 65 + n], sm[(ks + 2 * j + 1) * 65 + n]);
    w1[j] = cvt_pk_bf16(sm[(ks + 8 + 2 * j) * 65 + n], sm[(ks + 8 + 2 * j + 1) * 65 + n]);
  }
  bf16_t* d = dst + (size_t)(nt * 64 + n) * dstld + kt * 128 + ks;
  *(u32x4*)d = w0;
  *(u32x4*)(d + 8) = w1;
  __syncthreads();
}

constexpr int PREP_T_IN = 8 * 104, PREP_T_BR = 2 * 4 * 16, PREP_T_OUT = 8 * 16, PREP_T_UP = 8 * 88,
              PREP_T_DN = 22 * 16, PREP_WEFF = 128;
constexpr int PREP_ITEMS = PREP_T_IN + PREP_T_BR + PREP_T_OUT + PREP_T_UP + PREP_T_DN + PREP_WEFF;

DI void prep_transposes(const Params& p, int l, int it, float* sm) {
  if (it < PREP_T_IN) {
    transpose_tile(p.w_in + (size_t)l * D * INW, INW, p.WIN, D, it / 104, it % 104, sm);
    return;
  }
  it -= PREP_T_IN;
  if (it < PREP_T_BR) {
    const int i = it >> 6, r = it & 63;
    transpose_tile(p.w_branch + (size_t)(l * 3 + i) * 512 * D, D, p.WB + i * 512, 1536, r >> 4, r & 15, sm);
    return;
  }
  it -= PREP_T_BR;
  if (it < PREP_T_OUT) {
    transpose_tile(p.w_out + (size_t)l * D * D, D, p.WO, D, it >> 4, it & 15, sm);
    return;
  }
  it -= PREP_T_OUT;
  if (it < PREP_T_UP) {
    transpose_tile(p.w_up + (size_t)l * D * 2 * DFF, 2 * DFF, p.WU, D, it / 88, it % 88, sm);
    return;
  }
  it -= PREP_T_UP;
  if (it < PREP_T_DN) {
    transpose_tile(p.w_down + (size_t)l * DFF * D, D, p.WD, DFF, it >> 4, it & 15, sm);
    return;
  }
}

DI void prep_item(const Params& p, int l, int it, float* sm) {
  if (it < PREP_WEFF) {
    const int g = it >> 5, cb = (it >> 1) & 15, db = it & 1;
    const int t = tidx();
    const int dd = db * 512 + t;
    const float* wb2 = p.w_branch + (size_t)(l * 3 + 2) * 512 * D + (size_t)(g * 128) * D + dd;
    for (int i = t; i < 1024; i += NTHREADS) {
      const int e = i >> 3, c = i & 7;
      sm[i] = p.pool_w[((size_t)(l * 4 + g) * 128 + cb * 8 + c) * 128 + e] * p.pool_scale[l * 512 + g * 128 + e];
    }
    __syncthreads();
    float acc[8];
#pragma unroll
    for (int c = 0; c < 8; ++c) acc[c] = 0.f;
#pragma unroll 16
    for (int e = 0; e < 128; ++e) {
      const float w = wb2[(size_t)e * D];
      const f32x4 s0 = *(const f32x4*)(sm + e * 8), s1 = *(const f32x4*)(sm + e * 8 + 4);
#pragma unroll
      for (int c = 0; c < 4; ++c) { acc[c] += s0[c] * w; acc[4 + c] += s1[c] * w; }
    }
    u32x4 o;
#pragma unroll
    for (int j = 0; j < 4; ++j) o[j] = cvt_pk_bf16(acc[2 * j], acc[2 * j + 1]);
    *(u32x4*)(p.WB + (size_t)dd * 1536 + 1024 + g * 128 + cb * 8) = o;
    __syncthreads();
  }
  else {
    it -= PREP_WEFF;
    prep_transposes(p, l, it, sm);
  }
}

constexpr int MOD_ITEMS = 2 * 96;
DI void mod_item(const Params& p, int it, float* sm) {
  const int t = tidx();
  const int l = it / 96, cb = it % 96;
  float* red = sm + 5 * 1024;
  for (int i = t; i < 5 * 1024; i += NTHREADS) {
    const int v = i >> 10, k = i & 1023;
    const float cv = (v == 0) ? p.c_ctx[k] : p.c[(v - 1) * D + k];
    sm[i] = cv / (1.f + __expf(-cv));
  }
  __syncthreads();
  const int kg = t >> 4, ct = t & 15;
  f32x4 acc[5];
#pragma unroll
  for (int v = 0; v < 5; ++v) acc[v] = (f32x4){0.f, 0.f, 0.f, 0.f};
  const float* w = p.w_mod + ((size_t)l * D + kg * 32) * 6144 + cb * 64 + ct * 4;
#pragma unroll 8
  for (int kk = 0; kk < 32; ++kk) {
    const f32x4 wv = *(const f32x4*)(w + (size_t)kk * 6144);
#pragma unroll
    for (int v = 0; v < 5; ++v) acc[v] += sm[v * 1024 + kg * 32 + kk] * wv;
  }
#pragma unroll
  for (int v = 0; v < 5; ++v)
#pragma unroll
    for (int j = 0; j < 4; ++j) red[(kg * 5 + v) * 64 + ct * 4 + j] = acc[v][j];
  __syncthreads();
  for (int i = t; i < 320; i += NTHREADS) {
    const int v = i >> 6, c = i & 63;
    float s = p.b_mod[l * 6144 + cb * 64 + c];
#pragma unroll
    for (int g = 0; g < 32; ++g) s += red[(g * 5 + v) * 64 + c];
    p.MOD[(size_t)(l * 5 + v) * 6144 + cb * 64 + c] = s;
  }
  __syncthreads();
}

constexpr int CACHE_ITEMS = 32;
DI void cache_item(const Params& p, int it) {
  const int t = tidx() & 255;
  it = it * 2 + (tidx() >> 8);
  const int b = it >> 4, l = (it >> 3) & 1, h = it & 7;
  const float* ks = p.cache_kv + ((size_t)(((b * 2 + l) * 2 + 0) * 8 + h)) * 16384;
  const float* vs = p.cache_kv + ((size_t)(((b * 2 + l) * 2 + 1) * 8 + h)) * 16384;
  bf16_t* kd = p.KC + (size_t)((b * 2 + l) * 8 + h) * 16384;
  bf16_t* vd = p.VCT + (size_t)((b * 2 + l) * 8 + h) * 16384;
#pragma unroll 4
  for (int i = 0; i < 16; ++i) {
    const int e = (i * 256 + t) * 4;
    const f32x4 v = *(const f32x4*)(ks + e);
    u32x2 o;
    o[0] = cvt_pk_bf16(v[0], v[1]);
    o[1] = cvt_pk_bf16(v[2], v[3]);
    *(u32x2*)(kd + e) = o;
  }
#pragma unroll 4
  for (int d = 0; d < 64; d += 4) {
    const f32x4 v = *(const f32x4*)(vs + t * 64 + d);
#pragma unroll
    for (int j = 0; j < 4; ++j) vd[(d + j) * 256 + t] = (bf16_t)(cvt_pk_bf16(v[j], 0.f) & 0xffffu);
  }
}

DI void normmod_row2(const Params& p, int l, int which, int row, const float* xr) {
  const int lane = tidx() & 63;
  f32x4 v[2][4];
  float ss[2] = {0.f, 0.f};
#pragma unroll
  for (int r = 0; r < 2; ++r)
#pragma unroll
    for (int i = 0; i < 4; ++i) v[r][i] = *(const f32x4*)(xr + r * D + i * 256 + lane * 4);
#pragma unroll
  for (int r = 0; r < 2; ++r) {
#pragma unroll
    for (int i = 0; i < 4; ++i)
      ss[r] += v[r][i][0] * v[r][i][0] + v[r][i][1] * v[r][i][1] + v[r][i][2] * v[r][i][2] + v[r][i][3] * v[r][i][3];
    ss[r] = wave_sum(ss[r]);
  }
  const float* g = (which == 0 ? p.g1 : p.g2) + l * D;
  const float* mod = p.MOD + (size_t)(l * 5 + vec_of_row(row)) * 6144 + which * 3072;
#pragma unroll
  for (int i = 0; i < 4; ++i) {
    const int col = i * 256 + lane * 4;
    const f32x4 gg = *(const f32x4*)(g + col);
    const f32x4 sh = *(const f32x4*)(mod + col);
    const f32x4 sc = *(const f32x4*)(mod + 1024 + col);
#pragma unroll
    for (int r = 0; r < 2; ++r) {
      const float rstd = rsqrtf(ss[r] * (1.f / 1024.f) + 1e-6f);
      f32x4 h;
#pragma unroll
      for (int j = 0; j < 4; ++j) h[j] = v[r][i][j] * rstd * gg[j] * (1.f + sc[j]) + sh[j];
      u32x2 o;
      o[0] = cvt_pk_bf16(h[0], h[1]);
      o[1] = cvt_pk_bf16(h[2], h[3]);
      *(u32x2*)(p.H + (size_t)(row + r) * D + col) = o;
    }
  }
}

constexpr int STAGE_BYTES = 49152;
#ifdef EXP_B
#define EXP_B_EXTRA gemm_stage<256>(A, lda, (4 * x + (pj & 3)) * 256, pt * 64, dst, tid); gemm_stage<128>(Bt, ldb, (pj >> 2) * 128, pt * 64, dst + 32768, tid);
#define VM_STAGE "12"
#else
#define EXP_B_EXTRA
#define VM_STAGE "6"
#endif
template <int ROWS>
DI void gemm_stage(const bf16_t* __restrict__ A, int lda, int row0, int k0, char* s, int t) {
  const int cp = t & 7, rr = t >> 3, c = cp ^ (rr & 7);
#pragma unroll
  for (int i = 0; i < ROWS / 64; ++i)
    __builtin_amdgcn_global_load_lds((const unsigned*)(A + (size_t)(row0 + rr + 64 * i) * lda + k0 + c * 8),
                                     (unsigned*)(s + t * 16 + i * 8192), 16, 0, 0);
}
DI void gemm_compute(const char* sA, const char* sB, f32x4 (&acc)[4][4], int wm, int wn, int lane) {
  const int fr = lane & 15, fq = lane >> 4;
#pragma unroll
  for (int ks = 0; ks < 2; ++ks) {
    bf16x8 a[4], b[4];
    const int sw = ((ks * 4 + fq) ^ (fr & 7)) << 4;
#pragma unroll
    for (int ni = 0; ni < 4; ++ni) b[ni] = *(const bf16x8*)(sB + (wn * 64 + ni * 16 + fr) * 128 + sw);
#pragma unroll
    for (int mi = 0; mi < 4; ++mi) a[mi] = *(const bf16x8*)(sA + (wm * 64 + mi * 16 + fr) * 128 + sw);
    __builtin_amdgcn_sched_barrier(0);
#pragma unroll
    for (int mi = 0; mi < 4; ++mi)
#pragma unroll
      for (int ni = 0; ni < 4; ++ni)
        acc[mi][ni] = __builtin_amdgcn_mfma_f32_16x16x32_bf16(b[ni], a[mi], acc[mi][ni], 0, 0, 0);
    __builtin_amdgcn_sched_barrier(0);
  }
}

template <bool GATED, class Epi>
DI void gemm_phase(const bf16_t* __restrict__ A, int lda, const bf16_t* __restrict__ Bt, int ldb, int K, int N,
                   char* smem, const Epi& epi, const bf16_t* gates) {
  const int tid = tidx();
  const int wid = tid >> 6, lane = tid & 63, wm = wid >> 1, wn = wid & 1;
  const int fr = lane & 15, fq = lane >> 4;
  const int bid = bidx(), nb = gridDim.x;
  const int nN = N >> 7, nt = K >> 6;
  const int x = bid & 7, per_x = 4 * nN, cstep = nb >> 3;
  int pj = bid >> 3, pt = 0, ps = 0;
#define GEMM_ISSUE()                                                                                          \
  do {                                                                                                        \
    if (pj < per_x) {                                                                                         \
      char* dst = smem + ps * STAGE_BYTES;                                                                    \
      gemm_stage<256>(A, lda, (4 * x + (pj & 3)) * 256, pt * 64, dst, tid);                                   \
      gemm_stage<128>(Bt, ldb, (pj >> 2) * 128, pt * 64, dst + 32768, tid);                                   \
      EXP_B_EXTRA                                                                                             \
      if (++pt == nt) { pt = 0; pj += cstep; }                                                                \
      ps = (ps == 2) ? 0 : ps + 1;                                                                            \
    }                                                                                                         \
  } while (0)
  GEMM_ISSUE();
  GEMM_ISSUE();
  int cs = 0;
  for (int cj = bid >> 3; cj < per_x; cj += cstep) {
    const int row0 = (4 * x + (cj & 3)) * 256, col0 = (cj >> 2) * 128;
    f32x4 acc[4][4];
    f32x4 tot[4][4];
#pragma unroll
    for (int mi = 0; mi < 4; ++mi)
#pragma unroll
      for (int ni = 0; ni < 4; ++ni) {
        acc[mi][ni] = (f32x4){0.f, 0.f, 0.f, 0.f};
        if (GATED) tot[mi][ni] = (f32x4){0.f, 0.f, 0.f, 0.f};
      }
    const bool last_tile = cj + cstep >= per_x;
    for (int t = 0; t < nt; ++t) {
      if (last_tile && t == nt - 1) asm volatile("s_waitcnt vmcnt(0)" ::: "memory");
      else asm volatile("s_waitcnt vmcnt(" VM_STAGE ")" ::: "memory");
      __builtin_amdgcn_s_barrier();
      GEMM_ISSUE();
      const char* cur = smem + cs * STAGE_BYTES;
      gemm_compute(cur, cur + 32768, acc, wm, wn, lane);
      cs = (cs == 2) ? 0 : cs + 1;
      if (GATED && ((t & 7) == 7)) {
        const int seg = t >> 3;
        int gofs = (row0 + wm * 64 + fr) * INW + seg * 1024 + col0 + wn * 64 + fq * 4;
        asm volatile("" : "+v"(gofs));
#pragma unroll
        for (int mi = 0; mi < 4; ++mi)
#pragma unroll
          for (int ni = 0; ni < 4; ++ni) {
            const u32x2 g = *(const u32x2*)(gates + (gofs + mi * 16 * INW + ni * 16));
            tot[mi][ni][0] += bf_lo(g[0]) * acc[mi][ni][0];
            tot[mi][ni][1] += bf_hi(g[0]) * acc[mi][ni][1];
            tot[mi][ni][2] += bf_lo(g[1]) * acc[mi][ni][2];
            tot[mi][ni][3] += bf_hi(g[1]) * acc[mi][ni][3];
            acc[mi][ni] = (f32x4){0.f, 0.f, 0.f, 0.f};
          }
      }
    }
#pragma unroll
    for (int mi = 0; mi < 4; ++mi)
#pragma unroll
      for (int ni = 0; ni < 4; ++ni) {
        const int row = row0 + wm * 64 + mi * 16 + fr, col = col0 + wn * 64 + ni * 16 + fq * 4;
        epi(row, col, GATED ? tot[mi][ni] : acc[mi][ni]);
      }
  }
#undef GEMM_ISSUE
  __syncthreads();
}

DI void store_bf16x4(bf16_t* d, f32x4 v) {
  u32x2 o;
  o[0] = cvt_pk_bf16(v[0], v[1]);
  o[1] = cvt_pk_bf16(v[2], v[3]);
  *(u32x2*)d = o;
}

struct EpiZ {
  bf16_t* Z; bf16_t* VT; float* kv; int l;
  DI void operator()(int row, int col, f32x4 v) const {
    const int colt = __builtin_amdgcn_readfirstlane(col) & ~127;
    if (colt >= 3584) {
#pragma unroll
      for (int j = 0; j < 4; ++j) v[j] = __builtin_amdgcn_rcpf(1.f + __expf(-v[j]));
    }
    store_bf16x4(Z + (size_t)row * INW + col, v);
    if (colt >= 2048 && colt < 3072) {
      const int which = (colt - 2048) >> 9, hd = (col - 2048) & 511;
      if (row < NCTX) {
        const int b = row >> 8, s = row & 255, hh = hd >> 6, d = hd & 63;
        *(f32x4*)(kv + ((size_t)((((b * 2 + l) * 2 + which) * 8 + hh) * 256 + s)) * 64 + d) = v;
      }
      if (which == 1) {
#pragma unroll
        for (int j = 0; j < 4; ++j)
          VT[(((size_t)(hd >> 6) * 256 + (row >> 5)) * 64 + (hd & 63) + j) * 32 + (row & 31)] = (bf16_t)(cvt_pk_bf16(v[j], 0.f) & 0xffffu);
      }
    }
  }
};
struct EpiBf16 {
  bf16_t* O; int ld;
  DI void operator()(int row, int col, f32x4 v) const { store_bf16x4(O + (size_t)row * ld + col, v); }
};
struct EpiResid {
  const Params* p; int l; int gate_off; bool from_input;
  DI void operator()(int row, int col, f32x4 v) const {
    const float* xi = from_input ? xin_row(*p, row) + col : p->X + (size_t)row * D + col;
    const f32x4 x = *(const f32x4*)xi;
    const f32x4 g = *(const f32x4*)(p->MOD + (size_t)(l * 5 + vec_of_row(row)) * 6144 + gate_off + col);
    f32x4 o;
#pragma unroll
    for (int j = 0; j < 4; ++j) o[j] = x[j] + g[j] * v[j];
    *(f32x4*)(p->X + (size_t)row * D + col) = o;
  }
};

template <bool LATBIAS>
DI void attn_chunk(const bf16x8 qf0, const bf16x8 qf1, const bf16_t* __restrict__ kbase, int kstride,
                   const bf16_t* __restrict__ vtbase, int vstride, int tk0, int tk1, int tk2, int tk3,
                   const float* __restrict__ rpb_h, int dr0, int band, int qc, float& m, float& lsum,
                   f32x4 (&o)[4], int lane) {
  const int fr = lane & 15, fq = lane >> 4;
  f32x4 s[4];
#pragma unroll
  for (int T = 0; T < 4; ++T) {
    const int tk = (T == 0 ? tk0 : T == 1 ? tk1 : T == 2 ? tk2 : tk3);
    const bf16_t* kp = kbase + (size_t)(tk + fr) * kstride + fq * 8;
    const bf16x8 k0 = *(const bf16x8*)kp;
    const bf16x8 k1 = *(const bf16x8*)(kp + 32);
    f32x4 z = (f32x4){0.f, 0.f, 0.f, 0.f};
    z = __builtin_amdgcn_mfma_f32_16x16x32_bf16(k0, qf0, z, 0, 0, 0);
    z = __builtin_amdgcn_mfma_f32_16x16x32_bf16(k1, qf1, z, 0, 0, 0);
    s[T] = z;
  }
  float cmax = -INFINITY;
#pragma unroll
  for (int T = 0; T < 4; ++T) {
#pragma unroll
    for (int j = 0; j < 4; ++j) {
      float v = s[T][j] * 0.125f;
      if (LATBIAS) {
        const int kc = band + (T & 1) * 16 + fq * 4 + j;
        const int cs = min(max(qc - 8, 0), 48);
        const bool valid = (kc >= cs) && (kc < cs + 16);
        const int dr = dr0 + (T >> 1);
        const int dc = min(max(kc - qc + 15, 0), 30);
        v = valid ? v + rpb_h[dr * 31 + dc] : -INFINITY;
      }
      s[T][j] = v;
      cmax = fmaxf(cmax, v);
    }
  }
  cmax = fmaxf(cmax, __shfl_xor(cmax, 16));
  cmax = fmaxf(cmax, __shfl_xor(cmax, 32));
  const float mnew = fmaxf(m, cmax);
  const float alpha = __expf(m - mnew);
  m = mnew;
  float ps = 0.f;
#pragma unroll
  for (int T = 0; T < 4; ++T)
#pragma unroll
    for (int j = 0; j < 4; ++j) {
      const float pv = __expf(s[T][j] - mnew);
      s[T][j] = pv;
      ps += pv;
    }
  lsum = lsum * alpha + ps;
#pragma unroll
  for (int dt = 0; dt < 4; ++dt) o[dt] *= alpha;
#pragma unroll
  for (int pr = 0; pr < 2; ++pr) {
    u32x4 pk;
    pk[0] = cvt_pk_bf16(s[2 * pr][0], s[2 * pr][1]);
    pk[1] = cvt_pk_bf16(s[2 * pr][2], s[2 * pr][3]);
    pk[2] = cvt_pk_bf16(s[2 * pr + 1][0], s[2 * pr + 1][1]);
    pk[3] = cvt_pk_bf16(s[2 * pr + 1][2], s[2 * pr + 1][3]);
    const bf16x8 pa = __builtin_bit_cast(bf16x8, pk);
    const int ta = (pr == 0 ? tk0 : tk2) + fq * 4, tb = (pr == 0 ? tk1 : tk3) + fq * 4;
#pragma unroll
    for (int dt = 0; dt < 4; ++dt) {
      const bf16_t* vp = vtbase + (dt * 16 + fr) * 32;
      const u32x2 lo = *(const u32x2*)(vp + (size_t)(ta >> 5) * 2048 + (ta & 31));
      const u32x2 hi = *(const u32x2*)(vp + (size_t)(tb >> 5) * 2048 + (tb & 31));
      u32x4 vv;
      vv[0] = lo[0]; vv[1] = lo[1]; vv[2] = hi[0]; vv[3] = hi[1];
      o[dt] = __builtin_amdgcn_mfma_f32_16x16x32_bf16(__builtin_bit_cast(bf16x8, vv), pa, o[dt], 0, 0, 0);
    }
  }
}

DI void attn_finish(bf16_t* ys_row, float lsum, const f32x4 (&o)[4], int lane) {
  const int fq = lane >> 4;
  lsum += __shfl_xor(lsum, 16);
  lsum += __shfl_xor(lsum, 32);
  const float inv = 1.f / lsum;
#pragma unroll
  for (int dt = 0; dt < 4; ++dt) store_bf16x4(ys_row + dt * 16 + fq * 4, o[dt] * inv);
}

constexpr int ATT_VROW = 528, ATT_SV_OFF = 32768;
template <bool VTILED>
DI void attn_stage_kv(const bf16_t* __restrict__ kbase, int kstride, int ktok0, const bf16_t* __restrict__ vtbase,
                      int vstride, int vtok0, char* smem, int tid) {
  gemm_stage<256>(kbase, kstride, ktok0, 0, smem, tid);
  const int d = tid >> 3, seg = tid & 7;
  const bf16_t* vp = VTILED ? vtbase + ((size_t)((vtok0 >> 5) + seg) * 64 + d) * 32
                            : vtbase + (size_t)d * vstride + vtok0 + seg * 32;
  char* dst = smem + ATT_SV_OFF + d * ATT_VROW + seg * 64;
#pragma unroll
  for (int i = 0; i < 4; ++i) *(u32x4*)(dst + i * 16) = *(const u32x4*)(vp + i * 8);
}
DI void attn_chunk_lds(const bf16x8 qf0, const bf16x8 qf1, const char* sK, const char* sV, int t0, float& m,
                       float& lsum, f32x4 (&o)[4], int lane) {
  const int fr = lane & 15, fq = lane >> 4;
  f32x4 s[4];
#pragma unroll
  for (int T = 0; T < 4; ++T) {
    const char* kp = sK + (t0 + T * 16 + fr) * 128;
    const bf16x8 k0 = *(const bf16x8*)(kp + ((fq ^ (fr & 7)) << 4));
    const bf16x8 k1 = *(const bf16x8*)(kp + (((4 + fq) ^ (fr & 7)) << 4));
    f32x4 z = (f32x4){0.f, 0.f, 0.f, 0.f};
    z = __builtin_amdgcn_mfma_f32_16x16x32_bf16(k0, qf0, z, 0, 0, 0);
    z = __builtin_amdgcn_mfma_f32_16x16x32_bf16(k1, qf1, z, 0, 0, 0);
    s[T] = z;
  }
  float cmax = -INFINITY;
#pragma unroll
  for (int T = 0; T < 4; ++T)
#pragma unroll
    for (int j = 0; j < 4; ++j) {
      s[T][j] *= 0.125f;
      cmax = fmaxf(cmax, s[T][j]);
    }
  cmax = fmaxf(cmax, __shfl_xor(cmax, 16));
  cmax = fmaxf(cmax, __shfl_xor(cmax, 32));
  const float mnew = fmaxf(m, cmax);
  const float alpha = __expf(m - mnew);
  m = mnew;
  float ps = 0.f;
#pragma unroll
  for (int T = 0; T < 4; ++T)
#pragma unroll
    for (int j = 0; j < 4; ++j) {
      const float pv = __expf(s[T][j] - mnew);
      s[T][j] = pv;
      ps += pv;
    }
  lsum = lsum * alpha + ps;
#pragma unroll
  for (int dt = 0; dt < 4; ++dt) o[dt] *= alpha;
#pragma unroll
  for (int pr = 0; pr < 2; ++pr) {
    u32x4 pk;
    pk[0] = cvt_pk_bf16(s[2 * pr][0], s[2 * pr][1]);
    pk[1] = cvt_pk_bf16(s[2 * pr][2], s[2 * pr][3]);
    pk[2] = cvt_pk_bf16(s[2 * pr + 1][0], s[2 * pr + 1][1]);
    pk[3] = cvt_pk_bf16(s[2 * pr + 1][2], s[2 * pr + 1][3]);
    const bf16x8 pa = __builtin_bit_cast(bf16x8, pk);
#pragma unroll
    for (int dt = 0; dt < 4; ++dt) {
      const char* vp = sV + (dt * 16 + fr) * ATT_VROW + (t0 + pr * 32 + fq * 4) * 2;
      const u32x2 lo = *(const u32x2*)vp;
      const u32x2 hi = *(const u32x2*)(vp + 32);
      u32x4 vv;
      vv[0] = lo[0]; vv[1] = lo[1]; vv[2] = hi[0]; vv[3] = hi[1];
      o[dt] = __builtin_amdgcn_mfma_f32_16x16x32_bf16(__builtin_bit_cast(bf16x8, vv), pa, o[dt], 0, 0, 0);
    }
  }
}

DI void attn_ctx_item(const Params& p, int it, char* smem) {
  const int tid = tidx(), wid = tid >> 6, lane = tid & 63;
  const int b = it >> 4, h = (it >> 1) & 7, qt = (it & 1) * 8 + wid;
  const int fr = lane & 15, fq = lane >> 4;
  __syncthreads();
  attn_stage_kv<true>(p.Z + 2048 + h * 64, INW, b * 256, p.VT + (size_t)h * 256 * 2048, NTOK, b * 256, smem, tid);
  const int qtok = b * 256 + qt * 16 + fr;
  const bf16_t* qp = p.Z + (size_t)qtok * INW + 1536 + h * 64 + fq * 8;
  const bf16x8 qf0 = *(const bf16x8*)qp, qf1 = *(const bf16x8*)(qp + 32);
  float m = -INFINITY, lsum = 0.f;
  f32x4 o[4];
#pragma unroll
  for (int dt = 0; dt < 4; ++dt) o[dt] = (f32x4){0.f, 0.f, 0.f, 0.f};
  __syncthreads();
  for (int ch = 0; ch < 4; ++ch) attn_chunk_lds(qf0, qf1, smem, smem + ATT_SV_OFF, ch * 64, m, lsum, o, lane);
  attn_finish(p.YS + (size_t)qtok * 1536 + 512 + h * 64, lsum, o, lane);
}

DI void attn_lat_item(const Params& p, int l, int it, char* smem) {
  const int tid = tidx(), wid = tid >> 6, lane = tid & 63;
  const int b = it >> 6, h = (it >> 3) & 7, r = (it & 7) * 2 + (wid >> 2), j = wid & 3;
  const int fr = lane & 15, fq = lane >> 4;
  __syncthreads();
  {
    const size_t cb = (size_t)((b * 2 + l) * 8 + h) * 16384;
    attn_stage_kv<false>(p.KC + cb, 64, 0, p.VCT + cb, 256, 0, smem, tid);
  }
  const int qc = j * 16 + fr;
  const int qtok = NCTX + b * 1024 + r * 64 + qc;
  const bf16_t* qp = p.Z + (size_t)qtok * INW + 1536 + h * 64 + fq * 8;
  const bf16x8 qf0 = *(const bf16x8*)qp, qf1 = *(const bf16x8*)(qp + 32);
  float m = -INFINITY, lsum = 0.f;
  f32x4 o[4];
#pragma unroll
  for (int dt = 0; dt < 4; ++dt) o[dt] = (f32x4){0.f, 0.f, 0.f, 0.f};
  {
    const bf16_t* kbase = p.Z + 2048 + h * 64;
    const bf16_t* vtbase = p.VT + (size_t)h * 256 * 2048;
    const float* rpb_h = p.rpb + (size_t)(l * 8 + h) * 15 * 31;
    const int rs = min(max(r - 4, 0), 8);
    const int band = min(max(j * 16 - 8, 0), 32);
    for (int ch = 0; ch < 4; ++ch) {
      const int kr = rs + 2 * ch;
      const int t0 = NCTX + b * 1024 + kr * 64 + band;
      attn_chunk<true>(qf0, qf1, kbase, INW, vtbase, NTOK, t0, t0 + 16, t0 + 64, t0 + 80, rpb_h, kr - r + 7, band, qc,
                       m, lsum, o, lane);
    }
  }
  __syncthreads();
  for (int ch = 0; ch < 4; ++ch) attn_chunk_lds(qf0, qf1, smem, smem + ATT_SV_OFF, ch * 64, m, lsum, o, lane);
  attn_finish(p.YS + (size_t)qtok * 1536 + 512 + h * 64, lsum, o, lane);
}

DI void attn_ctx_unit(const Params& p, int u, int lane) {
  const int b = u >> 7, h = (u >> 4) & 7, qt = u & 15;
  const int fr = lane & 15, fq = lane >> 4;
  const int qtok = b * 256 + qt * 16 + fr;
  const bf16_t* qp = p.Z + (size_t)qtok * INW + 1536 + h * 64 + fq * 8;
  const bf16x8 qf0 = *(const bf16x8*)qp, qf1 = *(const bf16x8*)(qp + 32);
  const bf16_t* kbase = p.Z + 2048 + h * 64;
  const bf16_t* vtbase = p.VT + (size_t)h * 64 * NTOK;
  float m = -INFINITY, lsum = 0.f;
  f32x4 o[4];
#pragma unroll
  for (int dt = 0; dt < 4; ++dt) o[dt] = (f32x4){0.f, 0.f, 0.f, 0.f};
  for (int ch = 0; ch < 4; ++ch) {
    const int t0 = b * 256 + ch * 64;
    attn_chunk<false>(qf0, qf1, kbase, INW, vtbase, NTOK, t0, t0 + 16, t0 + 32, t0 + 48, nullptr, 0, 0, 0, m, lsum, o,
                      lane);
  }
  attn_finish(p.YS + (size_t)qtok * 1536 + 512 + h * 64, lsum, o, lane);
}

DI void attn_lat_unit(const Params& p, int l, int u, int lane) {
  const int b = u >> 9, h = (u >> 6) & 7, r = (u >> 2) & 15, j = u & 3;
  const int fr = lane & 15, fq = lane >> 4;
  const int qc = j * 16 + fr;
  const int qtok = NCTX + b * 1024 + r * 64 + qc;
  const bf16_t* qp = p.Z + (size_t)qtok * INW + 1536 + h * 64 + fq * 8;
  const bf16x8 qf0 = *(const bf16x8*)qp, qf1 = *(const bf16x8*)(qp + 32);
  float m = -INFINITY, lsum = 0.f;
  f32x4 o[4];
#pragma unroll
  for (int dt = 0; dt < 4; ++dt) o[dt] = (f32x4){0.f, 0.f, 0.f, 0.f};
  {
    const bf16_t* kbase = p.Z + 2048 + h * 64;
    const bf16_t* vtbase = p.VT + (size_t)h * 64 * NTOK;
    const float* rpb_h = p.rpb + (size_t)(l * 8 + h) * 15 * 31;
    const int rs = min(max(r - 4, 0), 8);
    const int band = min(max(j * 16 - 8, 0), 32);
    for (int ch = 0; ch < 4; ++ch) {
      const int kr = rs + 2 * ch;
      const int t0 = NCTX + b * 1024 + kr * 64 + band;
      attn_chunk<true>(qf0, qf1, kbase, INW, vtbase, NTOK, t0, t0 + 16, t0 + 64, t0 + 80, rpb_h, kr - r + 7, band, qc,
                       m, lsum, o, lane);
    }
  }
  {
    const bf16_t* kbase = p.KC + (size_t)((b * 2 + l) * 8 + h) * 16384;
    const bf16_t* vtbase = p.VCT + (size_t)((b * 2 + l) * 8 + h) * 16384;
    for (int ch = 0; ch < 4; ++ch) {
      const int t0 = ch * 64;
      attn_chunk<false>(qf0, qf1, kbase, 64, vtbase, 256, t0, t0 + 16, t0 + 32, t0 + 48, nullptr, 0, 0, 0, m, lsum, o,
                        lane);
    }
  }
  attn_finish(p.YS + (size_t)qtok * 1536 + 512 + h * 64, lsum, o, lane);
}

DI void unpack8(u32x4 u, float (&f)[8]) {
#pragma unroll
  for (int j = 0; j < 4; ++j) {
    f[2 * j] = bf_lo(u[j]);
    f[2 * j + 1] = bf_hi(u[j]);
  }
}
DI u32x4 pack8(const float (&f)[8]) {
  u32x4 o;
#pragma unroll
  for (int j = 0; j < 4; ++j) o[j] = cvt_pk_bf16(f[2 * j], f[2 * j + 1]);
  return o;
}

DI void conv_item(const Params& p, int l, int it) {
  const int t = tidx();
  const int row = it * 8 + (t >> 6), ch = (t & 63) * 8;
  const bf16_t* z = p.Z + (size_t)row * INW;
  float bg[8], a[8], b[8], acc[8];
  unpack8(*(const u32x4*)(z + ch), bg);
  const float* cw = p.conv_w + (size_t)l * 3 * 512 + ch;
  unpack8(*(const u32x4*)(z + 512 + ch), a);
  unpack8(*(const u32x4*)(z + 1024 + ch), b);
#pragma unroll
  for (int j = 0; j < 8; ++j) acc[j] = a[j] * b[j] * cw[512 + j];
  if (!seq_first(row)) {
    unpack8(*(const u32x4*)(z - INW + 512 + ch), a);
    unpack8(*(const u32x4*)(z - INW + 1024 + ch), b);
#pragma unroll
    for (int j = 0; j < 8; ++j) acc[j] += a[j] * b[j] * cw[j];
  }
  if (!seq_last(row)) {
    unpack8(*(const u32x4*)(z + INW + 512 + ch), a);
    unpack8(*(const u32x4*)(z + INW + 1024 + ch), b);
#pragma unroll
    for (int j = 0; j < 8; ++j) acc[j] += a[j] * b[j] * cw[1024 + j];
  }
#pragma unroll
  for (int j = 0; j < 8; ++j) acc[j] *= bg[j];
  *(u32x4*)(p.YS + (size_t)row * 1536 + ch) = pack8(acc);
}

DI void pool_item(const Params& p, int it) {
  const int t = tidx();
  const int row = it * 8 + (t >> 6), ch = (t & 63) * 8;
  const int g = ch >> 7, w = 2 << g;
  int seq0, seqn;
  if (row < NCTX) { seq0 = row & ~255; seqn = 256; } else { seq0 = row & ~1023; seqn = 1024; }
  const int tt = row - seq0;
  const int lo = max(tt - w / 2, 0), hi = min(tt - w / 2 + w, seqn);
  float acc[8], f[8];
#pragma unroll
  for (int j = 0; j < 8; ++j) acc[j] = 0.f;
  const bf16_t* zp = p.Z + (size_t)(seq0 + lo) * INW + 3072 + ch;
  const int cnt = hi - lo;
  u32x4 wv[16];
#pragma unroll
  for (int q = 0; q < 16; ++q) wv[q] = (q < cnt) ? *(const u32x4*)(zp + (size_t)q * INW) : (u32x4){0u, 0u, 0u, 0u};
#pragma unroll
  for (int q = 0; q < 16; ++q) {
    unpack8(wv[q], f);
#pragma unroll
    for (int j = 0; j < 8; ++j) acc[j] += f[j];
  }
  unpack8(*(const u32x4*)(p.Z + (size_t)row * INW + 3072 + ch), f);
  const float inv = 1.f / (float)(hi - lo);
#pragma unroll
  for (int j = 0; j < 8; ++j) acc[j] = acc[j] * inv - f[j];
  *(u32x4*)(p.YS + (size_t)row * 1536 + 1024 + ch) = pack8(acc);
}

DI float gelu_tanh(float x) {
  const float y = 0.7978845608028654f * (x + 0.044715f * x * x * x);
  const float e = __expf(2.f * y);
  const float th = 1.f - 2.f / (e + 1.f);
  return 0.5f * x * (1.f + th);
}
DI void act_item(const Params& p, int l, int it) {
  const int id = it * NTHREADS + tidx();
  const int row = (id / 352) * 4, ch = (id % 352) * 8;
  const bf16_t* u = p.U + (size_t)row * (2 * DFF) + ch;
  const float* cw = p.f_conv + (size_t)l * 3 * DFF + ch;
  const bool first = seq_first(row), last = seq_last(row + 3);
  u32x4 ur[6], vr[4];
#pragma unroll
  for (int i = 0; i < 6; ++i) {
    const bool ok = (i == 0) ? !first : (i == 5) ? !last : true;
    ur[i] = ok ? *(const u32x4*)(u + (ptrdiff_t)(i - 1) * (2 * DFF)) : (u32x4){0u, 0u, 0u, 0u};
  }
#pragma unroll
  for (int i = 0; i < 4; ++i) vr[i] = *(const u32x4*)(u + (size_t)i * (2 * DFF) + DFF);
  float w0[8], w1[8], w2[8];
#pragma unroll
  for (int j = 0; j < 8; ++j) { w0[j] = cw[j]; w1[j] = cw[DFF + j]; w2[j] = cw[2 * DFF + j]; }
#pragma unroll
  for (int i = 0; i < 4; ++i) {
    float a[8], b[8], c[8], val[8], acc[8];
    unpack8(ur[i], a);
    unpack8(ur[i + 1], b);
    unpack8(ur[i + 2], c);
    unpack8(vr[i], val);
#pragma unroll
    for (int j = 0; j < 8; ++j) acc[j] = gelu_tanh(a[j] * w0[j] + b[j] * w1[j] + c[j] * w2[j]) * val[j];
    *(u32x4*)(p.ACT + (size_t)(row + i) * DFF + ch) = pack8(acc);
  }
}

DI void final_row(const Params& p, int row) {
  const int lane = tidx() & 63;
  const float* xr = p.X + (size_t)row * D;
  f32x4 v[4];
  float ss = 0.f;
#pragma unroll
  for (int i = 0; i < 4; ++i) {
    v[i] = *(const f32x4*)(xr + i * 256 + lane * 4);
    ss += v[i][0] * v[i][0] + v[i][1] * v[i][1] + v[i][2] * v[i][2] + v[i][3] * v[i][3];
  }
  ss = wave_sum(ss);
  const float rstd = rsqrtf(ss * (1.f / 1024.f) + 1e-6f);
#pragma unroll
  for (int i = 0; i < 4; ++i) {
    const int col = i * 256 + lane * 4;
    const f32x4 gg = *(const f32x4*)(p.g_final + col);
    f32x4 o;
#pragma unroll
    for (int j = 0; j < 4; ++j) o[j] = v[i][j] * rstd * gg[j];
    *(f32x4*)(p.out + (size_t)row * D + col) = o;
  }
}

constexpr int N_PHASES = 20;
extern __shared__ __attribute__((aligned(16))) char g_smem[];
#define NI __device__ __forceinline__
constexpr size_t KV_OFF = (size_t)NTOK * D;

NI void ph_prep0(const Params& p) {
  char* smem = g_smem;
  const int nb = gridDim.x, bid = bidx();
  const int total = PREP_ITEMS + MOD_ITEMS + CACHE_ITEMS;
  for (int it = bid; it < total; it += nb) {
    if (it < MOD_ITEMS) mod_item(p, it, (float*)smem);
    else if (it < MOD_ITEMS + CACHE_ITEMS) cache_item(p, it - MOD_ITEMS);
    else prep_item(p, 0, it - MOD_ITEMS - CACHE_ITEMS, (float*)smem);
  }
#ifdef REP_MOD
  for (int it = bid; it < MOD_ITEMS; it += nb) mod_item(p, it, (float*)smem);
#endif
#ifdef REP_WEFF
  for (int it = bid; it < PREP_WEFF; it += nb) prep_item(p, 0, it, (float*)smem);
#endif
#ifdef REP_TRANS
  for (int it = PREP_WEFF + bid; it < PREP_ITEMS; it += nb) prep_item(p, 0, it, (float*)smem);
#endif
}
NI void ph_final(const Params& p) {
  const int nb = gridDim.x, bid = bidx(), wid = tidx() >> 6;
  for (int row = bid * NWAVES + wid; row < NTOK; row += nb * NWAVES) final_row(p, row);
}
NI void ph_normmod1(const Params& p, int l) {
  char* smem = g_smem;
  const int nb = gridDim.x, bid = bidx(), wid = tidx() >> 6;
  for (int row = (bid * NWAVES + wid) * 2; row < NTOK; row += nb * NWAVES * 2)
    normmod_row2(p, l, 0, row, l == 0 ? xin_row(p, row) : p.X + (size_t)row * D);
  if (l == 1)
    for (int it = bid; it < PREP_ITEMS; it += nb) prep_item(p, 1, it, (float*)smem);
}
NI void ph_inproj(const Params& p, int l) {
  EpiZ epi{p.Z, p.VT, p.out + KV_OFF, l};
  gemm_phase<false>(p.H, D, p.WIN, D, D, INW, g_smem, epi, nullptr);
}
NI void ph_attn(const Params& p, int l) {
  const int nb = gridDim.x, bid = bidx();
  for (int it = bid; it < 512; it += nb) {
    if (it < 256) attn_lat_item(p, l, it, g_smem);
    else attn_ctx_item(p, it - 256, g_smem);
  }
  __syncthreads();
}
NI void ph_convpool(const Params& p, int l) {
  const int nb = gridDim.x, bid = bidx();
  for (int it = bid; it < 2048; it += nb) {
    if (it < 1024) conv_item(p, l, it);
    else pool_item(p, it - 1024);
  }
}
NI void ph_branch(const Params& p) {
  EpiBf16 epi{p.MERGED, D};
  gemm_phase<true>(p.YS, 1536, p.WB, 1536, 1536, D, g_smem, epi, p.Z + 3584);
}
NI void ph_outproj(const Params& p, int l) {
  EpiResid epi{&p, l, 2048, l == 0};
  gemm_phase<false>(p.MERGED, D, p.WO, D, D, D, g_smem, epi, nullptr);
}
NI void ph_normmod2(const Params& p, int l) {
  const int nb = gridDim.x, bid = bidx(), wid = tidx() >> 6;
  for (int row = (bid * NWAVES + wid) * 2; row < NTOK; row += nb * NWAVES * 2) normmod_row2(p, l, 1, row, p.X + (size_t)row * D);
}
NI void ph_up(const Params& p) {
  EpiBf16 epi{p.U, 2 * DFF};
  gemm_phase<false>(p.H, D, p.WU, D, D, 2 * DFF, g_smem, epi, nullptr);
}
NI void ph_act(const Params& p, int l) {
  const int nb = gridDim.x, bid = bidx();
  for (int it = bid; it < (NTOK / 4) * 352 / NTHREADS; it += nb) act_item(p, l, it);
}
NI void ph_down(const Params& p, int l) {
  EpiResid epi{&p, l, 5120, false};
  gemm_phase<false>(p.ACT, DFF, p.WD, DFF, DFF, D, g_smem, epi, nullptr);
}

DI void run_phase(const Params& p, int ph) {
  if (ph == 0) { ph_prep0(p); return; }
  if (ph == 19) { ph_final(p); return; }
  const int l = (ph - 1) / 9, s = (ph - 1) % 9;
  switch (s) {
    case 0: ph_normmod1(p, l); break;
    case 1: ph_inproj(p, l); break;
    case 2:
      ph_attn(p, l);
#ifdef REP_ATTN
      if (l == 0) ph_attn(p, l);
#endif
      ph_convpool(p, l);
#ifdef REP_CONVPOOL
      if (l == 0) ph_convpool(p, l);
#endif
      break;
    case 3: ph_branch(p); break;
    case 4: ph_outproj(p, l); break;
    case 5: ph_normmod2(p, l); break;
    case 6: ph_up(p); break;
    case 7: ph_act(p, l); break;
    case 8: ph_down(p, l); break;
  }
}


#define XB_TMO      128
#define XB_XCNT(j)  (256  + 64 * (j))
#define XB_XSUB(j)  (1280 + 64 * (j))
#define XB_XGEN(j)  (2304 + 64 * (j))
#define XB_TOP      3328
#define XB_TOPGEN   3392
#define XCD_BAR_WORDS 3456
#define XB_SPIN_CAP (1u << 20)
DI unsigned xb_ld(unsigned* p) { return __hip_atomic_load(p, __ATOMIC_RELAXED, __HIP_MEMORY_SCOPE_AGENT); }
DI unsigned xb_add(unsigned* p, unsigned v) { return __hip_atomic_fetch_add(p, v, __ATOMIC_RELAXED, __HIP_MEMORY_SCOPE_AGENT); }
DI unsigned xb_xcc_id() { return (unsigned)__builtin_amdgcn_s_getreg((3 << 11) | 20) & 0xFu; }
#define XB_SPIN(cond, bar) do { unsigned _sp = 0; while (cond) { __builtin_amdgcn_s_sleep(1); \
    if ((++_sp & 255u) == 0u) { if (xb_ld(&(bar)[XB_TMO])) break; if (_sp > XB_SPIN_CAP) { atomicAdd(&(bar)[XB_TMO], 1u); break; } } } } while (0)
struct XcdBarrier { unsigned* bar; unsigned x, nloc, nx; };
DI XcdBarrier xcd_barrier_post(unsigned* bar) {
  XcdBarrier b; b.bar = bar; b.x = xb_xcc_id(); b.nloc = 0u; b.nx = 0u;
  if (threadIdx.x == 0) (void)xb_add(&bar[XB_XCNT(b.x)], 1u);
  return b;
}
DI void xcd_barrier_complete(unsigned* bar, unsigned x, unsigned& nloc, unsigned& nx) {
  const unsigned G = gridDim.x;
  unsigned sum, cnt, mine, sp = 0u;
  for (;;) {
    sum = 0u; cnt = 0u; mine = 0u;
#pragma unroll
    for (unsigned j = 0; j < 16; ++j) { const unsigned c = xb_ld(&bar[XB_XCNT(j)]); sum += c; cnt += (c > 0u) ? 1u : 0u; mine = (j == x) ? c : mine; }
    if (sum == G) break;
    __builtin_amdgcn_s_sleep(1);
    if ((++sp & 255u) == 0u) { if (xb_ld(&bar[XB_TMO])) break; if (sp > XB_SPIN_CAP) { atomicAdd(&bar[XB_TMO], 1u); break; } }
  }
  nloc = mine > 0u ? mine : 1u; nx = cnt > 0u ? cnt : 1u;
}
DI void xcd_barrier(XcdBarrier& b) {
  asm volatile("s_waitcnt vmcnt(0)" ::: "memory");
  __syncthreads();
  if (threadIdx.x == 0) {
    unsigned* bar = b.bar;
    __builtin_amdgcn_s_waitcnt(0);
    if (b.nloc == 0u) xcd_barrier_complete(bar, b.x, b.nloc, b.nx);
    const unsigned nloc = b.nloc, nx = b.nx;
    const unsigned old = xb_add(&bar[XB_XSUB(b.x)], 1u);
    const unsigned gen = old / nloc;
    if (old + 1u == (gen + 1u) * nloc) {
      __builtin_amdgcn_fence(__ATOMIC_RELEASE, "agent");
      asm volatile("s_waitcnt vmcnt(0)" ::: "memory");
      const unsigned og = xb_add(&bar[XB_TOP], 1u);
      const unsigned tg = og / nx;
      if (og + 1u == (tg + 1u) * nx) xb_add(&bar[XB_TOPGEN], 1u);
      else XB_SPIN(xb_ld(&bar[XB_TOPGEN]) == tg, bar);
      __builtin_amdgcn_fence(__ATOMIC_ACQUIRE, "agent");
      xb_add(&bar[XB_XGEN(b.x)], 1u);
      asm volatile("s_waitcnt vmcnt(0)" ::: "memory");
    } else {
      XB_SPIN(xb_ld(&bar[XB_XGEN(b.x)]) == gen, bar);
      __builtin_amdgcn_fence(__ATOMIC_ACQUIRE, "agent");
      asm volatile("s_waitcnt vmcnt(0)" ::: "memory");
    }
  }
  __syncthreads();
}

__global__ void __launch_bounds__(NTHREADS, 2) mega_kernel(Params p, int ph_lo, int ph_hi) {
  cg::grid_group grid = cg::this_grid();
  XcdBarrier xb = xcd_barrier_post(p.BAR);
#ifndef REPEAT_MASK
#define REPEAT_MASK 0u
#endif
  for (int ph = ph_lo; ph < ph_hi; ++ph) {
    run_phase(p, ph);
    if ((REPEAT_MASK >> ph) & 1u) {
      xcd_barrier(xb);
      run_phase(p, ph);
    }
    if (ph + 1 < ph_hi) xcd_barrier(xb);
  }
  if (ph_hi > 1000) grid.sync();
}

extern "C" void kernel_launch(void* const* d_in, const int* in_sizes, int n_in, void* d_out, int out_size, void* d_ws,
                              size_t ws_size, hipStream_t stream) {
  static int grid_blocks = 0;
  if (!grid_blocks) {
    int dev = 0, cus = 0, per_cu = 0;
    (void)hipGetDevice(&dev);
    (void)hipDeviceGetAttribute(&cus, hipDeviceAttributeMultiprocessorCount, dev);
    (void)hipFuncSetAttribute((const void*)mega_kernel, hipFuncAttributeMaxDynamicSharedMemorySize, LDS_BYTES);
    (void)hipOccupancyMaxActiveBlocksPerMultiprocessor(&per_cu, mega_kernel, NTHREADS, LDS_BYTES);
    if (per_cu < 1) fprintf(stderr, "occupancy query reports %d blocks/CU\n", per_cu);
    grid_blocks = cus;
  }
  Params p{};
  const float** f = (const float**)&p;
  for (int i = 0; i < 20; ++i) f[i] = (const float*)d_in[i];
  p.out = (float*)d_out;
  char* ws = (char*)d_ws;
  size_t off = 0;
  auto take = [&](size_t bytes) { char* r = ws + off; off += (bytes + 255) & ~(size_t)255; return r; };
  p.BAR = (unsigned*)take(XCD_BAR_WORDS * 4);
  p.MOD = (float*)take(2 * 5 * 6144 * 4);
  p.X = (float*)take((size_t)NTOK * D * 4);
  p.KC = (bf16_t*)take((size_t)64 * 16384 * 2);
  p.VCT = (bf16_t*)take((size_t)64 * 16384 * 2);
  p.WIN = (bf16_t*)take((size_t)INW * D * 2);
  p.WB = (bf16_t*)take((size_t)D * 1536 * 2);
  p.WO = (bf16_t*)take((size_t)D * D * 2);
  p.WU = (bf16_t*)take((size_t)2 * DFF * D * 2);
  p.WD = (bf16_t*)take((size_t)D * DFF * 2);
  p.H = (bf16_t*)take((size_t)NTOK * D * 2);
  p.Z = (bf16_t*)take((size_t)NTOK * INW * 2);
  p.U = p.Z;
  char* r2 = take((size_t)NTOK * 1536 * 2 + (size_t)NTOK * D * 2 + (size_t)512 * NTOK * 2);
  p.YS = (bf16_t*)r2;
  p.MERGED = (bf16_t*)(r2 + (size_t)NTOK * 1536 * 2);
  p.VT = (bf16_t*)(r2 + (size_t)NTOK * 1536 * 2 + (size_t)NTOK * D * 2);
  p.ACT = (bf16_t*)r2;
  (void)hipMemsetAsync(p.BAR, 0, XCD_BAR_WORDS * 4, stream);
#ifndef MULTI_LAUNCH
#define MULTI_LAUNCH 0
#endif
#if MULTI_LAUNCH
  for (int ph = 0; ph < N_PHASES; ++ph) mega_kernel<<<dim3(grid_blocks), dim3(NTHREADS), LDS_BYTES, stream>>>(p, ph, ph + 1);
#else
  int lo = 0, hi = N_PHASES;
  void* args[] = {&p, &lo, &hi};
  hipError_t e = hipLaunchCooperativeKernel((void*)mega_kernel, dim3(grid_blocks), dim3(NTHREADS), args, LDS_BYTES, stream);
  if (e != hipSuccess) fprintf(stderr, "cooperative launch failed: %s (grid %d)\n", hipGetErrorString(e), grid_blocks);
#endif
}
```

```cpp
#include <hip/hip_runtime.h>
#include <hip/hip_cooperative_groups.h>
#include <cstdio>
namespace cg = cooperative_groups;

typedef unsigned short bf16_t;
typedef short bf16x8 __attribute__((ext_vector_type(8)));
typedef float f32x4 __attribute__((ext_vector_type(4)));
typedef unsigned u32x4 __attribute__((ext_vector_type(4)));
typedef unsigned u32x2 __attribute__((ext_vector_type(2)));

#define DI __device__ __forceinline__
DI int tidx() { int t = threadIdx.x; asm volatile("" : "+v"(t)); return t; }
DI int bidx() { int b = blockIdx.x; asm volatile("" : "+s"(b)); return b; }

constexpr int D = 1024, NTOK = 8192, NCTX = 4096, INW = 6656, DFF = 2816;
constexpr int NTHREADS = 512, NWAVES = 8;
constexpr int LDS_BYTES = 147456 + 16;
constexpr int LDS_XB_OFF = 147456;

struct Params {
  const float *x_prompt, *x_sample, *cache_kv, *c, *c_ctx, *w_mod, *b_mod, *g1, *g2, *w_in, *conv_w, *rpb, *pool_w,
      *pool_scale, *w_branch, *w_out, *w_up, *f_conv, *w_down, *g_final;
  float* out;
  float* MOD;
  float* X;
  unsigned* BAR;
  bf16_t *KC, *VCT, *WIN, *WB, *WO, *WU, *WD, *H, *Z, *U, *YS, *MERGED, *VT, *ACT;
};

DI Params load_params() {
#if defined(__HIP_DEVICE_COMPILE__)
  typedef __attribute__((address_space(4))) const char* kptr_t;
  kptr_t ka = (kptr_t)__builtin_amdgcn_kernarg_segment_ptr();
  int off = 0;
  asm volatile("" : "+s"(off));
  return *(__attribute__((address_space(4))) const Params*)(ka + off);
#else
  return Params{};
#endif
}

typedef float f32x2 __attribute__((ext_vector_type(2)));
typedef __bf16 bf16x2_t __attribute__((ext_vector_type(2)));
DI unsigned cvt_pk_bf16(float lo, float hi) {
  const f32x2 v = {lo, hi};
  return __builtin_bit_cast(unsigned, __builtin_convertvector(v, bf16x2_t));
}
DI float bf_lo(unsigned u) { return __uint_as_float(u << 16); }
DI float bf_hi(unsigned u) { return __uint_as_float(u & 0xffff0000u); }
DI float wave_sum(float v) {
#pragma unroll
  for (int o = 32; o > 0; o >>= 1) v += __shfl_xor(v, o);
  return v;
}
DI const float* xin_row(const Params& p, int row) {
  return row < NCTX ? p.x_prompt + (size_t)row * D : p.x_sample + (size_t)(row - NCTX) * D;
}
DI int vec_of_row(int row) { return row < NCTX ? 0 : 1 + ((row - NCTX) >> 10); }
DI bool seq_first(int row) { return row < NCTX ? ((row & 255) == 0) : ((row & 1023) == 0); }
DI bool seq_last(int row) { return row < NCTX ? ((row & 255) == 255) : ((row & 1023) == 1023); }

DI void transpose_tile(const float* __restrict__ src, int srcld, bf16_t* __restrict__ dst, int dstld, int kt, int nt,
                       float* sm) {
  const int t = tidx();
  const float* s = src + (size_t)(kt * 128) * srcld + nt * 64;
#pragma unroll
  for (int i = 0; i < 4; ++i) {
    const int row = (t >> 4) + 32 * i, c4 = (t & 15) * 4;
    const f32x4 v = *(const f32x4*)(s + (size_t)row * srcld + c4);
    sm[row * 65 + c4 + 0] = v[0];
    sm[row * 65 + c4 + 1] = v[1];
    sm[row * 65 + c4 + 2] = v[2];
    sm[row * 65 + c4 + 3] = v[3];
  }
  __syncthreads();
  const int n = t >> 3, ks = (t & 7) * 16;
  u32x4 w0, w1;
#pragma unroll
  for (int j = 0; j < 4; ++j) {
    w0[j] = cvt_pk_bf16(sm[(ks + 2 * j) * 65 + n], sm[(ks + 2 * j + 1) * 65 + n]);
    w1[j] = cvt_pk_bf16(sm[(ks + 8 + 2 * j) * 65 + n], sm[(ks + 8 + 2 * j + 1) * 65 + n]);
  }
  bf16_t* d = dst + (size_t)(nt * 64 + n) * dstld + kt * 128 + ks;
  *(u32x4*)d = w0;
  *(u32x4*)(d + 8) = w1;
  __syncthreads();
}

constexpr int PREP_T_IN = 8 * 104, PREP_T_BR = 2 * 4 * 16, PREP_T_OUT = 8 * 16, PREP_T_UP = 8 * 88,
              PREP_T_DN = 22 * 16, PREP_WEFF = 128;
constexpr int PREP_ITEMS = PREP_T_IN + PREP_T_BR + PREP_T_OUT + PREP_T_UP + PREP_T_DN + PREP_WEFF;

DI void prep_transposes(const Params& p, int l, int it, float* sm) {
  if (it < PREP_T_IN) {
    transpose_tile(p.w_in + (size_t)l * D * INW, INW, p.WIN, D, it / 104, it % 104, sm);
    return;
  }
  it -= PREP_T_IN;
  if (it < PREP_T_BR) {
    const int i = it >> 6, r = it & 63;
    transpose_tile(p.w_branch + (size_t)(l * 3 + i) * 512 * D, D, p.WB + i * 512, 1536, r >> 4, r & 15, sm);
    return;
  }
  it -= PREP_T_BR;
  if (it < PREP_T_OUT) {
    transpose_tile(p.w_out + (size_t)l * D * D, D, p.WO, D, it >> 4, it & 15, sm);
    return;
  }
  it -= PREP_T_OUT;
  if (it < PREP_T_UP) {
    {
      const int nt = it % 88, q = nt >> 2, sub = nt & 3;
      const int src_col = (sub < 2) ? 128 * q + 64 * sub : DFF + 128 * q + 64 * (sub - 2);
      transpose_tile(p.w_up + (size_t)l * D * 2 * DFF + (src_col - nt * 64), 2 * DFF, p.WU, D, it / 88, nt, sm);
    }
    return;
  }
  it -= PREP_T_UP;
  if (it < PREP_T_DN) {
    transpose_tile(p.w_down + (size_t)l * DFF * D, D, p.WD, DFF, it >> 4, it & 15, sm);
    return;
  }
}

DI void prep_item(const Params& p, int l, int it, float* sm) {
  if (it < PREP_WEFF) {
    const int g = it >> 5, cb = (it >> 1) & 15, db = it & 1;
    const int t = tidx();
    const int dd = db * 512 + t;
    const float* wb2 = p.w_branch + (size_t)(l * 3 + 2) * 512 * D + (size_t)(g * 128) * D + dd;
    for (int i = t; i < 1024; i += NTHREADS) {
      const int e = i >> 3, c = i & 7;
      sm[i] = p.pool_w[((size_t)(l * 4 + g) * 128 + cb * 8 + c) * 128 + e] * p.pool_scale[l * 512 + g * 128 + e];
    }
    __syncthreads();
    float acc[8];
#pragma unroll
    for (int c = 0; c < 8; ++c) acc[c] = 0.f;
#pragma unroll 16
    for (int e = 0; e < 128; ++e) {
      const float w = wb2[(size_t)e * D];
      const f32x4 s0 = *(const f32x4*)(sm + e * 8), s1 = *(const f32x4*)(sm + e * 8 + 4);
#pragma unroll
      for (int c = 0; c < 4; ++c) { acc[c] += s0[c] * w; acc[4 + c] += s1[c] * w; }
    }
    u32x4 o;
#pragma unroll
    for (int j = 0; j < 4; ++j) o[j] = cvt_pk_bf16(acc[2 * j], acc[2 * j + 1]);
    *(u32x4*)(p.WB + (size_t)dd * 1536 + 1024 + g * 128 + cb * 8) = o;
    __syncthreads();
  }
  else {
    it -= PREP_WEFF;
    prep_transposes(p, l, it, sm);
  }
}

constexpr int MOD_ITEMS = 2 * 96;
DI void mod_item(const Params& p, int it, float* sm) {
  const int t = tidx();
  const int l = it / 96, cb = it % 96;
  float* red = sm + 5 * 1024;
  for (int i = t; i < 5 * 1024; i += NTHREADS) {
    const int v = i >> 10, k = i & 1023;
    const float cv = (v == 0) ? p.c_ctx[k] : p.c[(v - 1) * D + k];
    sm[i] = cv / (1.f + __expf(-cv));
  }
  __syncthreads();
  const int kg = t >> 4, ct = t & 15;
  f32x4 acc[5];
#pragma unroll
  for (int v = 0; v < 5; ++v) acc[v] = (f32x4){0.f, 0.f, 0.f, 0.f};
  const float* w = p.w_mod + ((size_t)l * D + kg * 32) * 6144 + cb * 64 + ct * 4;
#pragma unroll 8
  for (int kk = 0; kk < 32; ++kk) {
    const f32x4 wv = *(const f32x4*)(w + (size_t)kk * 6144);
#pragma unroll
    for (int v = 0; v < 5; ++v) acc[v] += sm[v * 1024 + kg * 32 + kk] * wv;
  }
#pragma unroll
  for (int v = 0; v < 5; ++v)
#pragma unroll
    for (int j = 0; j < 4; ++j) red[(kg * 5 + v) * 64 + ct * 4 + j] = acc[v][j];
  __syncthreads();
  for (int i = t; i < 320; i += NTHREADS) {
    const int v = i >> 6, c = i & 63;
    float s = p.b_mod[l * 6144 + cb * 64 + c];
#pragma unroll
    for (int g = 0; g < 32; ++g) s += red[(g * 5 + v) * 64 + c];
    p.MOD[(size_t)(l * 5 + v) * 6144 + cb * 64 + c] = s;
  }
  __syncthreads();
}

constexpr int CACHE_ITEMS = 32;
DI void cache_item(const Params& p, int it) {
  const int t = tidx() & 255;
  it = it * 2 + (tidx() >> 8);
  const int b = it >> 4, l = (it >> 3) & 1, h = it & 7;
  const float* ks = p.cache_kv + ((size_t)(((b * 2 + l) * 2 + 0) * 8 + h)) * 16384;
  const float* vs = p.cache_kv + ((size_t)(((b * 2 + l) * 2 + 1) * 8 + h)) * 16384;
  bf16_t* kd = p.KC + (size_t)((b * 2 + l) * 8 + h) * 16384;
  bf16_t* vd = p.VCT + (size_t)((b * 2 + l) * 8 + h) * 16384;
#pragma unroll 4
  for (int i = 0; i < 16; ++i) {
    const int e = (i * 256 + t) * 4;
    const f32x4 v = *(const f32x4*)(ks + e);
    u32x2 o;
    o[0] = cvt_pk_bf16(v[0], v[1]);
    o[1] = cvt_pk_bf16(v[2], v[3]);
    *(u32x2*)(kd + e) = o;
  }
#pragma unroll 4
  for (int d = 0; d < 64; d += 4) {
    const f32x4 v = *(const f32x4*)(vs + t * 64 + d);
#pragma unroll
    for (int j = 0; j < 4; ++j) vd[(d + j) * 256 + t] = (bf16_t)(cvt_pk_bf16(v[j], 0.f) & 0xffffu);
  }
}

DI void normmod_row2(const Params& p, int l, int which, int row, const float* xr) {
  const int lane = tidx() & 63;
  f32x4 v[2][4];
  float ss[2] = {0.f, 0.f};
#pragma unroll
  for (int r = 0; r < 2; ++r)
#pragma unroll
    for (int i = 0; i < 4; ++i) v[r][i] = *(const f32x4*)(xr + r * D + i * 256 + lane * 4);
#pragma unroll
  for (int r = 0; r < 2; ++r) {
#pragma unroll
    for (int i = 0; i < 4; ++i)
      ss[r] += v[r][i][0] * v[r][i][0] + v[r][i][1] * v[r][i][1] + v[r][i][2] * v[r][i][2] + v[r][i][3] * v[r][i][3];
    ss[r] = wave_sum(ss[r]);
  }
  const float* g = (which == 0 ? p.g1 : p.g2) + l * D;
  const float* mod = p.MOD + (size_t)(l * 5 + vec_of_row(row)) * 6144 + which * 3072;
#pragma unroll
  for (int i = 0; i < 4; ++i) {
    const int col = i * 256 + lane * 4;
    const f32x4 gg = *(const f32x4*)(g + col);
    const f32x4 sh = *(const f32x4*)(mod + col);
    const f32x4 sc = *(const f32x4*)(mod + 1024 + col);
#pragma unroll
    for (int r = 0; r < 2; ++r) {
      const float rstd = rsqrtf(ss[r] * (1.f / 1024.f) + 1e-6f);
      f32x4 h;
#pragma unroll
      for (int j = 0; j < 4; ++j) h[j] = v[r][i][j] * rstd * gg[j] * (1.f + sc[j]) + sh[j];
      u32x2 o;
      o[0] = cvt_pk_bf16(h[0], h[1]);
      o[1] = cvt_pk_bf16(h[2], h[3]);
      *(u32x2*)(p.H + (size_t)(row + r) * D + col) = o;
    }
  }
}

constexpr int STAGE_BYTES = 49152;
#ifdef EXP_B
#define EXP_B_EXTRA gemm_stage<256>(A, lda, (4 * x + (pj & 3)) * 256, pt * 64, dst, tid); gemm_stage<128>(Bt, ldb, (pj >> 2) * 128, pt * 64, dst + 32768, tid);
#define VM_STAGE "12"
#else
#define EXP_B_EXTRA
#define VM_STAGE "6"
#endif
template <int ROWS>
DI void gemm_stage(const bf16_t* __restrict__ A, int lda, int row0, int k0, char* s, int t) {
  const int cp = t & 7, rr = t >> 3, c = cp ^ (rr & 7);
#pragma unroll
  for (int i = 0; i < ROWS / 64; ++i)
    __builtin_amdgcn_global_load_lds((const unsigned*)(A + (size_t)(row0 + rr + 64 * i) * lda + k0 + c * 8),
                                     (unsigned*)(s + t * 16 + i * 8192), 16, 0, 0);
}
DI void gemm_compute(const char* sA, const char* sB, f32x4 (&acc)[4][4], int wm, int wn, int lane) {
  const int fr = lane & 15, fq = lane >> 4;
#pragma unroll
  for (int ks = 0; ks < 2; ++ks) {
    bf16x8 a[4], b[4];
    const int sw = ((ks * 4 + fq) ^ (fr & 7)) << 4;
#pragma unroll
    for (int ni = 0; ni < 4; ++ni) b[ni] = *(const bf16x8*)(sB + (wn * 64 + ni * 16 + fr) * 128 + sw);
#pragma unroll
    for (int mi = 0; mi < 4; ++mi) a[mi] = *(const bf16x8*)(sA + (wm * 64 + mi * 16 + fr) * 128 + sw);
    __builtin_amdgcn_sched_barrier(0);
#pragma unroll
    for (int mi = 0; mi < 4; ++mi)
#pragma unroll
      for (int ni = 0; ni < 4; ++ni)
        acc[mi][ni] = __builtin_amdgcn_mfma_f32_16x16x32_bf16(b[ni], a[mi], acc[mi][ni], 0, 0, 0);
    __builtin_amdgcn_sched_barrier(0);
  }
}

template <bool GATED, class Epi>
DI void gemm_phase(const bf16_t* __restrict__ A, int lda, const bf16_t* __restrict__ Bt, int ldb, int K, int N,
                   char* smem, const Epi& epi, const bf16_t* gates) {
  const int tid = tidx();
  const int wid = tid >> 6, lane = tid & 63, wm = wid >> 1, wn = wid & 1;
  const int fr = lane & 15, fq = lane >> 4;
  const int bid = bidx(), nb = gridDim.x;
  const int nN = N >> 7, nt = K >> 6;
  const int x = bid & 7, per_x = 4 * nN, cstep = nb >> 3;
  int pj = bid >> 3, pt = 0, ps = 0;
#define GEMM_ISSUE()                                                                                          \
  do {                                                                                                        \
    if (pj < per_x) {                                                                                         \
      char* dst = smem + ps * STAGE_BYTES;                                                                    \
      gemm_stage<256>(A, lda, (4 * x + (pj & 3)) * 256, pt * 64, dst, tid);                                   \
      gemm_stage<128>(Bt, ldb, (pj >> 2) * 128, pt * 64, dst + 32768, tid);                                   \
      EXP_B_EXTRA                                                                                             \
      if (++pt == nt) { pt = 0; pj += cstep; }                                                                \
      ps = (ps == 2) ? 0 : ps + 1;                                                                            \
    }                                                                                                         \
  } while (0)
  GEMM_ISSUE();
  GEMM_ISSUE();
  int cs = 0;
  for (int cj = bid >> 3; cj < per_x; cj += cstep) {
    const int row0 = (4 * x + (cj & 3)) * 256, col0 = (cj >> 2) * 128;
    f32x4 acc[4][4];
    f32x4 tot[4][4];
#pragma unroll
    for (int mi = 0; mi < 4; ++mi)
#pragma unroll
      for (int ni = 0; ni < 4; ++ni) {
        acc[mi][ni] = (f32x4){0.f, 0.f, 0.f, 0.f};
        if (GATED) tot[mi][ni] = (f32x4){0.f, 0.f, 0.f, 0.f};
      }
    const bool last_tile = cj + cstep >= per_x;
    for (int t = 0; t < nt; ++t) {
      if (last_tile && t == nt - 1) asm volatile("s_waitcnt vmcnt(0)" ::: "memory");
      else asm volatile("s_waitcnt vmcnt(" VM_STAGE ")" ::: "memory");
      __builtin_amdgcn_s_barrier();
      GEMM_ISSUE();
      const char* cur = smem + cs * STAGE_BYTES;
      gemm_compute(cur, cur + 32768, acc, wm, wn, lane);
      cs = (cs == 2) ? 0 : cs + 1;
      if (GATED && ((t & 7) == 7)) {
        const int seg = t >> 3;
        int gofs = (row0 + wm * 64 + fr) * INW + seg * 1024 + col0 + wn * 64 + fq * 4;
        asm volatile("" : "+v"(gofs));
#pragma unroll
        for (int mi = 0; mi < 4; ++mi)
#pragma unroll
          for (int ni = 0; ni < 4; ++ni) {
            const u32x2 g = *(const u32x2*)(gates + (gofs + mi * 16 * INW + ni * 16));
            tot[mi][ni][0] += bf_lo(g[0]) * acc[mi][ni][0];
            tot[mi][ni][1] += bf_hi(g[0]) * acc[mi][ni][1];
            tot[mi][ni][2] += bf_lo(g[1]) * acc[mi][ni][2];
            tot[mi][ni][3] += bf_hi(g[1]) * acc[mi][ni][3];
            acc[mi][ni] = (f32x4){0.f, 0.f, 0.f, 0.f};
          }
      }
    }
#pragma unroll
    for (int mi = 0; mi < 4; ++mi)
#pragma unroll
      for (int ni = 0; ni < 4; ++ni) {
        const int row = row0 + wm * 64 + mi * 16 + fr, col = col0 + wn * 64 + ni * 16 + fq * 4;
        epi(row, col, GATED ? tot[mi][ni] : acc[mi][ni]);
      }
  }
#undef GEMM_ISSUE
  __syncthreads();
}

DI void store_bf16x4(bf16_t* d, f32x4 v) {
  u32x2 o;
  o[0] = cvt_pk_bf16(v[0], v[1]);
  o[1] = cvt_pk_bf16(v[2], v[3]);
  *(u32x2*)d = o;
}

struct EpiZ {
  bf16_t* Z; bf16_t* VT; float* kv; int l;
  DI void operator()(int row, int col, f32x4 v) const {
    const int colt = __builtin_amdgcn_readfirstlane(col) & ~127;
    if (colt >= 3584) {
#pragma unroll
      for (int j = 0; j < 4; ++j) v[j] = __builtin_amdgcn_rcpf(1.f + __expf(-v[j]));
    }
    store_bf16x4(Z + (size_t)row * INW + col, v);
    if (colt >= 2048 && colt < 3072) {
      const int which = (colt - 2048) >> 9, hd = (col - 2048) & 511;
      if (row < NCTX) {
        const int b = row >> 8, s = row & 255, hh = hd >> 6, d = hd & 63;
        *(f32x4*)(kv + ((size_t)((((b * 2 + l) * 2 + which) * 8 + hh) * 256 + s)) * 64 + d) = v;
      }
      if (which == 1) {
#pragma unroll
        for (int j = 0; j < 4; ++j)
          VT[(((size_t)(hd >> 6) * 256 + (row >> 5)) * 64 + (hd & 63) + j) * 32 + (row & 31)] = (bf16_t)(cvt_pk_bf16(v[j], 0.f) & 0xffffu);
      }
    }
  }
};
struct EpiBf16 {
  bf16_t* O; int ld;
  DI void operator()(int row, int col, f32x4 v) const { store_bf16x4(O + (size_t)row * ld + col, v); }
};
struct EpiResid {
  const Params* p; int l; int gate_off; bool from_input;
  DI void operator()(int row, int col, f32x4 v) const {
    const float* xi = from_input ? xin_row(*p, row) + col : p->X + (size_t)row * D + col;
    const f32x4 x = *(const f32x4*)xi;
    const f32x4 g = *(const f32x4*)(p->MOD + (size_t)(l * 5 + vec_of_row(row)) * 6144 + gate_off + col);
    f32x4 o;
#pragma unroll
    for (int j = 0; j < 4; ++j) o[j] = x[j] + g[j] * v[j];
    *(f32x4*)(p->X + (size_t)row * D + col) = o;
  }
};


namespace pg8 {
#define PG8_LAS __attribute__((address_space(3)))
typedef unsigned short bf16_t;
typedef short bf16x8 __attribute__((ext_vector_type(8)));
typedef float f32x4 __attribute__((ext_vector_type(4)));
typedef unsigned u32x4 __attribute__((ext_vector_type(4)));
constexpr int BM = 256, BK = 64, HALF = 128, HTB = HALF * BK * 2  , STAGE_BYTES = 8 * HTB, NXCD = 8, WGM = 4;

__host__ __device__ __forceinline__ int lds_byte(int r, int c) { const int st = (r >> 4) * 2 + (c >> 5), rr = r & 15, cc = c & 31, ob = rr * 64 + cc * 2; return st * 1024 + (ob ^ (((ob >> 9) & 1) << 5)); }
__host__ __device__ __forceinline__ void stage_rc(int b, int& R, int& C) { const int st = b / 1024, sb = b % 1024, swz = sb ^ (((sb >> 9) & 1) << 5); R = (st >> 1) * 16 + swz / 64; C = (st & 1) * 32 + (swz % 64) / 2; }
__host__ __device__ __forceinline__ int perm32(int rho) { const int n = rho >> 4, i = rho & 15; return 8 * (i >> 2) + 4 * n + (i & 3); }

struct Unit { int pm, pn; };
struct Gemm { const bf16_t* A; const bf16_t* Bt; int M, N, K; };

struct StaticOrder {
    int nM, nN, nwg, G, c;
    __host__ __device__ void init(int M, int N, int G_, int c_) { nM = M / BM; nN = N / BM; nwg = nM * nN; G = G_; c = c_; }
    __host__ __device__ bool next(int i, Unit& u) const {
        const long L = (long)i * G + c; if (L >= nwg) return false;
        int wgid = (int)L; { const int q = nwg / NXCD, r = nwg % NXCD, xcd = wgid % NXCD, off = wgid / NXCD; wgid = (xcd < r ? xcd * (q + 1) : r * (q + 1) + (xcd - r) * q) + off; }
        const int nig = WGM * nN, gid = wgid / nig, fm = gid * WGM, gsz = (nM - fm) < WGM ? (nM - fm) : WGM;
        u.pm = fm + ((wgid % nig) % gsz); u.pn = (wgid % nig) / gsz; return true;
    }
    __device__ __forceinline__ void a_ready(const Unit&) const {}
    __device__ __forceinline__ void done(const Unit&) const {}
};
template <class Epi, class Sched, bool ALIGN_EPI = false, bool SP2 = false>
__device__ __forceinline__ void gemm_phase(PG8_LAS unsigned char* lds, const Gemm g, const Sched& S, const Epi& E) {
    const int tid = tidx()  , wid = __builtin_amdgcn_readfirstlane(tid >> 6), lane = tid & 63, wr = wid >> 2, wc = wid & 3, fr = lane & 15, fq = lane >> 4;
    const int K = g.K, nt = K / BK;
    unsigned voffA[2], voffB[2];
#pragma unroll
    for (int i = 0; i < 2; ++i) { int R, C; stage_rc(tid * 16 + i * 8192, R, C); const int Rb = Epi::PERM ? ((R & ~31) + perm32(R & 31)) : R;
        voffA[i] = (unsigned)(R * K + C) * 2u; voffB[i] = (unsigned)(Rb * K + C) * 2u; }
    const size_t kstep = (size_t)(BK * 2);
    const size_t hstep = (size_t)HALF * K * 2;
    const size_t tstep = 2 * hstep;
    const unsigned ldsw = (unsigned)wid * 1024u;
    const int aoff = lds_byte(wr * 64 + fr, fq * 8), boff = lds_byte(wc * 32 + fr, fq * 8);
#define PG8_SA(b, h) (((b) * 2 + (h)) * HTB)
#define PG8_SB(b, h) ((4 + (b) * 2 + (h)) * HTB)
#define PG8_STAGE(bufoff, gbase, voff) do { _Pragma("unroll") for (int _i = 0; _i < 2; ++_i) \
        __builtin_amdgcn_global_load_lds((const unsigned*)((const char*)(gbase) + (voff)[_i]), (PG8_LAS unsigned*)(lds + (bufoff) + ldsw + _i * 8192), 16, 0, 0); } while (0)
#define PG8_LDA(dst, b, h) do { _Pragma("unroll") for (int m = 0; m < 4; ++m) _Pragma("unroll") for (int k = 0; k < 2; ++k) dst[m][k] = *(const PG8_LAS bf16x8*)(lds + PG8_SA(b, h) + aoff + m * 2048 + k * 1024); } while (0)
#define PG8_LDB(dst, b, h) do { _Pragma("unroll") for (int n = 0; n < 2; ++n) _Pragma("unroll") for (int k = 0; k < 2; ++k) dst[n][k] = *(const PG8_LAS bf16x8*)(lds + PG8_SB(b, h) + boff + n * 2048 + k * 1024); } while (0)
#define PG8_MMA(ai, bj, At, Bt) do { __builtin_amdgcn_s_setprio(1); _Pragma("unroll") for (int m = 0; m < 4; ++m) _Pragma("unroll") for (int n = 0; n < 2; ++n) _Pragma("unroll") for (int k = 0; k < 2; ++k) \
        acc[ai][bj][m][n] = __builtin_amdgcn_mfma_f32_16x16x32_bf16(Bt[n][k], At[m][k], acc[ai][bj][m][n], 0, 0, 0); __builtin_amdgcn_s_setprio(0); } while (0)
#define PG8_WAIT_V(n) asm volatile("s_waitcnt vmcnt(" #n ")" ::: "memory")
#define PG8_WAIT_L(n) asm volatile("s_waitcnt lgkmcnt(" #n ")" ::: "memory")
#define PG8_BAR __builtin_amdgcn_s_barrier()
#define PG8_SCHED __builtin_amdgcn_sched_barrier(0)
    Unit cur, nxt; int ui = 0;
    if (!S.next(0, cur)) return;
    f32x4 acc[2][2][4][2];
#pragma unroll
    for (int a = 0; a < 2; ++a)
#pragma unroll
        for (int b = 0; b < 2; ++b)
#pragma unroll
            for (int m = 0; m < 4; ++m)
#pragma unroll
                for (int n = 0; n < 2; ++n) acc[a][b][m][n] = (f32x4){0.f, 0.f, 0.f, 0.f};
    bf16x8 At[4][2], B0[2][2], B1[2][2];
    const char* cA = (const char*)g.A + (size_t)cur.pm * tstep; const char* cB = (const char*)g.Bt + (size_t)cur.pn * tstep;
    S.a_ready(cur);
    if constexpr (SP2) {
        PG8_STAGE(PG8_SB(0, 0), cB, voffB); PG8_STAGE(PG8_SB(0, 1), cB + hstep, voffB); PG8_STAGE(PG8_SA(0, 0), cA, voffA); PG8_STAGE(PG8_SA(0, 1), cA + hstep, voffA);
        if (wr == 1) PG8_BAR;
        PG8_WAIT_V(2); PG8_BAR;
        PG8_STAGE(PG8_SB(1, 0), cB + kstep, voffB); PG8_STAGE(PG8_SA(1, 0), cA + kstep, voffA); PG8_STAGE(PG8_SB(1, 1), cB + hstep + kstep, voffB);
        PG8_WAIT_V(6); PG8_BAR;
    } else {
        PG8_STAGE(PG8_SB(0, 0), cB, voffB); PG8_STAGE(PG8_SA(0, 0), cA, voffA); PG8_STAGE(PG8_SB(0, 1), cB + hstep, voffB); PG8_STAGE(PG8_SA(0, 1), cA + hstep, voffA);
        if (wr == 1) PG8_BAR;
        PG8_WAIT_V(4); PG8_BAR;
        PG8_STAGE(PG8_SB(1, 0), cB + kstep, voffB); PG8_STAGE(PG8_SA(1, 0), cA + kstep, voffA); PG8_STAGE(PG8_SB(1, 1), cB + hstep + kstep, voffB);
        PG8_WAIT_V(6); PG8_BAR;
    }
    for (;;) {
        const bool has_next = S.next(ui + 1, nxt);
        const char* nA = has_next ? (const char*)g.A + (size_t)nxt.pm * tstep : cA; const char* nB = has_next ? (const char*)g.Bt + (size_t)nxt.pn * tstep : cB;
        for (int t = 0; t < nt; t += 2) {
            const bool last = (t == nt - 2);
            const char* a1 = cA + (size_t)(t + 1) * kstep;
            const char* a2 = last ? nA : cA + (size_t)(t + 2) * kstep; const char* b2 = last ? nB : cB + (size_t)(t + 2) * kstep;
            const char* a3 = a2 + kstep; const char* b3 = b2 + kstep;
            if (last && has_next) S.a_ready(nxt);
            if constexpr (SP2) {
            PG8_LDB(B0, 0, 0); PG8_LDB(B1, 0, 1); PG8_SCHED; PG8_LDA(At, 0, 0); PG8_STAGE(PG8_SA(1, 1), a1 + hstep, voffA);
            PG8_WAIT_V(8); PG8_WAIT_L(0); PG8_BAR; PG8_MMA(0, 0, At, B0); PG8_MMA(0, 1, At, B1); PG8_BAR; PG8_SCHED;
            PG8_LDA(At, 0, 1); PG8_STAGE(PG8_SB(0, 0), b2, voffB); PG8_STAGE(PG8_SB(0, 1), b2 + hstep, voffB); PG8_STAGE(PG8_SA(0, 0), a2, voffA);
            PG8_WAIT_V(8); PG8_WAIT_L(0); PG8_BAR; PG8_MMA(1, 0, At, B0); PG8_MMA(1, 1, At, B1); PG8_BAR; PG8_SCHED;
            PG8_LDB(B0, 1, 0); PG8_LDB(B1, 1, 1); PG8_SCHED; PG8_LDA(At, 1, 0); PG8_STAGE(PG8_SA(0, 1), a2 + hstep, voffA);
            PG8_WAIT_V(8); PG8_WAIT_L(0); PG8_BAR; PG8_MMA(0, 0, At, B0); PG8_MMA(0, 1, At, B1); PG8_BAR; PG8_SCHED;
            PG8_LDA(At, 1, 1); PG8_STAGE(PG8_SB(1, 0), b3, voffB); PG8_STAGE(PG8_SB(1, 1), b3 + hstep, voffB); PG8_STAGE(PG8_SA(1, 0), a3, voffA);
            PG8_WAIT_V(8); PG8_WAIT_L(0); PG8_BAR; PG8_MMA(1, 0, At, B0); PG8_MMA(1, 1, At, B1); PG8_BAR; PG8_SCHED;
            } else {
            PG8_LDB(B0, 0, 0); PG8_SCHED; PG8_LDA(At, 0, 0); PG8_STAGE(PG8_SA(1, 1), a1 + hstep, voffA);
            PG8_WAIT_L(8); PG8_BAR; PG8_WAIT_L(0); PG8_MMA(0, 0, At, B0); PG8_BAR; PG8_SCHED;
            PG8_LDB(B1, 0, 1); PG8_STAGE(PG8_SB(0, 0), b2, voffB);
            PG8_BAR; PG8_WAIT_L(0); PG8_MMA(0, 1, At, B1); PG8_BAR;
            PG8_LDA(At, 0, 1); PG8_STAGE(PG8_SA(0, 0), a2, voffA);
            PG8_BAR; PG8_WAIT_L(0); PG8_MMA(1, 0, At, B0); PG8_BAR; PG8_SCHED;
            PG8_STAGE(PG8_SB(0, 1), b2 + hstep, voffB);
            PG8_WAIT_V(6); PG8_BAR; PG8_MMA(1, 1, At, B1); PG8_BAR;
            PG8_LDB(B0, 1, 0); PG8_SCHED; PG8_LDA(At, 1, 0); PG8_STAGE(PG8_SA(0, 1), a2 + hstep, voffA);
            PG8_WAIT_L(8); PG8_BAR; PG8_WAIT_L(0); PG8_MMA(0, 0, At, B0); PG8_BAR; PG8_SCHED;
            PG8_LDB(B1, 1, 1); PG8_STAGE(PG8_SB(1, 0), b3, voffB);
            PG8_BAR; PG8_WAIT_L(0); PG8_MMA(0, 1, At, B1); PG8_BAR;
            PG8_LDA(At, 1, 1); PG8_STAGE(PG8_SA(1, 0), a3, voffA);
            PG8_BAR; PG8_WAIT_L(0); PG8_MMA(1, 0, At, B0); PG8_BAR; PG8_SCHED;
            PG8_STAGE(PG8_SB(1, 1), b3 + hstep, voffB);
            PG8_WAIT_V(6); PG8_BAR; PG8_MMA(1, 1, At, B1); PG8_BAR;
            }
        }
        if constexpr (ALIGN_EPI) { if (wr == 0) PG8_BAR; }
        if constexpr (!Epi::AFTER_DRAIN) { E(acc, cur, wr, wc, fr, fq); S.done(cur); }
        if (!has_next) break;
#pragma unroll
        for (int a = 0; a < 2; ++a)
#pragma unroll
            for (int b = 0; b < 2; ++b)
#pragma unroll
                for (int m = 0; m < 4; ++m)
#pragma unroll
                    for (int n = 0; n < 2; ++n) acc[a][b][m][n] = (f32x4){0.f, 0.f, 0.f, 0.f};
        cur = nxt; cA = nA; cB = nB; ++ui;
        if constexpr (ALIGN_EPI) { if (wr == 1) PG8_BAR; }
    }
    PG8_WAIT_V(0);
    if constexpr (!ALIGN_EPI) { if (wr == 0) PG8_BAR; }
    PG8_BAR;
    if constexpr (Epi::AFTER_DRAIN) { E.fused(acc, cur, wr, wc, fr, fq, lds, wid, lane); S.done(cur); }
#undef PG8_SA
#undef PG8_SB
#undef PG8_STAGE
#undef PG8_LDA
#undef PG8_LDB
#undef PG8_MMA
#undef PG8_WAIT_V
#undef PG8_WAIT_L
#undef PG8_BAR
#undef PG8_SCHED
}
}

struct EpiZ8 {
  static constexpr bool PERM = true, AFTER_DRAIN = false;
  bf16_t* Z; bf16_t* VT; float* kv; int l;
  DI void operator()(const f32x4 (&acc)[2][2][4][2], const pg8::Unit& u, int wr, int wc, int fr, int fq) const {
    const int pn = u.pn;
#pragma unroll
    for (int ai = 0; ai < 2; ++ai)
#pragma unroll
      for (int m = 0; m < 4; ++m) {
        const int row = u.pm * 256 + ai * 128 + wr * 64 + m * 16 + fr;
#pragma unroll
        for (int bj = 0; bj < 2; ++bj) {
          const int c0 = pn * 256 + bj * 128 + wc * 32 + fq * 8;
          f32x4 v0 = acc[ai][bj][m][0], v1 = acc[ai][bj][m][1];
          if (pn >= 14) {
#pragma unroll
            for (int j = 0; j < 4; ++j) {
              v0[j] = __builtin_amdgcn_rcpf(1.f + __expf(-v0[j]));
              v1[j] = __builtin_amdgcn_rcpf(1.f + __expf(-v1[j]));
            }
          }
          u32x4 w;
          w[0] = cvt_pk_bf16(v0[0], v0[1]); w[1] = cvt_pk_bf16(v0[2], v0[3]);
          w[2] = cvt_pk_bf16(v1[0], v1[1]); w[3] = cvt_pk_bf16(v1[2], v1[3]);
          *(u32x4*)(Z + (size_t)row * INW + c0) = w;
          if (pn >= 8 && pn < 12) {
            const int which = (pn >= 10) ? 1 : 0, hd = (c0 - 2048) & 511, hh = hd >> 6, d = hd & 63;
            if (row < NCTX) {
              const int b = row >> 8, s = row & 255;
              float* kp = kv + ((size_t)((((b * 2 + l) * 2 + which) * 8 + hh) * 256 + s)) * 64 + d;
              *(f32x4*)kp = v0;
              *(f32x4*)(kp + 4) = v1;
            }
            if (which == 1) {
              bf16_t* vp = VT + (((size_t)hh * 256 + (row >> 5)) * 64 + d) * 32 + (row & 31);
              vp[0] = (bf16_t)(w[0] & 0xffffu); vp[32] = (bf16_t)(w[0] >> 16);
              vp[64] = (bf16_t)(w[1] & 0xffffu); vp[96] = (bf16_t)(w[1] >> 16);
              vp[128] = (bf16_t)(w[2] & 0xffffu); vp[160] = (bf16_t)(w[2] >> 16);
              vp[192] = (bf16_t)(w[3] & 0xffffu); vp[224] = (bf16_t)(w[3] >> 16);
            }
          }
        }
      }
  }
};
struct EpiO8 {
  static constexpr bool PERM = true, AFTER_DRAIN = false;
  bf16_t* O; int ld;
  DI void operator()(const f32x4 (&acc)[2][2][4][2], const pg8::Unit& u, int wr, int wc, int fr, int fq) const {
#pragma unroll
    for (int ai = 0; ai < 2; ++ai)
#pragma unroll
      for (int m = 0; m < 4; ++m) {
        const int row = u.pm * 256 + ai * 128 + wr * 64 + m * 16 + fr;
#pragma unroll
        for (int bj = 0; bj < 2; ++bj) {
          const int c0 = u.pn * 256 + bj * 128 + wc * 32 + fq * 8;
          const f32x4 v0 = acc[ai][bj][m][0], v1 = acc[ai][bj][m][1];
          u32x4 w;
          w[0] = cvt_pk_bf16(v0[0], v0[1]); w[1] = cvt_pk_bf16(v0[2], v0[3]);
          w[2] = cvt_pk_bf16(v1[0], v1[1]); w[3] = cvt_pk_bf16(v1[2], v1[3]);
          *(u32x4*)(O + (size_t)row * ld + c0) = w;
        }
      }
  }
};

template <bool LATBIAS>
DI void attn_chunk(const bf16x8 qf0, const bf16x8 qf1, const bf16_t* __restrict__ kbase, int kstride,
                   const bf16_t* __restrict__ vtbase, int vstride, int tk0, int tk1, int tk2, int tk3,
                   const float* __restrict__ rpb_h, int dr0, int band, int qc, float& m, float& lsum,
                   f32x4 (&o)[4], int lane) {
  const int fr = lane & 15, fq = lane >> 4;
  f32x4 s[4];
#pragma unroll
  for (int T = 0; T < 4; ++T) {
    const int tk = (T == 0 ? tk0 : T == 1 ? tk1 : T == 2 ? tk2 : tk3);
    const bf16_t* kp = kbase + (size_t)(tk + fr) * kstride + fq * 8;
    const bf16x8 k0 = *(const bf16x8*)kp;
    const bf16x8 k1 = *(const bf16x8*)(kp + 32);
    f32x4 z = (f32x4){0.f, 0.f, 0.f, 0.f};
    z = __builtin_amdgcn_mfma_f32_16x16x32_bf16(k0, qf0, z, 0, 0, 0);
    z = __builtin_amdgcn_mfma_f32_16x16x32_bf16(k1, qf1, z, 0, 0, 0);
    s[T] = z;
  }
  float cmax = -INFINITY;
#pragma unroll
  for (int T = 0; T < 4; ++T) {
#pragma unroll
    for (int j = 0; j < 4; ++j) {
      float v = s[T][j] * 0.125f;
      if (LATBIAS) {
        const int kc = band + (T & 1) * 16 + fq * 4 + j;
        const int cs = min(max(qc - 8, 0), 48);
        const bool valid = (kc >= cs) && (kc < cs + 16);
        const int dr = dr0 + (T >> 1);
        const int dc = min(max(kc - qc + 15, 0), 30);
        v = valid ? v + rpb_h[dr * 31 + dc] : -INFINITY;
      }
      s[T][j] = v;
      cmax = fmaxf(cmax, v);
    }
  }
  cmax = fmaxf(cmax, __shfl_xor(cmax, 16));
  cmax = fmaxf(cmax, __shfl_xor(cmax, 32));
  const float mnew = fmaxf(m, cmax);
  const float alpha = __expf(m - mnew);
  m = mnew;
  float ps = 0.f;
#pragma unroll
  for (int T = 0; T < 4; ++T)
#pragma unroll
    for (int j = 0; j < 4; ++j) {
      const float pv = __expf(s[T][j] - mnew);
      s[T][j] = pv;
      ps += pv;
    }
  lsum = lsum * alpha + ps;
#pragma unroll
  for (int dt = 0; dt < 4; ++dt) o[dt] *= alpha;
#pragma unroll
  for (int pr = 0; pr < 2; ++pr) {
    u32x4 pk;
    pk[0] = cvt_pk_bf16(s[2 * pr][0], s[2 * pr][1]);
    pk[1] = cvt_pk_bf16(s[2 * pr][2], s[2 * pr][3]);
    pk[2] = cvt_pk_bf16(s[2 * pr + 1][0], s[2 * pr + 1][1]);
    pk[3] = cvt_pk_bf16(s[2 * pr + 1][2], s[2 * pr + 1][3]);
    const bf16x8 pa = __builtin_bit_cast(bf16x8, pk);
    const int ta = (pr == 0 ? tk0 : tk2) + fq * 4, tb = (pr == 0 ? tk1 : tk3) + fq * 4;
#pragma unroll
    for (int dt = 0; dt < 4; ++dt) {
      const bf16_t* vp = vtbase + (dt * 16 + fr) * 32;
      const u32x2 lo = *(const u32x2*)(vp + (size_t)(ta >> 5) * 2048 + (ta & 31));
      const u32x2 hi = *(const u32x2*)(vp + (size_t)(tb >> 5) * 2048 + (tb & 31));
      u32x4 vv;
      vv[0] = lo[0]; vv[1] = lo[1]; vv[2] = hi[0]; vv[3] = hi[1];
      o[dt] = __builtin_amdgcn_mfma_f32_16x16x32_bf16(__builtin_bit_cast(bf16x8, vv), pa, o[dt], 0, 0, 0);
    }
  }
}

DI void attn_finish(bf16_t* ys_row, float lsum, const f32x4 (&o)[4], int lane) {
  const int fq = lane >> 4;
  lsum += __shfl_xor(lsum, 16);
  lsum += __shfl_xor(lsum, 32);
  const float inv = 1.f / lsum;
#pragma unroll
  for (int dt = 0; dt < 4; ++dt) store_bf16x4(ys_row + dt * 16 + fq * 4, o[dt] * inv);
}

constexpr int ATT_VROW = 528, ATT_SV_OFF = 32768;
template <bool VTILED>
DI void attn_stage_kv(const bf16_t* __restrict__ kbase, int kstride, int ktok0, const bf16_t* __restrict__ vtbase,
                      int vstride, int vtok0, char* smem, int tid) {
  gemm_stage<256>(kbase, kstride, ktok0, 0, smem, tid);
  const int d = tid >> 3, seg = tid & 7;
  const bf16_t* vp = VTILED ? vtbase + ((size_t)((vtok0 >> 5) + seg) * 64 + d) * 32
                            : vtbase + (size_t)d * vstride + vtok0 + seg * 32;
  char* dst = smem + ATT_SV_OFF + d * ATT_VROW + seg * 64;
#pragma unroll
  for (int i = 0; i < 4; ++i) *(u32x4*)(dst + i * 16) = *(const u32x4*)(vp + i * 8);
}
DI void attn_chunk_lds(const bf16x8 qf0, const bf16x8 qf1, const char* sK, const char* sV, int t0, float& m,
                       float& lsum, f32x4 (&o)[4], int lane) {
  const int fr = lane & 15, fq = lane >> 4;
  f32x4 s[4];
#pragma unroll
  for (int T = 0; T < 4; ++T) {
    const char* kp = sK + (t0 + T * 16 + fr) * 128;
    const bf16x8 k0 = *(const bf16x8*)(kp + ((fq ^ (fr & 7)) << 4));
    const bf16x8 k1 = *(const bf16x8*)(kp + (((4 + fq) ^ (fr & 7)) << 4));
    f32x4 z = (f32x4){0.f, 0.f, 0.f, 0.f};
    z = __builtin_amdgcn_mfma_f32_16x16x32_bf16(k0, qf0, z, 0, 0, 0);
    z = __builtin_amdgcn_mfma_f32_16x16x32_bf16(k1, qf1, z, 0, 0, 0);
    s[T] = z;
  }
  float cmax = -INFINITY;
#pragma unroll
  for (int T = 0; T < 4; ++T)
#pragma unroll
    for (int j = 0; j < 4; ++j) {
      s[T][j] *= 0.18033688f;
      cmax = fmaxf(cmax, s[T][j]);
    }
  cmax = fmaxf(cmax, __shfl_xor(cmax, 16));
  cmax = fmaxf(cmax, __shfl_xor(cmax, 32));
  const float mnew = fmaxf(m, cmax);
  const float alpha = __builtin_amdgcn_exp2f(m - mnew);
  m = mnew;
  float ps = 0.f;
#pragma unroll
  for (int T = 0; T < 4; ++T)
#pragma unroll
    for (int j = 0; j < 4; ++j) {
      const float pv = __builtin_amdgcn_exp2f(s[T][j] - mnew);
      s[T][j] = pv;
      ps += pv;
    }
  lsum = lsum * alpha + ps;
#pragma unroll
  for (int dt = 0; dt < 4; ++dt) o[dt] *= alpha;
#pragma unroll
  for (int pr = 0; pr < 2; ++pr) {
    u32x4 pk;
    pk[0] = cvt_pk_bf16(s[2 * pr][0], s[2 * pr][1]);
    pk[1] = cvt_pk_bf16(s[2 * pr][2], s[2 * pr][3]);
    pk[2] = cvt_pk_bf16(s[2 * pr + 1][0], s[2 * pr + 1][1]);
    pk[3] = cvt_pk_bf16(s[2 * pr + 1][2], s[2 * pr + 1][3]);
    const bf16x8 pa = __builtin_bit_cast(bf16x8, pk);
#pragma unroll
    for (int dt = 0; dt < 4; ++dt) {
      const char* vp = sV + (dt * 16 + fr) * ATT_VROW + (t0 + pr * 32 + fq * 4) * 2;
      const u32x2 lo = *(const u32x2*)vp;
      const u32x2 hi = *(const u32x2*)(vp + 32);
      u32x4 vv;
      vv[0] = lo[0]; vv[1] = lo[1]; vv[2] = hi[0]; vv[3] = hi[1];
      o[dt] = __builtin_amdgcn_mfma_f32_16x16x32_bf16(__builtin_bit_cast(bf16x8, vv), pa, o[dt], 0, 0, 0);
    }
  }
}

DI void attn_ctx_item(const Params& p, int it, char* smem) {
  const int tid = tidx(), wid = tid >> 6, lane = tid & 63;
  const int b = it >> 4, h = (it >> 1) & 7, qt = (it & 1) * 8 + wid;
  const int fr = lane & 15, fq = lane >> 4;
  __syncthreads();
  attn_stage_kv<true>(p.Z + 2048 + h * 64, INW, b * 256, p.VT + (size_t)h * 256 * 2048, NTOK, b * 256, smem, tid);
  const int qtok = b * 256 + qt * 16 + fr;
  const bf16_t* qp = p.Z + (size_t)qtok * INW + 1536 + h * 64 + fq * 8;
  const bf16x8 qf0 = *(const bf16x8*)qp, qf1 = *(const bf16x8*)(qp + 32);
  float m = -INFINITY, lsum = 0.f;
  f32x4 o[4];
#pragma unroll
  for (int dt = 0; dt < 4; ++dt) o[dt] = (f32x4){0.f, 0.f, 0.f, 0.f};
  __syncthreads();
  for (int ch = 0; ch < 4; ++ch) attn_chunk_lds(qf0, qf1, smem, smem + ATT_SV_OFF, ch * 64, m, lsum, o, lane);
  attn_finish(p.YS + (size_t)qtok * 1536 + 512 + h * 64, lsum, o, lane);
}

DI void attn_lat_item(const Params& p, int l, int it, char* smem) {
  const int tid = tidx(), wid = tid >> 6, lane = tid & 63;
  const int b = it >> 6, h = (it >> 3) & 7, r = (it & 7) * 2 + (wid >> 2), j = wid & 3;
  const int fr = lane & 15, fq = lane >> 4;
  __syncthreads();
  {
    const size_t cb = (size_t)((b * 2 + l) * 8 + h) * 16384;
    attn_stage_kv<false>(p.KC + cb, 64, 0, p.VCT + cb, 256, 0, smem, tid);
  }
  const int qc = j * 16 + fr;
  const int qtok = NCTX + b * 1024 + r * 64 + qc;
  const bf16_t* qp = p.Z + (size_t)qtok * INW + 1536 + h * 64 + fq * 8;
  const bf16x8 qf0 = *(const bf16x8*)qp, qf1 = *(const bf16x8*)(qp + 32);
  float m = -INFINITY, lsum = 0.f;
  f32x4 o[4];
#pragma unroll
  for (int dt = 0; dt < 4; ++dt) o[dt] = (f32x4){0.f, 0.f, 0.f, 0.f};
  {
    const bf16_t* kbase = p.Z + 2048 + h * 64;
    const bf16_t* vtbase = p.VT + (size_t)h * 256 * 2048;
    const float* rpb_h = p.rpb + (size_t)(l * 8 + h) * 15 * 31;
    const int rs = min(max(r - 4, 0), 8);
    const int band = min(max(j * 16 - 8, 0), 32);
    for (int ch = 0; ch < 4; ++ch) {
      const int kr = rs + 2 * ch;
      const int t0 = NCTX + b * 1024 + kr * 64 + band;
      attn_chunk<true>(qf0, qf1, kbase, INW, vtbase, NTOK, t0, t0 + 16, t0 + 64, t0 + 80, rpb_h, kr - r + 7, band, qc,
                       m, lsum, o, lane);
    }
  }
  __syncthreads();
  for (int ch = 0; ch < 4; ++ch) attn_chunk_lds(qf0, qf1, smem, smem + ATT_SV_OFF, ch * 64, m, lsum, o, lane);
  attn_finish(p.YS + (size_t)qtok * 1536 + 512 + h * 64, lsum, o, lane);
}

DI void attn_load_k(const bf16_t* __restrict__ kbase, int t0, int lane, bf16x8 (&kf)[8]) {
  const int fr = lane & 15, fq = lane >> 4;
#pragma unroll
  for (int T = 0; T < 4; ++T) {
    const int tk = t0 + (T & 1) * 16 + (T >> 1) * 64;
    const bf16_t* kp = kbase + (size_t)(tk + fr) * INW + fq * 8;
    kf[2 * T] = *(const bf16x8*)kp;
    kf[2 * T + 1] = *(const bf16x8*)(kp + 32);
  }
}
DI void attn_load_v(const bf16_t* __restrict__ vtbase, int t0, int lane, u32x4 (&vf)[8]) {
  const int fr = lane & 15, fq = lane >> 4;
#pragma unroll
  for (int pr = 0; pr < 2; ++pr) {
    const int ta = t0 + pr * 64 + fq * 4, tb = ta + 16;
#pragma unroll
    for (int dt = 0; dt < 4; ++dt) {
      const bf16_t* vp = vtbase + (dt * 16 + fr) * 32;
      const u32x2 lo = *(const u32x2*)(vp + (size_t)(ta >> 5) * 2048 + (ta & 31));
      const u32x2 hi = *(const u32x2*)(vp + (size_t)(tb >> 5) * 2048 + (tb & 31));
      u32x4 vv;
      vv[0] = lo[0]; vv[1] = lo[1]; vv[2] = hi[0]; vv[3] = hi[1];
      vf[pr * 4 + dt] = vv;
    }
  }
}
DI void attn_chunk_lat(const bool HAS_NEXT, const bf16x8 qf0, const bf16x8 qf1, bf16x8 (&kf)[8], u32x4 (&vf)[8],
                       const bf16_t* __restrict__ kbase, const bf16_t* __restrict__ vtbase, int t0,
                       const float* rpb_h, int dr0, int band, int qc, float& m, float& lsum, f32x4 (&o)[4], int lane) {
  const int fr = lane & 15, fq = lane >> 4;
  f32x4 s[4];
#pragma unroll
  for (int T = 0; T < 4; ++T) {
    f32x4 z = (f32x4){0.f, 0.f, 0.f, 0.f};
    z = __builtin_amdgcn_mfma_f32_16x16x32_bf16(kf[2 * T], qf0, z, 0, 0, 0);
    z = __builtin_amdgcn_mfma_f32_16x16x32_bf16(kf[2 * T + 1], qf1, z, 0, 0, 0);
    s[T] = z;
  }

  float cmax = -INFINITY;
  const int cs = min(max(qc - 8, 0), 48);
#pragma unroll
  for (int T = 0; T < 4; ++T) {
#pragma unroll
    for (int j = 0; j < 4; ++j) {
      const int kc = band + (T & 1) * 16 + fq * 4 + j;
      const bool valid = (kc >= cs) && (kc < cs + 16);
      const int dc = min(max(kc - qc + 15, 0), 30);
      const float v = valid ? s[T][j] * 0.18033688f + rpb_h[(dr0 + (T >> 1)) * 31 + dc] : -INFINITY;
      s[T][j] = v;
      cmax = fmaxf(cmax, v);
    }
  }
  cmax = fmaxf(cmax, __shfl_xor(cmax, 16));
  cmax = fmaxf(cmax, __shfl_xor(cmax, 32));
  const float mnew = fmaxf(m, cmax);
  const float alpha = __builtin_amdgcn_exp2f(m - mnew);
  m = mnew;
  float ps = 0.f;
#pragma unroll
  for (int T = 0; T < 4; ++T)
#pragma unroll
    for (int j = 0; j < 4; ++j) {
      const float pv = __builtin_amdgcn_exp2f(s[T][j] - mnew);
      s[T][j] = pv;
      ps += pv;
    }
  lsum = lsum * alpha + ps;
#pragma unroll
  for (int dt = 0; dt < 4; ++dt) o[dt] *= alpha;
#pragma unroll
  for (int pr = 0; pr < 2; ++pr) {
    u32x4 pk;
    pk[0] = cvt_pk_bf16(s[2 * pr][0], s[2 * pr][1]);
    pk[1] = cvt_pk_bf16(s[2 * pr][2], s[2 * pr][3]);
    pk[2] = cvt_pk_bf16(s[2 * pr + 1][0], s[2 * pr + 1][1]);
    pk[3] = cvt_pk_bf16(s[2 * pr + 1][2], s[2 * pr + 1][3]);
    const bf16x8 pa = __builtin_bit_cast(bf16x8, pk);
#pragma unroll
    for (int dt = 0; dt < 4; ++dt)
      o[dt] = __builtin_amdgcn_mfma_f32_16x16x32_bf16(__builtin_bit_cast(bf16x8, vf[pr * 4 + dt]), pa, o[dt], 0, 0, 0);
  }
  if (HAS_NEXT) {
    attn_load_k(kbase, t0 + 128, lane, kf);
    attn_load_v(vtbase, t0 + 128, lane, vf);
  }
}

constexpr int ATT_REGION = 32768 + 64 * ATT_VROW;
DI void attn_pair(const Params& p, int l, int it, char* smem) {
  const int tid = tidx(), wid = tid >> 6, lane = tid & 63;
  const int fr = lane & 15, fq = lane >> 4;
  const int lb = it >> 6, lh = (it >> 3) & 7, r = (it & 7) * 2 + (wid >> 2), j = wid & 3;
  const int qc = j * 16 + fr;
  const int lqtok = NCTX + lb * 1024 + r * 64 + qc;
  const int cb_ = it >> 4, ch_ = (it >> 1) & 7, qt = (it & 1) * 8 + wid;
  const int cqtok = cb_ * 256 + qt * 16 + fr;
  __syncthreads();
  {
    const size_t cbo = (size_t)((lb * 2 + l) * 8 + lh) * 16384;
    attn_stage_kv<false>(p.KC + cbo, 64, 0, p.VCT + cbo, 256, 0, smem, tid);
    attn_stage_kv<true>(p.Z + 2048 + ch_ * 64, INW, cb_ * 256, p.VT + (size_t)ch_ * 256 * 2048, NTOK, cb_ * 256, smem + ATT_REGION, tid);
  }
  const bf16_t* lqp = p.Z + (size_t)lqtok * INW + 1536 + lh * 64 + fq * 8;
  const bf16x8 lq0 = *(const bf16x8*)lqp, lq1 = *(const bf16x8*)(lqp + 32);
  const bf16_t* kbase = p.Z + 2048 + lh * 64;
  const bf16_t* vtbase = p.VT + (size_t)lh * 256 * 2048;
  const float* rpb_h = p.rpb + (size_t)(l * 8 + lh) * 15 * 31;
  const int rs = min(max(r - 4, 0), 8);
  const int band = min(max(j * 16 - 8, 0), 32);
  const int tbase = NCTX + lb * 1024 + rs * 64 + band;
  float* rpb_s = (float*)(smem + 2 * ATT_REGION);
  if (tid < 465) rpb_s[tid] = rpb_h[tid] * 1.4426950409f;
  bf16x8 kA[8];
  u32x4 vA[8];
  attn_load_k(kbase, tbase, lane, kA);
  attn_load_v(vtbase, tbase, lane, vA);
  float m = -INFINITY, lsum = 0.f;
  f32x4 o[4];
#pragma unroll
  for (int dt = 0; dt < 4; ++dt) o[dt] = (f32x4){0.f, 0.f, 0.f, 0.f};
  const bf16_t* cqp = p.Z + (size_t)cqtok * INW + 1536 + ch_ * 64 + fq * 8;
  const bf16x8 cq0 = *(const bf16x8*)cqp, cq1 = *(const bf16x8*)(cqp + 32);
  float m2 = -INFINITY, l2 = 0.f;
  f32x4 o2[4];
#pragma unroll
  for (int dt = 0; dt < 4; ++dt) o2[dt] = (f32x4){0.f, 0.f, 0.f, 0.f};
  __syncthreads();
#pragma unroll 1
  for (int ch = 0; ch < 4; ++ch) {
    attn_chunk_lds(lq0, lq1, smem, smem + ATT_SV_OFF, ch * 64, m, lsum, o, lane);
    attn_chunk_lds(cq0, cq1, smem + ATT_REGION, smem + ATT_REGION + ATT_SV_OFF, ch * 64, m2, l2, o2, lane);
    __builtin_amdgcn_sched_barrier(0);
    attn_chunk_lat(ch < 3, lq0, lq1, kA, vA, kbase, vtbase, tbase + ch * 128, rpb_s, rs + 2 * ch - r + 7, band, qc, m, lsum, o, lane);
    __builtin_amdgcn_sched_barrier(0);
  }
  attn_finish(p.YS + (size_t)cqtok * 1536 + 512 + ch_ * 64, l2, o2, lane);
  attn_finish(p.YS + (size_t)lqtok * 1536 + 512 + lh * 64, lsum, o, lane);
}

DI void attn_ctx_unit(const Params& p, int u, int lane) {
  const int b = u >> 7, h = (u >> 4) & 7, qt = u & 15;
  const int fr = lane & 15, fq = lane >> 4;
  const int qtok = b * 256 + qt * 16 + fr;
  const bf16_t* qp = p.Z + (size_t)qtok * INW + 1536 + h * 64 + fq * 8;
  const bf16x8 qf0 = *(const bf16x8*)qp, qf1 = *(const bf16x8*)(qp + 32);
  const bf16_t* kbase = p.Z + 2048 + h * 64;
  const bf16_t* vtbase = p.VT + (size_t)h * 64 * NTOK;
  float m = -INFINITY, lsum = 0.f;
  f32x4 o[4];
#pragma unroll
  for (int dt = 0; dt < 4; ++dt) o[dt] = (f32x4){0.f, 0.f, 0.f, 0.f};
  for (int ch = 0; ch < 4; ++ch) {
    const int t0 = b * 256 + ch * 64;
    attn_chunk<false>(qf0, qf1, kbase, INW, vtbase, NTOK, t0, t0 + 16, t0 + 32, t0 + 48, nullptr, 0, 0, 0, m, lsum, o,
                      lane);
  }
  attn_finish(p.YS + (size_t)qtok * 1536 + 512 + h * 64, lsum, o, lane);
}

DI void attn_lat_unit(const Params& p, int l, int u, int lane) {
  const int b = u >> 9, h = (u >> 6) & 7, r = (u >> 2) & 15, j = u & 3;
  const int fr = lane & 15, fq = lane >> 4;
  const int qc = j * 16 + fr;
  const int qtok = NCTX + b * 1024 + r * 64 + qc;
  const bf16_t* qp = p.Z + (size_t)qtok * INW + 1536 + h * 64 + fq * 8;
  const bf16x8 qf0 = *(const bf16x8*)qp, qf1 = *(const bf16x8*)(qp + 32);
  float m = -INFINITY, lsum = 0.f;
  f32x4 o[4];
#pragma unroll
  for (int dt = 0; dt < 4; ++dt) o[dt] = (f32x4){0.f, 0.f, 0.f, 0.f};
  {
    const bf16_t* kbase = p.Z + 2048 + h * 64;
    const bf16_t* vtbase = p.VT + (size_t)h * 64 * NTOK;
    const float* rpb_h = p.rpb + (size_t)(l * 8 + h) * 15 * 31;
    const int rs = min(max(r - 4, 0), 8);
    const int band = min(max(j * 16 - 8, 0), 32);
    for (int ch = 0; ch < 4; ++ch) {
      const int kr = rs + 2 * ch;
      const int t0 = NCTX + b * 1024 + kr * 64 + band;
      attn_chunk<true>(qf0, qf1, kbase, INW, vtbase, NTOK, t0, t0 + 16, t0 + 64, t0 + 80, rpb_h, kr - r + 7, band, qc,
                       m, lsum, o, lane);
    }
  }
  {
    const bf16_t* kbase = p.KC + (size_t)((b * 2 + l) * 8 + h) * 16384;
    const bf16_t* vtbase = p.VCT + (size_t)((b * 2 + l) * 8 + h) * 16384;
    for (int ch = 0; ch < 4; ++ch) {
      const int t0 = ch * 64;
      attn_chunk<false>(qf0, qf1, kbase, 64, vtbase, 256, t0, t0 + 16, t0 + 32, t0 + 48, nullptr, 0, 0, 0, m, lsum, o,
                        lane);
    }
  }
  attn_finish(p.YS + (size_t)qtok * 1536 + 512 + h * 64, lsum, o, lane);
}

DI void unpack8(u32x4 u, float (&f)[8]) {
#pragma unroll
  for (int j = 0; j < 4; ++j) {
    f[2 * j] = bf_lo(u[j]);
    f[2 * j + 1] = bf_hi(u[j]);
  }
}
DI u32x4 pack8(const float (&f)[8]) {
  u32x4 o;
#pragma unroll
  for (int j = 0; j < 4; ++j) o[j] = cvt_pk_bf16(f[2 * j], f[2 * j + 1]);
  return o;
}

DI void conv_item(const Params& p, int l, int it) {
  const int t = tidx();
  const int row = it * 8 + (t >> 6), ch = (t & 63) * 8;
  const bf16_t* z = p.Z + (size_t)row * INW;
  float bg[8], a[8], b[8], acc[8];
  unpack8(*(const u32x4*)(z + ch), bg);
  const float* cw = p.conv_w + (size_t)l * 3 * 512 + ch;
  unpack8(*(const u32x4*)(z + 512 + ch), a);
  unpack8(*(const u32x4*)(z + 1024 + ch), b);
#pragma unroll
  for (int j = 0; j < 8; ++j) acc[j] = a[j] * b[j] * cw[512 + j];
  if (!seq_first(row)) {
    unpack8(*(const u32x4*)(z - INW + 512 + ch), a);
    unpack8(*(const u32x4*)(z - INW + 1024 + ch), b);
#pragma unroll
    for (int j = 0; j < 8; ++j) acc[j] += a[j] * b[j] * cw[j];
  }
  if (!seq_last(row)) {
    unpack8(*(const u32x4*)(z + INW + 512 + ch), a);
    unpack8(*(const u32x4*)(z + INW + 1024 + ch), b);
#pragma unroll
    for (int j = 0; j < 8; ++j) acc[j] += a[j] * b[j] * cw[1024 + j];
  }
#pragma unroll
  for (int j = 0; j < 8; ++j) acc[j] *= bg[j];
  *(u32x4*)(p.YS + (size_t)row * 1536 + ch) = pack8(acc);
}

DI void pool_item(const Params& p, int it) {
  const int t = tidx();
  const int row = it * 8 + (t >> 6), ch = (t & 63) * 8;
  const int g = ch >> 7, w = 2 << g;
  int seq0, seqn;
  if (row < NCTX) { seq0 = row & ~255; seqn = 256; } else { seq0 = row & ~1023; seqn = 1024; }
  const int tt = row - seq0;
  const int lo = max(tt - w / 2, 0), hi = min(tt - w / 2 + w, seqn);
  float acc[8], f[8];
#pragma unroll
  for (int j = 0; j < 8; ++j) acc[j] = 0.f;
  const bf16_t* zp = p.Z + (size_t)(seq0 + lo) * INW + 3072 + ch;
  const int cnt = hi - lo;
  u32x4 wv[16];
#pragma unroll
  for (int q = 0; q < 16; ++q) wv[q] = (q < cnt) ? *(const u32x4*)(zp + (size_t)q * INW) : (u32x4){0u, 0u, 0u, 0u};
#pragma unroll
  for (int q = 0; q < 16; ++q) {
    unpack8(wv[q], f);
#pragma unroll
    for (int j = 0; j < 8; ++j) acc[j] += f[j];
  }
  unpack8(*(const u32x4*)(p.Z + (size_t)row * INW + 3072 + ch), f);
  const float inv = 1.f / (float)(hi - lo);
#pragma unroll
  for (int j = 0; j < 8; ++j) acc[j] = acc[j] * inv - f[j];
  *(u32x4*)(p.YS + (size_t)row * 1536 + 1024 + ch) = pack8(acc);
}

DI float gelu_tanh(float x) {
  const float t = x * (1.5957691216f + 0.0713548163f * x * x);
  return x * __builtin_amdgcn_rcpf(1.f + __builtin_amdgcn_exp2f(-1.4426950409f * t));
}
DI void act_item(const Params& p, int l, int it) {
  const int id = it * NTHREADS + tidx();
  const int row = (id / 352) * 4, ch = (id % 352) * 8;
  const bf16_t* u = p.U + (size_t)row * (2 * DFF) + ch;
  const float* cw = p.f_conv + (size_t)l * 3 * DFF + ch;
  const bool first = seq_first(row), last = seq_last(row + 3);
  u32x4 ur[6], vr[4];
#pragma unroll
  for (int i = 0; i < 6; ++i) {
    const bool ok = (i == 0) ? !first : (i == 5) ? !last : true;
    ur[i] = ok ? *(const u32x4*)(u + (ptrdiff_t)(i - 1) * (2 * DFF)) : (u32x4){0u, 0u, 0u, 0u};
  }
#pragma unroll
  for (int i = 0; i < 4; ++i) vr[i] = *(const u32x4*)(u + (size_t)i * (2 * DFF) + DFF);
  float w0[8], w1[8], w2[8];
#pragma unroll
  for (int j = 0; j < 8; ++j) { w0[j] = cw[j]; w1[j] = cw[DFF + j]; w2[j] = cw[2 * DFF + j]; }
#pragma unroll
  for (int i = 0; i < 4; ++i) {
    float a[8], b[8], c[8], val[8], acc[8];
    unpack8(ur[i], a);
    unpack8(ur[i + 1], b);
    unpack8(ur[i + 2], c);
    unpack8(vr[i], val);
#pragma unroll
    for (int j = 0; j < 8; ++j) acc[j] = gelu_tanh(a[j] * w0[j] + b[j] * w1[j] + c[j] * w2[j]) * val[j];
    *(u32x4*)(p.ACT + (size_t)(row + i) * DFF + ch) = pack8(acc);
  }
}

DI void final_row(const Params& p, int row) {
  const int lane = tidx() & 63;
  const float* xr = p.X + (size_t)row * D;
  f32x4 v[4];
  float ss = 0.f;
#pragma unroll
  for (int i = 0; i < 4; ++i) {
    v[i] = *(const f32x4*)(xr + i * 256 + lane * 4);
    ss += v[i][0] * v[i][0] + v[i][1] * v[i][1] + v[i][2] * v[i][2] + v[i][3] * v[i][3];
  }
  ss = wave_sum(ss);
  const float rstd = rsqrtf(ss * (1.f / 1024.f) + 1e-6f);
#pragma unroll
  for (int i = 0; i < 4; ++i) {
    const int col = i * 256 + lane * 4;
    const f32x4 gg = *(const f32x4*)(p.g_final + col);
    f32x4 o;
#pragma unroll
    for (int j = 0; j < 4; ++j) o[j] = v[i][j] * rstd * gg[j];
    *(f32x4*)(p.out + (size_t)row * D + col) = o;
  }
}

constexpr int EDGE_STRIDE = 32 * 2 * DFF;
template <int CTRL>
DI float dpp_rot(float x) {
  return __builtin_bit_cast(float, __builtin_amdgcn_update_dpp(0, __builtin_bit_cast(int, x), CTRL, 0xf, 0xf, false));
}
struct EpiAct {
  static constexpr bool PERM = true, AFTER_DRAIN = false;
  bf16_t* ACT; const float* cw; float* edge; float* ex;
  DI void operator()(const f32x4 (&acc)[2][2][4][2], const pg8::Unit& u, int wr, int wc, int fr, int fq) const {
    const int chl = wc * 32 + fq * 8, ch0 = u.pn * 128 + chl;
    float w0[8], w1[8], w2[8];
#pragma unroll
    for (int j = 0; j < 8; ++j) { w0[j] = cw[ch0 + j]; w1[j] = cw[DFF + ch0 + j]; w2[j] = cw[2 * DFF + ch0 + j]; }
    float* EXF = ex;
    float* EXL = ex + 512;
#pragma unroll
    for (int ai = 0; ai < 2; ++ai) {
      const int blk = 2 * ai + wr;
      if (fr == 0) {
        *(f32x4*)(EXF + blk * 128 + chl) = acc[ai][0][0][0];
        *(f32x4*)(EXF + blk * 128 + chl + 4) = acc[ai][0][0][1];
      }
      if (fr == 15) {
        *(f32x4*)(EXL + blk * 128 + chl) = acc[ai][0][3][0];
        *(f32x4*)(EXL + blk * 128 + chl + 4) = acc[ai][0][3][1];
      }
    }
    asm volatile("s_waitcnt lgkmcnt(0)" ::: "memory");
    __builtin_amdgcn_s_barrier();
#pragma unroll
    for (int ai = 0; ai < 2; ++ai) {
      const int blk = 2 * ai + wr;
#pragma unroll
      for (int m = 0; m < 4; ++m) {
        const int row = u.pm * 256 + ai * 128 + wr * 64 + m * 16 + fr;
        float a[8], pre[8];
#pragma unroll
        for (int j = 0; j < 8; ++j) {
          const float x = acc[ai][0][m][j >> 2][j & 3];
          float pedge, nedge;
          if (m > 0) pedge = acc[ai][0][m > 0 ? m - 1 : 0][j >> 2][j & 3]; else pedge = (blk > 0) ? EXL[(blk - 1) * 128 + chl + j] : 0.f;
          if (m < 3) nedge = acc[ai][0][m < 3 ? m + 1 : 3][j >> 2][j & 3]; else nedge = (blk < 3) ? EXF[(blk + 1) * 128 + chl + j] : 0.f;
          const float pedge15 = pedge, nedge0 = nedge;
          const float prev = dpp_rot<0x121>((fr == 15) ? pedge15 : x);
          const float next = dpp_rot<0x12F>((fr == 0) ? nedge0 : x);
          pre[j] = w0[j] * prev + w1[j] * x + w2[j] * next;
          a[j] = gelu_tanh(pre[j]) * acc[ai][1][m][j >> 2][j & 3];
        }
        *(u32x4*)(ACT + (size_t)row * DFF + ch0) = pack8(a);
        const bool first_row = (ai == 0 && wr == 0 && m == 0 && fr == 0), last_row = (ai == 1 && wr == 1 && m == 3 && fr == 15);
        if ((m == 0 || m == 3) && (first_row || last_row)) {
          float* e = edge + (size_t)(u.pm * 2 + (last_row ? 1 : 0)) * DFF + ch0;
#pragma unroll
          for (int j = 0; j < 8; ++j) {
            e[j] = pre[j];
            e[EDGE_STRIDE + j] = acc[ai][1][m][j >> 2][j & 3];
            e[2 * EDGE_STRIDE + j] = acc[ai][0][m][j >> 2][j & 3];
          }
        }
      }
    }
  }
};
DI void act_fix_item(const Params& p, int l, int it) {
  const int id = it * NTHREADS + tidx();
  if (id >= 12 * DFF) return;
  const int e = id / DFF, c = id % DFF;
  const int pmB = 16 + (e / 3) * 4 + (e % 3) + 1;
  const float* edge = (const float*)p.U;
  const float* cw = p.f_conv + (size_t)l * 3 * DFF;
  const float* eA = edge + (size_t)((pmB - 1) * 2 + 1) * DFF + c;
  const float* eB = edge + (size_t)(pmB * 2 + 0) * DFF + c;
  const float actA = gelu_tanh(eA[0] + cw[2 * DFF + c] * eB[2 * EDGE_STRIDE]) * eA[EDGE_STRIDE];
  const float actB = gelu_tanh(eB[0] + cw[c] * eA[2 * EDGE_STRIDE]) * eB[EDGE_STRIDE];
  p.ACT[(size_t)(pmB * 256 - 1) * DFF + c] = (bf16_t)(cvt_pk_bf16(actA, 0.f) & 0xffffu);
  p.ACT[(size_t)(pmB * 256) * DFF + c] = (bf16_t)(cvt_pk_bf16(actB, 0.f) & 0xffffu);
}

constexpr int N_PHASES = 20;
extern __shared__ __attribute__((aligned(16))) char g_smem[];
#define NI __device__ __forceinline__
constexpr size_t KV_OFF = (size_t)NTOK * D;

constexpr int WIN1_EARLY = 320;
constexpr int PREP_REST = PREP_ITEMS - PREP_T_IN;
DI void prep_rest_item(const Params& p, int l, int k, float* sm) {
  prep_item(p, l, k < PREP_WEFF ? k : k + PREP_T_IN, sm);
}
NI void ph_prep0(const Params& p) {
  char* smem = g_smem;
  const int nb = gridDim.x, bid = bidx();
  const int total = PREP_T_IN + MOD_ITEMS + CACHE_ITEMS;
  for (int it = bid; it < total; it += nb) {
    if (it < MOD_ITEMS) mod_item(p, it, (float*)smem);
    else if (it < MOD_ITEMS + CACHE_ITEMS) cache_item(p, it - MOD_ITEMS);
    else prep_item(p, 0, PREP_WEFF + (it - MOD_ITEMS - CACHE_ITEMS), (float*)smem);
  }
}
NI void ph_final(const Params& p) {
  const int nb = gridDim.x, bid = bidx(), wid = tidx() >> 6;
  for (int row = bid * NWAVES + wid; row < NTOK; row += nb * NWAVES) final_row(p, row);
}
NI void ph_normmod1(const Params& p, int l) {
  char* smem = g_smem;
  const int nb = gridDim.x, bid = bidx(), wid = tidx() >> 6;
  for (int row = (bid * NWAVES + wid) * 2; row < NTOK; row += nb * NWAVES * 2)
    normmod_row2(p, l, 0, row, l == 0 ? xin_row(p, row) : p.X + (size_t)row * D);
  if (l == 1)
    for (int k = WIN1_EARLY + bid; k < PREP_T_IN; k += nb) prep_item(p, 1, PREP_WEFF + k, (float*)smem);
}
NI void ph_inproj(const Params& p, int l) {
  pg8::Gemm g{p.H, p.WIN, NTOK, INW, D};
  pg8::StaticOrder S; S.init(NTOK, INW, (int)gridDim.x, bidx());
  EpiZ8 E{p.Z, p.VT, p.out + KV_OFF, l};
  pg8::gemm_phase<EpiZ8, pg8::StaticOrder, true, true>((PG8_LAS unsigned char*)g_smem, g, S, E);
  __syncthreads();
  {
    const int nb = (int)gridDim.x, nunits = (NTOK / 256) * (INW / 256), busy = nunits % nb, bid = bidx();
    const Params q = load_params();
    if (busy != 0 && bid >= busy)
      for (int k = bid - busy; k < PREP_REST; k += nb - busy) prep_rest_item(q, l, k, (float*)g_smem);
    else if (busy == 0)
      for (int k = bid; k < PREP_REST; k += nb) prep_rest_item(q, l, k, (float*)g_smem);
  }
}
NI void ph_attn(const Params& p, int l) {
  const int nb = gridDim.x, bid = bidx();
  for (int it = bid; it < 256; it += nb) attn_pair(p, l, it, g_smem);
  __syncthreads();
}
NI void ph_convpool(const Params& p, int l) {
  const int nb = gridDim.x, bid = bidx();
  for (int it = bid; it < 2048; it += nb) {
    if (it < 1024) conv_item(p, l, it);
    else pool_item(p, it - 1024);
  }
}
NI void ph_branch(const Params& p) {
  EpiBf16 epi{p.MERGED, D};
  gemm_phase<true>(p.YS, 1536, p.WB, 1536, 1536, D, g_smem, epi, p.Z + 3584);
}
NI void ph_outproj(const Params& p, int l) {
  EpiResid epi{&p, l, 2048, l == 0};
  gemm_phase<false>(p.MERGED, D, p.WO, D, D, D, g_smem, epi, nullptr);
}
NI void ph_normmod2(const Params& p, int l) {
  const int nb = gridDim.x, bid = bidx(), wid = tidx() >> 6;
  for (int row = (bid * NWAVES + wid) * 2; row < NTOK; row += nb * NWAVES * 2) normmod_row2(p, l, 1, row, p.X + (size_t)row * D);
}
NI void ph_up(const Params& p, int l) {
  pg8::Gemm g{p.H, p.WU, NTOK, 2 * DFF, D};
  pg8::StaticOrder S; S.init(NTOK, 2 * DFF, (int)gridDim.x, bidx());
  EpiAct E{p.ACT, p.f_conv + (size_t)l * 3 * DFF, (float*)p.U, (float*)(g_smem + 131072)};
  pg8::gemm_phase<EpiAct, pg8::StaticOrder, true, true>((PG8_LAS unsigned char*)g_smem, g, S, E);
  __syncthreads();
  if (l == 0) {
    const int nb = (int)gridDim.x, nunits = (NTOK / 256) * (2 * DFF / 256), busy = nunits % nb, bid = bidx();
    const Params q = load_params();
    if (busy != 0 && bid >= busy)
      for (int k = bid - busy; k < WIN1_EARLY; k += nb - busy) prep_item(q, 1, PREP_WEFF + k, (float*)g_smem);
    else if (busy == 0)
      for (int k = bid; k < WIN1_EARLY; k += nb) prep_item(q, 1, PREP_WEFF + k, (float*)g_smem);
  }
}
NI void ph_act(const Params& p, int l) {
  const int nb = gridDim.x, bid = bidx();
  for (int it = bid; it < (12 * DFF + NTHREADS - 1) / NTHREADS; it += nb) act_fix_item(p, l, it);
}
DI void act_fix_panel(const Params& p, int l, int pm) {
  if (pm < 16) return;
  const float* edge = (const float*)p.U;
  const float* cw = p.f_conv + (size_t)l * 3 * DFF;
  const int t = tidx();
  if ((pm & 3) != 0) {
    const float* eB = edge + (size_t)(pm * 2 + 0) * DFF;
    const float* eA = edge + (size_t)((pm - 1) * 2 + 1) * DFF;
    for (int c = t; c < DFF; c += NTHREADS) {
      const float a = gelu_tanh(eB[c] + cw[c] * eA[2 * EDGE_STRIDE + c]) * eB[EDGE_STRIDE + c];
      p.ACT[(size_t)(pm * 256) * DFF + c] = (bf16_t)(cvt_pk_bf16(a, 0.f) & 0xffffu);
    }
  }
  if ((pm & 3) != 3) {
    const float* eA = edge + (size_t)(pm * 2 + 1) * DFF;
    const float* eB = edge + (size_t)((pm + 1) * 2 + 0) * DFF;
    for (int c = t; c < DFF; c += NTHREADS) {
      const float a = gelu_tanh(eA[c] + cw[2 * DFF + c] * eB[2 * EDGE_STRIDE + c]) * eA[EDGE_STRIDE + c];
      p.ACT[(size_t)(pm * 256 + 255) * DFF + c] = (bf16_t)(cvt_pk_bf16(a, 0.f) & 0xffffu);
    }
  }
  asm volatile("s_waitcnt vmcnt(0)" ::: "memory");
  __syncthreads();
}
NI void ph_down(const Params& p, int l) {
  {
    const int bid = bidx(), nb = gridDim.x, cstep = nb >> 3;
    for (int cj = bid >> 3; cj < 32; cj += cstep) act_fix_panel(p, l, 4 * (bid & 7) + (cj & 3));
  }
  EpiResid epi{&p, l, 5120, false};
  gemm_phase<false>(p.ACT, DFF, p.WD, DFF, DFF, D, g_smem, epi, nullptr);
}

DI void run_phase(int ph) {
  const Params p = load_params();
  if (ph == 0) { ph_prep0(p); return; }
  if (ph == 19) { ph_final(p); return; }
  const int l = (ph - 1) / 9, s = (ph - 1) % 9;
  switch (s) {
    case 0: ph_normmod1(p, l); break;
    case 1: ph_inproj(p, l); break;
    case 2:
      ph_attn(p, l);
#ifdef REP_ATTN
      if (l == 0) ph_attn(p, l);
#endif
      ph_convpool(p, l);
#ifdef REP_CONVPOOL
      if (l == 0) ph_convpool(p, l);
#endif
      break;
    case 3: ph_branch(p); break;
    case 4: ph_outproj(p, l); break;
    case 5: ph_normmod2(p, l); break;
    case 6: ph_up(p, l); break;
    case 7: ph_act(p, l); break;
    case 8: ph_down(p, l); break;
  }
}


#define XB_TMO      128
#define XB_XCNT(j)  (256  + 64 * (j))
#define XB_XSUB(j)  (1280 + 64 * (j))
#define XB_XGEN(j)  (2304 + 64 * (j))
#define XB_TOP      3328
#define XB_TOPGEN   3392
#define XCD_BAR_WORDS 3456
#define XB_SPIN_CAP (1u << 20)
DI unsigned xb_ld(unsigned* p) { return __hip_atomic_load(p, __ATOMIC_RELAXED, __HIP_MEMORY_SCOPE_AGENT); }
DI unsigned xb_add(unsigned* p, unsigned v) { return __hip_atomic_fetch_add(p, v, __ATOMIC_RELAXED, __HIP_MEMORY_SCOPE_AGENT); }
DI unsigned xb_xcc_id() { return (unsigned)__builtin_amdgcn_s_getreg((3 << 11) | 20) & 0xFu; }
#define XB_SPIN(cond, bar) do { unsigned _sp = 0; while (cond) { __builtin_amdgcn_s_sleep(1); \
    if ((++_sp & 255u) == 0u) { if (xb_ld(&(bar)[XB_TMO])) break; if (_sp > XB_SPIN_CAP) { atomicAdd(&(bar)[XB_TMO], 1u); break; } } } } while (0)
struct XcdBarrier { unsigned* bar; unsigned x; };
DI XcdBarrier xcd_barrier_post(unsigned* bar) {
  XcdBarrier b; b.bar = bar; b.x = xb_xcc_id();
  if (threadIdx.x == 0) {
    volatile unsigned* st = (volatile unsigned*)(g_smem + LDS_XB_OFF);
    st[0] = 0u; st[1] = 0u;
    (void)xb_add(&bar[XB_XCNT(b.x)], 1u);
  }
  return b;
}
DI void xcd_barrier_complete(unsigned* bar, unsigned x, unsigned& nloc, unsigned& nx) {
  const unsigned G = gridDim.x;
  unsigned sum, cnt, mine, sp = 0u;
  for (;;) {
    sum = 0u; cnt = 0u; mine = 0u;
#pragma unroll
    for (unsigned j = 0; j < 16; ++j) { const unsigned c = xb_ld(&bar[XB_XCNT(j)]); sum += c; cnt += (c > 0u) ? 1u : 0u; mine = (j == x) ? c : mine; }
    if (sum == G) break;
    __builtin_amdgcn_s_sleep(1);
    if ((++sp & 255u) == 0u) { if (xb_ld(&bar[XB_TMO])) break; if (sp > XB_SPIN_CAP) { atomicAdd(&bar[XB_TMO], 1u); break; } }
  }
  nloc = mine > 0u ? mine : 1u; nx = cnt > 0u ? cnt : 1u;
}
DI void xcd_barrier(XcdBarrier& b) {
  asm volatile("s_waitcnt vmcnt(0)" ::: "memory");
  __syncthreads();
  if (threadIdx.x == 0) {
    unsigned* bar = b.bar;
    __builtin_amdgcn_s_waitcnt(0);
    volatile unsigned* st = (volatile unsigned*)(g_smem + LDS_XB_OFF);
    unsigned nloc = st[0], nx = st[1];
    if (nloc == 0u) { xcd_barrier_complete(bar, b.x, nloc, nx); st[0] = nloc; st[1] = nx; }
    const unsigned old = xb_add(&bar[XB_XSUB(b.x)], 1u);
    const unsigned gen = old / nloc;
    if (old + 1u == (gen + 1u) * nloc) {
      __builtin_amdgcn_fence(__ATOMIC_RELEASE, "agent");
      asm volatile("s_waitcnt vmcnt(0)" ::: "memory");
      const unsigned og = xb_add(&bar[XB_TOP], 1u);
      const unsigned tg = og / nx;
      if (og + 1u == (tg + 1u) * nx) xb_add(&bar[XB_TOPGEN], 1u);
      else XB_SPIN(xb_ld(&bar[XB_TOPGEN]) == tg, bar);
      __builtin_amdgcn_fence(__ATOMIC_ACQUIRE, "agent");
      xb_add(&bar[XB_XGEN(b.x)], 1u);
      asm volatile("s_waitcnt vmcnt(0)" ::: "memory");
    } else {
      XB_SPIN(xb_ld(&bar[XB_XGEN(b.x)]) == gen, bar);
      __builtin_amdgcn_fence(__ATOMIC_ACQUIRE, "agent");
      asm volatile("s_waitcnt vmcnt(0)" ::: "memory");
    }
  }
  __syncthreads();
}

__global__ void __launch_bounds__(NTHREADS, 2) mega_kernel(Params p, int ph_lo, int ph_hi) {
  cg::grid_group grid = cg::this_grid();
  XcdBarrier xb = xcd_barrier_post(load_params().BAR);
#ifndef REPEAT_MASK
#define REPEAT_MASK 0u
#endif
  for (int ph = ph_lo; ph < ph_hi; ++ph) {
    if (ph >= 1 && (ph - 1) % 9 == 7) continue;
    run_phase(ph);
    if ((REPEAT_MASK >> ph) & 1u) {
      xcd_barrier(xb);
      run_phase(ph);
    }
    if (ph + 1 < ph_hi) xcd_barrier(xb);
  }
  if (ph_hi > 1000) grid.sync();
}

extern "C" void kernel_launch(void* const* d_in, const int* in_sizes, int n_in, void* d_out, int out_size, void* d_ws,
                              size_t ws_size, hipStream_t stream) {
  static int grid_blocks = 0;
  if (!grid_blocks) {
    int dev = 0, cus = 0, per_cu = 0;
    (void)hipGetDevice(&dev);
    (void)hipDeviceGetAttribute(&cus, hipDeviceAttributeMultiprocessorCount, dev);
    (void)hipFuncSetAttribute((const void*)mega_kernel, hipFuncAttributeMaxDynamicSharedMemorySize, LDS_BYTES);
    (void)hipOccupancyMaxActiveBlocksPerMultiprocessor(&per_cu, mega_kernel, NTHREADS, LDS_BYTES);
    if (per_cu < 1) fprintf(stderr, "occupancy query reports %d blocks/CU\n", per_cu);
    grid_blocks = cus;
  }
  Params p{};
  const float** f = (const float**)&p;
  for (int i = 0; i < 20; ++i) f[i] = (const float*)d_in[i];
  p.out = (float*)d_out;
  char* ws = (char*)d_ws;
  size_t off = 0;
  auto take = [&](size_t bytes) { char* r = ws + off; off += (bytes + 255) & ~(size_t)255; return r; };
  p.BAR = (unsigned*)take(XCD_BAR_WORDS * 4);
  p.MOD = (float*)take(2 * 5 * 6144 * 4);
  p.X = (float*)take((size_t)NTOK * D * 4);
  p.KC = (bf16_t*)take((size_t)64 * 16384 * 2);
  p.VCT = (bf16_t*)take((size_t)64 * 16384 * 2);
  p.WIN = (bf16_t*)take((size_t)INW * D * 2);
  p.WB = (bf16_t*)take((size_t)D * 1536 * 2);
  p.WO = (bf16_t*)take((size_t)D * D * 2);
  p.WU = (bf16_t*)take((size_t)2 * DFF * D * 2);
  p.WD = (bf16_t*)take((size_t)D * DFF * 2);
  p.H = (bf16_t*)take((size_t)NTOK * D * 2);
  p.Z = (bf16_t*)take((size_t)NTOK * INW * 2);
  p.U = p.Z;
  char* r2 = take((size_t)NTOK * 1536 * 2 + (size_t)NTOK * D * 2 + (size_t)512 * NTOK * 2);
  p.YS = (bf16_t*)r2;
  p.MERGED = (bf16_t*)(r2 + (size_t)NTOK * 1536 * 2);
  p.VT = (bf16_t*)(r2 + (size_t)NTOK * 1536 * 2 + (size_t)NTOK * D * 2);
  p.ACT = (bf16_t*)r2;
  (void)hipMemsetAsync(p.BAR, 0, XCD_BAR_WORDS * 4, stream);
#ifndef MULTI_LAUNCH
#define MULTI_LAUNCH 0
#endif
#if MULTI_LAUNCH
  for (int ph = 0; ph < N_PHASES; ++ph) mega_kernel<<<dim3(grid_blocks), dim3(NTHREADS), LDS_BYTES, stream>>>(p, ph, ph + 1);
#else
  int lo = 0, hi = N_PHASES;
  void* args[] = {&p, &lo, &hi};
  hipError_t e = hipLaunchCooperativeKernel((void*)mega_kernel, dim3(grid_blocks), dim3(NTHREADS), args, LDS_BYTES, stream);
  if (e != hipSuccess) fprintf(stderr, "cooperative launch failed: %s (grid %d)\n", hipGetErrorString(e), grid_blocks);
#endif
}
```

```cpp
#include <hip/hip_runtime.h>
#include <hip/hip_cooperative_groups.h>
#include <cstdio>
namespace cg = cooperative_groups;

typedef unsigned short bf16_t;
typedef short bf16x8 __attribute__((ext_vector_type(8)));
typedef float f32x4 __attribute__((ext_vector_type(4)));
typedef unsigned u32x4 __attribute__((ext_vector_type(4)));
typedef unsigned u32x2 __attribute__((ext_vector_type(2)));

#define DI __device__ __forceinline__
DI int tidx() { int t = threadIdx.x; asm volatile("" : "+v"(t)); return t; }
DI int bidx() { int b = blockIdx.x; asm volatile("" : "+s"(b)); return b; }

constexpr int D = 1024, NTOK = 8192, NCTX = 4096, INW = 6656, DFF = 2816;
constexpr int NTHREADS = 512, NWAVES = 8;
constexpr int LDS_BYTES = 147456 + 16;
constexpr int LDS_XB_OFF = 147456;

struct Params {
  const float *x_prompt, *x_sample, *cache_kv, *c, *c_ctx, *w_mod, *b_mod, *g1, *g2, *w_in, *conv_w, *rpb, *pool_w,
      *pool_scale, *w_branch, *w_out, *w_up, *f_conv, *w_down, *g_final;
  float* out;
  float* MOD;
  float* X;
  unsigned* BAR;
  bf16_t *KC, *VCT, *WIN, *WB, *WO, *WU, *WD, *H, *Z, *U, *YS, *MERGED, *VT, *ACT;
};

DI Params load_params() {
#if defined(__HIP_DEVICE_COMPILE__)
  typedef __attribute__((address_space(4))) const char* kptr_t;
  kptr_t ka = (kptr_t)__builtin_amdgcn_kernarg_segment_ptr();
  int off = 0;
  asm volatile("" : "+s"(off));
  return *(__attribute__((address_space(4))) const Params*)(ka + off);
#else
  return Params{};
#endif
}

typedef float f32x2 __attribute__((ext_vector_type(2)));
typedef __bf16 bf16x2_t __attribute__((ext_vector_type(2)));
DI unsigned cvt_pk_bf16(float lo, float hi) {
  const f32x2 v = {lo, hi};
  return __builtin_bit_cast(unsigned, __builtin_convertvector(v, bf16x2_t));
}
DI float bf_lo(unsigned u) { return __uint_as_float(u << 16); }
DI float bf_hi(unsigned u) { return __uint_as_float(u & 0xffff0000u); }
DI float wave_sum(float v) {
#pragma unroll
  for (int o = 32; o > 0; o >>= 1) v += __shfl_xor(v, o);
  return v;
}
DI const float* xin_row(const Params& p, int row) {
  return row < NCTX ? p.x_prompt + (size_t)row * D : p.x_sample + (size_t)(row - NCTX) * D;
}
DI int vec_of_row(int row) { return row < NCTX ? 0 : 1 + ((row - NCTX) >> 10); }
DI bool seq_first(int row) { return row < NCTX ? ((row & 255) == 0) : ((row & 1023) == 0); }
DI bool seq_last(int row) { return row < NCTX ? ((row & 255) == 255) : ((row & 1023) == 1023); }

DI void transpose_tile(const float* __restrict__ src, int srcld, bf16_t* __restrict__ dst, int dstld, int kt, int nt,
                       float* sm) {
  const int t = tidx();
  const float* s = src + (size_t)(kt * 128) * srcld + nt * 64;
#pragma unroll
  for (int i = 0; i < 4; ++i) {
    const int row = (t >> 4) + 32 * i, c4 = (t & 15) * 4;
    const f32x4 v = *(const f32x4*)(s + (size_t)row * srcld + c4);
    sm[row * 65 + c4 + 0] = v[0];
    sm[row * 65 + c4 + 1] = v[1];
    sm[row * 65 + c4 + 2] = v[2];
    sm[row * 65 + c4 + 3] = v[3];
  }
  __syncthreads();
  const int n = t >> 3, ks = (t & 7) * 16;
  u32x4 w0, w1;
#pragma unroll
  for (int j = 0; j < 4; ++j) {
    w0[j] = cvt_pk_bf16(sm[(ks + 2 * j) * 65 + n], sm[(ks + 2 * j + 1) * 65 + n]);
    w1[j] = cvt_pk_bf16(sm[(ks + 8 + 2 * j) * 65 + n], sm[(ks + 8 + 2 * j + 1) * 65 + n]);
  }
  bf16_t* d = dst + (size_t)(nt * 64 + n) * dstld + kt * 128 + ks;
  *(u32x4*)d = w0;
  *(u32x4*)(d + 8) = w1;
  __syncthreads();
}

constexpr int PREP_T_IN = 8 * 104, PREP_T_BR = 2 * 4 * 16, PREP_T_OUT = 8 * 16, PREP_T_UP = 8 * 88,
              PREP_T_DN = 22 * 16, PREP_WEFF = 128;
constexpr int PREP_ITEMS = PREP_T_IN + PREP_T_BR + PREP_T_OUT + PREP_T_UP + PREP_T_DN + PREP_WEFF;

DI void prep_transposes(const Params& p, int l, int it, float* sm) {
  if (it < PREP_T_IN) {
    transpose_tile(p.w_in + (size_t)l * D * INW, INW, p.WIN, D, it / 104, it % 104, sm);
    return;
  }
  it -= PREP_T_IN;
  if (it < PREP_T_BR) {
    const int i = it >> 6, r = it & 63;
    transpose_tile(p.w_branch + (size_t)(l * 3 + i) * 512 * D, D, p.WB + i * 512, 1536, r >> 4, r & 15, sm);
    return;
  }
  it -= PREP_T_BR;
  if (it < PREP_T_OUT) {
    transpose_tile(p.w_out + (size_t)l * D * D, D, p.WO, D, it >> 4, it & 15, sm);
    return;
  }
  it -= PREP_T_OUT;
  if (it < PREP_T_UP) {
    {
      const int nt = it % 88, q = nt >> 2, sub = nt & 3;
      const int src_col = (sub < 2) ? 128 * q + 64 * sub : DFF + 128 * q + 64 * (sub - 2);
      transpose_tile(p.w_up + (size_t)l * D * 2 * DFF + (src_col - nt * 64), 2 * DFF, p.WU, D, it / 88, nt, sm);
    }
    return;
  }
  it -= PREP_T_UP;
  if (it < PREP_T_DN) {
    transpose_tile(p.w_down + (size_t)l * DFF * D, D, p.WD, DFF, it >> 4, it & 15, sm);
    return;
  }
}

DI void prep_item(const Params& p, int l, int it, float* sm) {
  if (it < PREP_WEFF) {
    const int g = it >> 5, cb = (it >> 1) & 15, db = it & 1;
    const int t = tidx();
    const int dd = db * 512 + t;
    const float* wb2 = p.w_branch + (size_t)(l * 3 + 2) * 512 * D + (size_t)(g * 128) * D + dd;
    for (int i = t; i < 1024; i += NTHREADS) {
      const int e = i >> 3, c = i & 7;
      sm[i] = p.pool_w[((size_t)(l * 4 + g) * 128 + cb * 8 + c) * 128 + e] * p.pool_scale[l * 512 + g * 128 + e];
    }
    __syncthreads();
    float acc[8];
#pragma unroll
    for (int c = 0; c < 8; ++c) acc[c] = 0.f;
#pragma unroll 16
    for (int e = 0; e < 128; ++e) {
      const float w = wb2[(size_t)e * D];
      const f32x4 s0 = *(const f32x4*)(sm + e * 8), s1 = *(const f32x4*)(sm + e * 8 + 4);
#pragma unroll
      for (int c = 0; c < 4; ++c) { acc[c] += s0[c] * w; acc[4 + c] += s1[c] * w; }
    }
    u32x4 o;
#pragma unroll
    for (int j = 0; j < 4; ++j) o[j] = cvt_pk_bf16(acc[2 * j], acc[2 * j + 1]);
    *(u32x4*)(p.WB + (size_t)dd * 1536 + 1024 + g * 128 + cb * 8) = o;
    __syncthreads();
  }
  else {
    it -= PREP_WEFF;
    prep_transposes(p, l, it, sm);
  }
}

constexpr int MOD_ITEMS = 2 * 96;
DI void mod_item(const Params& p, int it, float* sm) {
  const int t = tidx();
  const int l = it / 96, cb = it % 96;
  float* red = sm + 5 * 1024;
  for (int i = t; i < 5 * 1024; i += NTHREADS) {
    const int v = i >> 10, k = i & 1023;
    const float cv = (v == 0) ? p.c_ctx[k] : p.c[(v - 1) * D + k];
    sm[i] = cv / (1.f + __expf(-cv));
  }
  __syncthreads();
  const int kg = t >> 4, ct = t & 15;
  f32x4 acc[5];
#pragma unroll
  for (int v = 0; v < 5; ++v) acc[v] = (f32x4){0.f, 0.f, 0.f, 0.f};
  const float* w = p.w_mod + ((size_t)l * D + kg * 32) * 6144 + cb * 64 + ct * 4;
#pragma unroll 8
  for (int kk = 0; kk < 32; ++kk) {
    const f32x4 wv = *(const f32x4*)(w + (size_t)kk * 6144);
#pragma unroll
    for (int v = 0; v < 5; ++v) acc[v] += sm[v * 1024 + kg * 32 + kk] * wv;
  }
#pragma unroll
  for (int v = 0; v < 5; ++v)
#pragma unroll
    for (int j = 0; j < 4; ++j) red[(kg * 5 + v) * 64 + ct * 4 + j] = acc[v][j];
  __syncthreads();
  for (int i = t; i < 320; i += NTHREADS) {
    const int v = i >> 6, c = i & 63;
    float s = p.b_mod[l * 6144 + cb * 64 + c];
#pragma unroll
    for (int g = 0; g < 32; ++g) s += red[(g * 5 + v) * 64 + c];
    p.MOD[(size_t)(l * 5 + v) * 6144 + cb * 64 + c] = s;
  }
  __syncthreads();
}

constexpr int CACHE_ITEMS = 32;
DI void cache_item(const Params& p, int it) {
  const int t = tidx() & 255;
  it = it * 2 + (tidx() >> 8);
  const int b = it >> 4, l = (it >> 3) & 1, h = it & 7;
  const float* ks = p.cache_kv + ((size_t)(((b * 2 + l) * 2 + 0) * 8 + h)) * 16384;
  const float* vs = p.cache_kv + ((size_t)(((b * 2 + l) * 2 + 1) * 8 + h)) * 16384;
  bf16_t* kd = p.KC + (size_t)((b * 2 + l) * 8 + h) * 16384;
  bf16_t* vd = p.VCT + (size_t)((b * 2 + l) * 8 + h) * 16384;
#pragma unroll 4
  for (int i = 0; i < 16; ++i) {
    const int e = (i * 256 + t) * 4;
    const f32x4 v = *(const f32x4*)(ks + e);
    u32x2 o;
    o[0] = cvt_pk_bf16(v[0], v[1]);
    o[1] = cvt_pk_bf16(v[2], v[3]);
    *(u32x2*)(kd + e) = o;
  }
#pragma unroll 4
  for (int d = 0; d < 64; d += 4) {
    const f32x4 v = *(const f32x4*)(vs + t * 64 + d);
#pragma unroll
    for (int j = 0; j < 4; ++j) vd[(d + j) * 256 + t] = (bf16_t)(cvt_pk_bf16(v[j], 0.f) & 0xffffu);
  }
}

DI void normmod_row2(const Params& p, int l, int which, int row, const float* xr) {
  const int lane = tidx() & 63;
  f32x4 v[2][4];
  float ss[2] = {0.f, 0.f};
#pragma unroll
  for (int r = 0; r < 2; ++r)
#pragma unroll
    for (int i = 0; i < 4; ++i) v[r][i] = *(const f32x4*)(xr + r * D + i * 256 + lane * 4);
#pragma unroll
  for (int r = 0; r < 2; ++r) {
#pragma unroll
    for (int i = 0; i < 4; ++i)
      ss[r] += v[r][i][0] * v[r][i][0] + v[r][i][1] * v[r][i][1] + v[r][i][2] * v[r][i][2] + v[r][i][3] * v[r][i][3];
    ss[r] = wave_sum(ss[r]);
  }
  const float* g = (which == 0 ? p.g1 : p.g2) + l * D;
  const float* mod = p.MOD + (size_t)(l * 5 + vec_of_row(row)) * 6144 + which * 3072;
#pragma unroll
  for (int i = 0; i < 4; ++i) {
    const int col = i * 256 + lane * 4;
    const f32x4 gg = *(const f32x4*)(g + col);
    const f32x4 sh = *(const f32x4*)(mod + col);
    const f32x4 sc = *(const f32x4*)(mod + 1024 + col);
#pragma unroll
    for (int r = 0; r < 2; ++r) {
      const float rstd = rsqrtf(ss[r] * (1.f / 1024.f) + 1e-6f);
      f32x4 h;
#pragma unroll
      for (int j = 0; j < 4; ++j) h[j] = v[r][i][j] * rstd * gg[j] * (1.f + sc[j]) + sh[j];
      u32x2 o;
      o[0] = cvt_pk_bf16(h[0], h[1]);
      o[1] = cvt_pk_bf16(h[2], h[3]);
      *(u32x2*)(p.H + (size_t)(row + r) * D + col) = o;
    }
  }
}

constexpr int STAGE_BYTES = 49152;
#ifdef EXP_B
#define EXP_B_EXTRA gemm_stage<256>(A, lda, (4 * x + (pj & 3)) * 256, pt * 64, dst, tid); gemm_stage<128>(Bt, ldb, (pj >> 2) * 128, pt * 64, dst + 32768, tid);
#define VM_STAGE "12"
#else
#define EXP_B_EXTRA
#define VM_STAGE "6"
#endif
template <int ROWS>
DI void gemm_stage(const bf16_t* __restrict__ A, int lda, int row0, int k0, char* s, int t) {
  const int cp = t & 7, rr = t >> 3, c = cp ^ (rr & 7);
#pragma unroll
  for (int i = 0; i < ROWS / 64; ++i)
    __builtin_amdgcn_global_load_lds((const unsigned*)(A + (size_t)(row0 + rr + 64 * i) * lda + k0 + c * 8),
                                     (unsigned*)(s + t * 16 + i * 8192), 16, 0, 0);
}
DI void gemm_compute(const char* sA, const char* sB, f32x4 (&acc)[4][4], int wm, int wn, int lane) {
  const int fr = lane & 15, fq = lane >> 4;
#pragma unroll
  for (int ks = 0; ks < 2; ++ks) {
    bf16x8 a[4], b[4];
    const int sw = ((ks * 4 + fq) ^ (fr & 7)) << 4;
#pragma unroll
    for (int ni = 0; ni < 4; ++ni) b[ni] = *(const bf16x8*)(sB + (wn * 64 + ni * 16 + fr) * 128 + sw);
#pragma unroll
    for (int mi = 0; mi < 4; ++mi) a[mi] = *(const bf16x8*)(sA + (wm * 64 + mi * 16 + fr) * 128 + sw);
    __builtin_amdgcn_sched_barrier(0);
#pragma unroll
    for (int mi = 0; mi < 4; ++mi)
#pragma unroll
      for (int ni = 0; ni < 4; ++ni)
        acc[mi][ni] = __builtin_amdgcn_mfma_f32_16x16x32_bf16(b[ni], a[mi], acc[mi][ni], 0, 0, 0);
    __builtin_amdgcn_sched_barrier(0);
  }
}

template <bool GATED, class Epi>
DI void gemm_phase(const bf16_t* __restrict__ A, int lda, const bf16_t* __restrict__ Bt, int ldb, int K, int N,
                   char* smem, const Epi& epi, const bf16_t* gates) {
  const int tid = tidx();
  const int wid = tid >> 6, lane = tid & 63, wm = wid >> 1, wn = wid & 1;
  const int fr = lane & 15, fq = lane >> 4;
  const int bid = bidx(), nb = gridDim.x;
  const int nN = N >> 7, nt = K >> 6;
  const int x = bid & 7, per_x = 4 * nN, cstep = nb >> 3;
  int pj = bid >> 3, pt = 0, ps = 0;
#define GEMM_ISSUE()                                                                                          \
  do {                                                                                                        \
    if (pj < per_x) {                                                                                         \
      char* dst = smem + ps * STAGE_BYTES;                                                                    \
      gemm_stage<256>(A, lda, (4 * x + (pj & 3)) * 256, pt * 64, dst, tid);                                   \
      gemm_stage<128>(Bt, ldb, (pj >> 2) * 128, pt * 64, dst + 32768, tid);                                   \
      EXP_B_EXTRA                                                                                             \
      if (++pt == nt) { pt = 0; pj += cstep; }                                                                \
      ps = (ps == 2) ? 0 : ps + 1;                                                                            \
    }                                                                                                         \
  } while (0)
  GEMM_ISSUE();
  GEMM_ISSUE();
  int cs = 0;
  for (int cj = bid >> 3; cj < per_x; cj += cstep) {
    const int row0 = (4 * x + (cj & 3)) * 256, col0 = (cj >> 2) * 128;
    f32x4 acc[4][4];
    f32x4 tot[4][4];
#pragma unroll
    for (int mi = 0; mi < 4; ++mi)
#pragma unroll
      for (int ni = 0; ni < 4; ++ni) {
        acc[mi][ni] = (f32x4){0.f, 0.f, 0.f, 0.f};
        if (GATED) tot[mi][ni] = (f32x4){0.f, 0.f, 0.f, 0.f};
      }
    const bool last_tile = cj + cstep >= per_x;
    for (int t = 0; t < nt; ++t) {
      if (last_tile && t == nt - 1) asm volatile("s_waitcnt vmcnt(0)" ::: "memory");
      else asm volatile("s_waitcnt vmcnt(" VM_STAGE ")" ::: "memory");
      __builtin_amdgcn_s_barrier();
      GEMM_ISSUE();
      const char* cur = smem + cs * STAGE_BYTES;
      gemm_compute(cur, cur + 32768, acc, wm, wn, lane);
      cs = (cs == 2) ? 0 : cs + 1;
      if (GATED && ((t & 7) == 7)) {
        const int seg = t >> 3;
        int gofs = (row0 + wm * 64 + fr) * INW + seg * 1024 + col0 + wn * 64 + fq * 4;
        asm volatile("" : "+v"(gofs));
#pragma unroll
        for (int mi = 0; mi < 4; ++mi)
#pragma unroll
          for (int ni = 0; ni < 4; ++ni) {
            const u32x2 g = *(const u32x2*)(gates + (gofs + mi * 16 * INW + ni * 16));
            tot[mi][ni][0] += bf_lo(g[0]) * acc[mi][ni][0];
            tot[mi][ni][1] += bf_hi(g[0]) * acc[mi][ni][1];
            tot[mi][ni][2] += bf_lo(g[1]) * acc[mi][ni][2];
            tot[mi][ni][3] += bf_hi(g[1]) * acc[mi][ni][3];
            acc[mi][ni] = (f32x4){0.f, 0.f, 0.f, 0.f};
          }
      }
    }
#pragma unroll
    for (int mi = 0; mi < 4; ++mi)
#pragma unroll
      for (int ni = 0; ni < 4; ++ni) {
        const int row = row0 + wm * 64 + mi * 16 + fr, col = col0 + wn * 64 + ni * 16 + fq * 4;
        epi(row, col, GATED ? tot[mi][ni] : acc[mi][ni]);
      }
  }
#undef GEMM_ISSUE
  __syncthreads();
}

DI void store_bf16x4(bf16_t* d, f32x4 v) {
  u32x2 o;
  o[0] = cvt_pk_bf16(v[0], v[1]);
  o[1] = cvt_pk_bf16(v[2], v[3]);
  *(u32x2*)d = o;
}

struct EpiZ {
  bf16_t* Z; bf16_t* VT; float* kv; int l;
  DI void operator()(int row, int col, f32x4 v) const {
    const int colt = __builtin_amdgcn_readfirstlane(col) & ~127;
    if (colt >= 3584) {
#pragma unroll
      for (int j = 0; j < 4; ++j) v[j] = __builtin_amdgcn_rcpf(1.f + __expf(-v[j]));
    }
    store_bf16x4(Z + (size_t)row * INW + col, v);
    if (colt >= 2048 && colt < 3072) {
      const int which = (colt - 2048) >> 9, hd = (col - 2048) & 511;
      if (row < NCTX) {
        const int b = row >> 8, s = row & 255, hh = hd >> 6, d = hd & 63;
        *(f32x4*)(kv + ((size_t)((((b * 2 + l) * 2 + which) * 8 + hh) * 256 + s)) * 64 + d) = v;
      }
      if (which == 1) {
#pragma unroll
        for (int j = 0; j < 4; ++j)
          VT[(((size_t)(hd >> 6) * 256 + (row >> 5)) * 64 + (hd & 63) + j) * 32 + (row & 31)] = (bf16_t)(cvt_pk_bf16(v[j], 0.f) & 0xffffu);
      }
    }
  }
};
struct EpiBf16 {
  bf16_t* O; int ld;
  DI void operator()(int row, int col, f32x4 v) const { store_bf16x4(O + (size_t)row * ld + col, v); }
};
struct EpiResid {
  const Params* p; int l; int gate_off; bool from_input;
  DI void operator()(int row, int col, f32x4 v) const {
    const float* xi = from_input ? xin_row(*p, row) + col : p->X + (size_t)row * D + col;
    const f32x4 x = *(const f32x4*)xi;
    const f32x4 g = *(const f32x4*)(p->MOD + (size_t)(l * 5 + vec_of_row(row)) * 6144 + gate_off + col);
    f32x4 o;
#pragma unroll
    for (int j = 0; j < 4; ++j) o[j] = x[j] + g[j] * v[j];
    *(f32x4*)(p->X + (size_t)row * D + col) = o;
  }
};


namespace pg8 {
#define PG8_LAS __attribute__((address_space(3)))
typedef unsigned short bf16_t;
typedef short bf16x8 __attribute__((ext_vector_type(8)));
typedef float f32x4 __attribute__((ext_vector_type(4)));
typedef unsigned u32x4 __attribute__((ext_vector_type(4)));
constexpr int BM = 256, BK = 64, HALF = 128, HTB = HALF * BK * 2  , STAGE_BYTES = 8 * HTB, NXCD = 8, WGM = 4;

__host__ __device__ __forceinline__ int lds_byte(int r, int c) { const int st = (r >> 4) * 2 + (c >> 5), rr = r & 15, cc = c & 31, ob = rr * 64 + cc * 2; return st * 1024 + (ob ^ (((ob >> 9) & 1) << 5)); }
__host__ __device__ __forceinline__ void stage_rc(int b, int& R, int& C) { const int st = b / 1024, sb = b % 1024, swz = sb ^ (((sb >> 9) & 1) << 5); R = (st >> 1) * 16 + swz / 64; C = (st & 1) * 32 + (swz % 64) / 2; }
__host__ __device__ __forceinline__ int perm32(int rho) { const int n = rho >> 4, i = rho & 15; return 8 * (i >> 2) + 4 * n + (i & 3); }

struct Unit { int pm, pn; };
struct Gemm { const bf16_t* A; const bf16_t* Bt; int M, N, K; };

struct StaticOrder {
    int nM, nN, nwg, G, c;
    __host__ __device__ void init(int M, int N, int G_, int c_) { nM = M / BM; nN = N / BM; nwg = nM * nN; G = G_; c = c_; }
    __host__ __device__ bool next(int i, Unit& u) const {
        const long L = (long)i * G + c; if (L >= nwg) return false;
        int wgid = (int)L; { const int q = nwg / NXCD, r = nwg % NXCD, xcd = wgid % NXCD, off = wgid / NXCD; wgid = (xcd < r ? xcd * (q + 1) : r * (q + 1) + (xcd - r) * q) + off; }
        const int nig = WGM * nN, gid = wgid / nig, fm = gid * WGM, gsz = (nM - fm) < WGM ? (nM - fm) : WGM;
        u.pm = fm + ((wgid % nig) % gsz); u.pn = (wgid % nig) / gsz; return true;
    }
    __device__ __forceinline__ void a_ready(const Unit&) const {}
    __device__ __forceinline__ void done(const Unit&) const {}
};
template <class Epi, class Sched, bool ALIGN_EPI = false, bool SP2 = false>
__device__ __forceinline__ void gemm_phase(PG8_LAS unsigned char* lds, const Gemm g, const Sched& S, const Epi& E) {
    const int tid = tidx()  , wid = __builtin_amdgcn_readfirstlane(tid >> 6), lane = tid & 63, wr = wid >> 2, wc = wid & 3, fr = lane & 15, fq = lane >> 4;
    const int K = g.K, nt = K / BK;
    unsigned voffA[2], voffB[2];
#pragma unroll
    for (int i = 0; i < 2; ++i) { int R, C; stage_rc(tid * 16 + i * 8192, R, C); const int Rb = Epi::PERM ? ((R & ~31) + perm32(R & 31)) : R;
        voffA[i] = (unsigned)(R * K + C) * 2u; voffB[i] = (unsigned)(Rb * K + C) * 2u; }
    const size_t kstep = (size_t)(BK * 2);
    const size_t hstep = (size_t)HALF * K * 2;
    const size_t tstep = 2 * hstep;
    const unsigned ldsw = (unsigned)wid * 1024u;
    const int aoff = lds_byte(wr * 64 + fr, fq * 8), boff = lds_byte(wc * 32 + fr, fq * 8);
#define PG8_SA(b, h) (((b) * 2 + (h)) * HTB)
#define PG8_SB(b, h) ((4 + (b) * 2 + (h)) * HTB)
#define PG8_STAGE(bufoff, gbase, voff) do { _Pragma("unroll") for (int _i = 0; _i < 2; ++_i) \
        __builtin_amdgcn_global_load_lds((const unsigned*)((const char*)(gbase) + (voff)[_i]), (PG8_LAS unsigned*)(lds + (bufoff) + ldsw + _i * 8192), 16, 0, 0); } while (0)
#define PG8_LDA(dst, b, h) do { _Pragma("unroll") for (int m = 0; m < 4; ++m) _Pragma("unroll") for (int k = 0; k < 2; ++k) dst[m][k] = *(const PG8_LAS bf16x8*)(lds + PG8_SA(b, h) + aoff + m * 2048 + k * 1024); } while (0)
#define PG8_LDB(dst, b, h) do { _Pragma("unroll") for (int n = 0; n < 2; ++n) _Pragma("unroll") for (int k = 0; k < 2; ++k) dst[n][k] = *(const PG8_LAS bf16x8*)(lds + PG8_SB(b, h) + boff + n * 2048 + k * 1024); } while (0)
#define PG8_MMA(ai, bj, At, Bt) do { __builtin_amdgcn_s_setprio(1); _Pragma("unroll") for (int m = 0; m < 4; ++m) _Pragma("unroll") for (int n = 0; n < 2; ++n) _Pragma("unroll") for (int k = 0; k < 2; ++k) \
        acc[ai][bj][m][n] = __builtin_amdgcn_mfma_f32_16x16x32_bf16(Bt[n][k], At[m][k], acc[ai][bj][m][n], 0, 0, 0); __builtin_amdgcn_s_setprio(0); } while (0)
#define PG8_WAIT_V(n) asm volatile("s_waitcnt vmcnt(" #n ")" ::: "memory")
#define PG8_WAIT_L(n) asm volatile("s_waitcnt lgkmcnt(" #n ")" ::: "memory")
#define PG8_BAR __builtin_amdgcn_s_barrier()
#define PG8_SCHED __builtin_amdgcn_sched_barrier(0)
    Unit cur, nxt; int ui = 0;
    if (!S.next(0, cur)) return;
    f32x4 acc[2][2][4][2];
#pragma unroll
    for (int a = 0; a < 2; ++a)
#pragma unroll
        for (int b = 0; b < 2; ++b)
#pragma unroll
            for (int m = 0; m < 4; ++m)
#pragma unroll
                for (int n = 0; n < 2; ++n) acc[a][b][m][n] = (f32x4){0.f, 0.f, 0.f, 0.f};
    bf16x8 At[4][2], B0[2][2], B1[2][2];
    const char* cA = (const char*)g.A + (size_t)cur.pm * tstep; const char* cB = (const char*)g.Bt + (size_t)cur.pn * tstep;
    S.a_ready(cur);
    if constexpr (SP2) {
        PG8_STAGE(PG8_SB(0, 0), cB, voffB); PG8_STAGE(PG8_SB(0, 1), cB + hstep, voffB); PG8_STAGE(PG8_SA(0, 0), cA, voffA); PG8_STAGE(PG8_SA(0, 1), cA + hstep, voffA);
        if (wr == 1) PG8_BAR;
        PG8_WAIT_V(2); PG8_BAR;
        PG8_STAGE(PG8_SB(1, 0), cB + kstep, voffB); PG8_STAGE(PG8_SA(1, 0), cA + kstep, voffA); PG8_STAGE(PG8_SB(1, 1), cB + hstep + kstep, voffB);
        PG8_WAIT_V(6); PG8_BAR;
    } else {
        PG8_STAGE(PG8_SB(0, 0), cB, voffB); PG8_STAGE(PG8_SA(0, 0), cA, voffA); PG8_STAGE(PG8_SB(0, 1), cB + hstep, voffB); PG8_STAGE(PG8_SA(0, 1), cA + hstep, voffA);
        if (wr == 1) PG8_BAR;
        PG8_WAIT_V(4); PG8_BAR;
        PG8_STAGE(PG8_SB(1, 0), cB + kstep, voffB); PG8_STAGE(PG8_SA(1, 0), cA + kstep, voffA); PG8_STAGE(PG8_SB(1, 1), cB + hstep + kstep, voffB);
        PG8_WAIT_V(6); PG8_BAR;
    }
    for (;;) {
        const bool has_next = S.next(ui + 1, nxt);
        const char* nA = has_next ? (const char*)g.A + (size_t)nxt.pm * tstep : cA; const char* nB = has_next ? (const char*)g.Bt + (size_t)nxt.pn * tstep : cB;
        for (int t = 0; t < nt; t += 2) {
            const bool last = (t == nt - 2);
            const char* a1 = cA + (size_t)(t + 1) * kstep;
            const char* a2 = last ? nA : cA + (size_t)(t + 2) * kstep; const char* b2 = last ? nB : cB + (size_t)(t + 2) * kstep;
            const char* a3 = a2 + kstep; const char* b3 = b2 + kstep;
            if (last && has_next) S.a_ready(nxt);
            if constexpr (SP2) {
            PG8_LDB(B0, 0, 0); PG8_LDB(B1, 0, 1); PG8_SCHED; PG8_LDA(At, 0, 0); PG8_STAGE(PG8_SA(1, 1), a1 + hstep, voffA);
            PG8_WAIT_V(8); PG8_WAIT_L(0); PG8_BAR; PG8_MMA(0, 0, At, B0); PG8_MMA(0, 1, At, B1); PG8_BAR; PG8_SCHED;
            PG8_LDA(At, 0, 1); PG8_STAGE(PG8_SB(0, 0), b2, voffB); PG8_STAGE(PG8_SB(0, 1), b2 + hstep, voffB); PG8_STAGE(PG8_SA(0, 0), a2, voffA);
            PG8_WAIT_V(8); PG8_WAIT_L(0); PG8_BAR; PG8_MMA(1, 0, At, B0); PG8_MMA(1, 1, At, B1); PG8_BAR; PG8_SCHED;
            PG8_LDB(B0, 1, 0); PG8_LDB(B1, 1, 1); PG8_SCHED; PG8_LDA(At, 1, 0); PG8_STAGE(PG8_SA(0, 1), a2 + hstep, voffA);
            PG8_WAIT_V(8); PG8_WAIT_L(0); PG8_BAR; PG8_MMA(0, 0, At, B0); PG8_MMA(0, 1, At, B1); PG8_BAR; PG8_SCHED;
            PG8_LDA(At, 1, 1); PG8_STAGE(PG8_SB(1, 0), b3, voffB); PG8_STAGE(PG8_SB(1, 1), b3 + hstep, voffB); PG8_STAGE(PG8_SA(1, 0), a3, voffA);
            PG8_WAIT_V(8); PG8_WAIT_L(0); PG8_BAR; PG8_MMA(1, 0, At, B0); PG8_MMA(1, 1, At, B1); PG8_BAR; PG8_SCHED;
            } else {
            PG8_LDB(B0, 0, 0); PG8_SCHED; PG8_LDA(At, 0, 0); PG8_STAGE(PG8_SA(1, 1), a1 + hstep, voffA);
            PG8_WAIT_L(8); PG8_BAR; PG8_WAIT_L(0); PG8_MMA(0, 0, At, B0); PG8_BAR; PG8_SCHED;
            PG8_LDB(B1, 0, 1); PG8_STAGE(PG8_SB(0, 0), b2, voffB);
            PG8_BAR; PG8_WAIT_L(0); PG8_MMA(0, 1, At, B1); PG8_BAR;
            PG8_LDA(At, 0, 1); PG8_STAGE(PG8_SA(0, 0), a2, voffA);
            PG8_BAR; PG8_WAIT_L(0); PG8_MMA(1, 0, At, B0); PG8_BAR; PG8_SCHED;
            PG8_STAGE(PG8_SB(0, 1), b2 + hstep, voffB);
            PG8_WAIT_V(6); PG8_BAR; PG8_MMA(1, 1, At, B1); PG8_BAR;
            PG8_LDB(B0, 1, 0); PG8_SCHED; PG8_LDA(At, 1, 0); PG8_STAGE(PG8_SA(0, 1), a2 + hstep, voffA);
            PG8_WAIT_L(8); PG8_BAR; PG8_WAIT_L(0); PG8_MMA(0, 0, At, B0); PG8_BAR; PG8_SCHED;
            PG8_LDB(B1, 1, 1); PG8_STAGE(PG8_SB(1, 0), b3, voffB);
            PG8_BAR; PG8_WAIT_L(0); PG8_MMA(0, 1, At, B1); PG8_BAR;
            PG8_LDA(At, 1, 1); PG8_STAGE(PG8_SA(1, 0), a3, voffA);
            PG8_BAR; PG8_WAIT_L(0); PG8_MMA(1, 0, At, B0); PG8_BAR; PG8_SCHED;
            PG8_STAGE(PG8_SB(1, 1), b3 + hstep, voffB);
            PG8_WAIT_V(6); PG8_BAR; PG8_MMA(1, 1, At, B1); PG8_BAR;
            }
        }
        if constexpr (ALIGN_EPI) { if (wr == 0) PG8_BAR; }
        if constexpr (!Epi::AFTER_DRAIN) { E(acc, cur, wr, wc, fr, fq); S.done(cur); }
        if (!has_next) break;
#pragma unroll
        for (int a = 0; a < 2; ++a)
#pragma unroll
            for (int b = 0; b < 2; ++b)
#pragma unroll
                for (int m = 0; m < 4; ++m)
#pragma unroll
                    for (int n = 0; n < 2; ++n) acc[a][b][m][n] = (f32x4){0.f, 0.f, 0.f, 0.f};
        cur = nxt; cA = nA; cB = nB; ++ui;
        if constexpr (ALIGN_EPI) { if (wr == 1) PG8_BAR; }
    }
    PG8_WAIT_V(0);
    if constexpr (!ALIGN_EPI) { if (wr == 0) PG8_BAR; }
    PG8_BAR;
    if constexpr (Epi::AFTER_DRAIN) { E.fused(acc, cur, wr, wc, fr, fq, lds, wid, lane); S.done(cur); }
#undef PG8_SA
#undef PG8_SB
#undef PG8_STAGE
#undef PG8_LDA
#undef PG8_LDB
#undef PG8_MMA
#undef PG8_WAIT_V
#undef PG8_WAIT_L
#undef PG8_BAR
#undef PG8_SCHED
}
}

struct EpiZ8 {
  static constexpr bool PERM = true, AFTER_DRAIN = false;
  bf16_t* Z; bf16_t* VT; float* kv; int l;
  DI void operator()(const f32x4 (&acc)[2][2][4][2], const pg8::Unit& u, int wr, int wc, int fr, int fq) const {
    const int pn = u.pn;
#pragma unroll
    for (int ai = 0; ai < 2; ++ai)
#pragma unroll
      for (int m = 0; m < 4; ++m) {
        const int row = u.pm * 256 + ai * 128 + wr * 64 + m * 16 + fr;
#pragma unroll
        for (int bj = 0; bj < 2; ++bj) {
          const int c0 = pn * 256 + bj * 128 + wc * 32 + fq * 8;
          f32x4 v0 = acc[ai][bj][m][0], v1 = acc[ai][bj][m][1];
          if (pn >= 14) {
#pragma unroll
            for (int j = 0; j < 4; ++j) {
              v0[j] = __builtin_amdgcn_rcpf(1.f + __expf(-v0[j]));
              v1[j] = __builtin_amdgcn_rcpf(1.f + __expf(-v1[j]));
            }
          }
          u32x4 w;
          w[0] = cvt_pk_bf16(v0[0], v0[1]); w[1] = cvt_pk_bf16(v0[2], v0[3]);
          w[2] = cvt_pk_bf16(v1[0], v1[1]); w[3] = cvt_pk_bf16(v1[2], v1[3]);
          *(u32x4*)(Z + (size_t)row * INW + c0) = w;
          if (pn >= 8 && pn < 12) {
            const int which = (pn >= 10) ? 1 : 0, hd = (c0 - 2048) & 511, hh = hd >> 6, d = hd & 63;
            if (row < NCTX) {
              const int b = row >> 8, s = row & 255;
              float* kp = kv + ((size_t)((((b * 2 + l) * 2 + which) * 8 + hh) * 256 + s)) * 64 + d;
              *(f32x4*)kp = v0;
              *(f32x4*)(kp + 4) = v1;
            }
            if (which == 1) {
              bf16_t* vp = VT + (((size_t)hh * 256 + (row >> 5)) * 64 + d) * 32 + (row & 31);
              vp[0] = (bf16_t)(w[0] & 0xffffu); vp[32] = (bf16_t)(w[0] >> 16);
              vp[64] = (bf16_t)(w[1] & 0xffffu); vp[96] = (bf16_t)(w[1] >> 16);
              vp[128] = (bf16_t)(w[2] & 0xffffu); vp[160] = (bf16_t)(w[2] >> 16);
              vp[192] = (bf16_t)(w[3] & 0xffffu); vp[224] = (bf16_t)(w[3] >> 16);
            }
          }
        }
      }
  }
};
struct EpiO8 {
  static constexpr bool PERM = true, AFTER_DRAIN = false;
  bf16_t* O; int ld;
  DI void operator()(const f32x4 (&acc)[2][2][4][2], const pg8::Unit& u, int wr, int wc, int fr, int fq) const {
#pragma unroll
    for (int ai = 0; ai < 2; ++ai)
#pragma unroll
      for (int m = 0; m < 4; ++m) {
        const int row = u.pm * 256 + ai * 128 + wr * 64 + m * 16 + fr;
#pragma unroll
        for (int bj = 0; bj < 2; ++bj) {
          const int c0 = u.pn * 256 + bj * 128 + wc * 32 + fq * 8;
          const f32x4 v0 = acc[ai][bj][m][0], v1 = acc[ai][bj][m][1];
          u32x4 w;
          w[0] = cvt_pk_bf16(v0[0], v0[1]); w[1] = cvt_pk_bf16(v0[2], v0[3]);
          w[2] = cvt_pk_bf16(v1[0], v1[1]); w[3] = cvt_pk_bf16(v1[2], v1[3]);
          *(u32x4*)(O + (size_t)row * ld + c0) = w;
        }
      }
  }
};

template <bool LATBIAS>
DI void attn_chunk(const bf16x8 qf0, const bf16x8 qf1, const bf16_t* __restrict__ kbase, int kstride,
                   const bf16_t* __restrict__ vtbase, int vstride, int tk0, int tk1, int tk2, int tk3,
                   const float* __restrict__ rpb_h, int dr0, int band, int qc, float& m, float& lsum,
                   f32x4 (&o)[4], int lane) {
  const int fr = lane & 15, fq = lane >> 4;
  f32x4 s[4];
#pragma unroll
  for (int T = 0; T < 4; ++T) {
    const int tk = (T == 0 ? tk0 : T == 1 ? tk1 : T == 2 ? tk2 : tk3);
    const bf16_t* kp = kbase + (size_t)(tk + fr) * kstride + fq * 8;
    const bf16x8 k0 = *(const bf16x8*)kp;
    const bf16x8 k1 = *(const bf16x8*)(kp + 32);
    f32x4 z = (f32x4){0.f, 0.f, 0.f, 0.f};
    z = __builtin_amdgcn_mfma_f32_16x16x32_bf16(k0, qf0, z, 0, 0, 0);
    z = __builtin_amdgcn_mfma_f32_16x16x32_bf16(k1, qf1, z, 0, 0, 0);
    s[T] = z;
  }
  float cmax = -INFINITY;
#pragma unroll
  for (int T = 0; T < 4; ++T) {
#pragma unroll
    for (int j = 0; j < 4; ++j) {
      float v = s[T][j] * 0.125f;
      if (LATBIAS) {
        const int kc = band + (T & 1) * 16 + fq * 4 + j;
        const int cs = min(max(qc - 8, 0), 48);
        const bool valid = (kc >= cs) && (kc < cs + 16);
        const int dr = dr0 + (T >> 1);
        const int dc = min(max(kc - qc + 15, 0), 30);
        v = valid ? v + rpb_h[dr * 31 + dc] : -INFINITY;
      }
      s[T][j] = v;
      cmax = fmaxf(cmax, v);
    }
  }
  cmax = fmaxf(cmax, __shfl_xor(cmax, 16));
  cmax = fmaxf(cmax, __shfl_xor(cmax, 32));
  const float mnew = fmaxf(m, cmax);
  const float alpha = __expf(m - mnew);
  m = mnew;
  float ps = 0.f;
#pragma unroll
  for (int T = 0; T < 4; ++T)
#pragma unroll
    for (int j = 0; j < 4; ++j) {
      const float pv = __expf(s[T][j] - mnew);
      s[T][j] = pv;
      ps += pv;
    }
  lsum = lsum * alpha + ps;
#pragma unroll
  for (int dt = 0; dt < 4; ++dt) o[dt] *= alpha;
#pragma unroll
  for (int pr = 0; pr < 2; ++pr) {
    u32x4 pk;
    pk[0] = cvt_pk_bf16(s[2 * pr][0], s[2 * pr][1]);
    pk[1] = cvt_pk_bf16(s[2 * pr][2], s[2 * pr][3]);
    pk[2] = cvt_pk_bf16(s[2 * pr + 1][0], s[2 * pr + 1][1]);
    pk[3] = cvt_pk_bf16(s[2 * pr + 1][2], s[2 * pr + 1][3]);
    const bf16x8 pa = __builtin_bit_cast(bf16x8, pk);
    const int ta = (pr == 0 ? tk0 : tk2) + fq * 4, tb = (pr == 0 ? tk1 : tk3) + fq * 4;
#pragma unroll
    for (int dt = 0; dt < 4; ++dt) {
      const bf16_t* vp = vtbase + (dt * 16 + fr) * 32;
      const u32x2 lo = *(const u32x2*)(vp + (size_t)(ta >> 5) * 2048 + (ta & 31));
      const u32x2 hi = *(const u32x2*)(vp + (size_t)(tb >> 5) * 2048 + (tb & 31));
      u32x4 vv;
      vv[0] = lo[0]; vv[1] = lo[1]; vv[2] = hi[0]; vv[3] = hi[1];
      o[dt] = __builtin_amdgcn_mfma_f32_16x16x32_bf16(__builtin_bit_cast(bf16x8, vv), pa, o[dt], 0, 0, 0);
    }
  }
}

DI void attn_finish(bf16_t* ys_row, float lsum, const f32x4 (&o)[4], int lane) {
  const int fq = lane >> 4;
  lsum += __shfl_xor(lsum, 16);
  lsum += __shfl_xor(lsum, 32);
  const float inv = 1.f / lsum;
#pragma unroll
  for (int dt = 0; dt < 4; ++dt) store_bf16x4(ys_row + dt * 16 + fq * 4, o[dt] * inv);
}

constexpr int ATT_VROW = 528, ATT_SV_OFF = 32768;
template <bool VTILED>
DI void attn_stage_kv(const bf16_t* __restrict__ kbase, int kstride, int ktok0, const bf16_t* __restrict__ vtbase,
                      int vstride, int vtok0, char* smem, int tid) {
  gemm_stage<256>(kbase, kstride, ktok0, 0, smem, tid);
  const int d = tid >> 3, seg = tid & 7;
  const bf16_t* vp = VTILED ? vtbase + ((size_t)((vtok0 >> 5) + seg) * 64 + d) * 32
                            : vtbase + (size_t)d * vstride + vtok0 + seg * 32;
  char* dst = smem + ATT_SV_OFF + d * ATT_VROW + seg * 64;
#pragma unroll
  for (int i = 0; i < 4; ++i) *(u32x4*)(dst + i * 16) = *(const u32x4*)(vp + i * 8);
}
DI void attn_chunk_lds(const bf16x8 qf0, const bf16x8 qf1, const char* sK, const char* sV, int t0, float& m,
                       float& lsum, f32x4 (&o)[4], int lane) {
  const int fr = lane & 15, fq = lane >> 4;
  f32x4 s[4];
#pragma unroll
  for (int T = 0; T < 4; ++T) {
    const char* kp = sK + (t0 + T * 16 + fr) * 128;
    const bf16x8 k0 = *(const bf16x8*)(kp + ((fq ^ (fr & 7)) << 4));
    const bf16x8 k1 = *(const bf16x8*)(kp + (((4 + fq) ^ (fr & 7)) << 4));
    f32x4 z = (f32x4){0.f, 0.f, 0.f, 0.f};
    z = __builtin_amdgcn_mfma_f32_16x16x32_bf16(k0, qf0, z, 0, 0, 0);
    z = __builtin_amdgcn_mfma_f32_16x16x32_bf16(k1, qf1, z, 0, 0, 0);
    s[T] = z;
  }
  float cmax = -INFINITY;
#pragma unroll
  for (int T = 0; T < 4; ++T)
#pragma unroll
    for (int j = 0; j < 4; ++j) {
      s[T][j] *= 0.125f;
      cmax = fmaxf(cmax, s[T][j]);
    }
  cmax = fmaxf(cmax, __shfl_xor(cmax, 16));
  cmax = fmaxf(cmax, __shfl_xor(cmax, 32));
  const float mnew = fmaxf(m, cmax);
  const float alpha = __expf(m - mnew);
  m = mnew;
  float ps = 0.f;
#pragma unroll
  for (int T = 0; T < 4; ++T)
#pragma unroll
    for (int j = 0; j < 4; ++j) {
      const float pv = __expf(s[T][j] - mnew);
      s[T][j] = pv;
      ps += pv;
    }
  lsum = lsum * alpha + ps;
#pragma unroll
  for (int dt = 0; dt < 4; ++dt) o[dt] *= alpha;
#pragma unroll
  for (int pr = 0; pr < 2; ++pr) {
    u32x4 pk;
    pk[0] = cvt_pk_bf16(s[2 * pr][0], s[2 * pr][1]);
    pk[1] = cvt_pk_bf16(s[2 * pr][2], s[2 * pr][3]);
    pk[2] = cvt_pk_bf16(s[2 * pr + 1][0], s[2 * pr + 1][1]);
    pk[3] = cvt_pk_bf16(s[2 * pr + 1][2], s[2 * pr + 1][3]);
    const bf16x8 pa = __builtin_bit_cast(bf16x8, pk);
#pragma unroll
    for (int dt = 0; dt < 4; ++dt) {
      const char* vp = sV + (dt * 16 + fr) * ATT_VROW + (t0 + pr * 32 + fq * 4) * 2;
      const u32x2 lo = *(const u32x2*)vp;
      const u32x2 hi = *(const u32x2*)(vp + 32);
      u32x4 vv;
      vv[0] = lo[0]; vv[1] = lo[1]; vv[2] = hi[0]; vv[3] = hi[1];
      o[dt] = __builtin_amdgcn_mfma_f32_16x16x32_bf16(__builtin_bit_cast(bf16x8, vv), pa, o[dt], 0, 0, 0);
    }
  }
}

DI void attn_ctx_item(const Params& p, int it, char* smem) {
  const int tid = tidx(), wid = tid >> 6, lane = tid & 63;
  const int b = it >> 4, h = (it >> 1) & 7, qt = (it & 1) * 8 + wid;
  const int fr = lane & 15, fq = lane >> 4;
  __syncthreads();
  attn_stage_kv<true>(p.Z + 2048 + h * 64, INW, b * 256, p.VT + (size_t)h * 256 * 2048, NTOK, b * 256, smem, tid);
  const int qtok = b * 256 + qt * 16 + fr;
  const bf16_t* qp = p.Z + (size_t)qtok * INW + 1536 + h * 64 + fq * 8;
  const bf16x8 qf0 = *(const bf16x8*)qp, qf1 = *(const bf16x8*)(qp + 32);
  float m = -INFINITY, lsum = 0.f;
  f32x4 o[4];
#pragma unroll
  for (int dt = 0; dt < 4; ++dt) o[dt] = (f32x4){0.f, 0.f, 0.f, 0.f};
  __syncthreads();
  for (int ch = 0; ch < 4; ++ch) attn_chunk_lds(qf0, qf1, smem, smem + ATT_SV_OFF, ch * 64, m, lsum, o, lane);
  attn_finish(p.YS + (size_t)qtok * 1536 + 512 + h * 64, lsum, o, lane);
}

DI void attn_lat_item(const Params& p, int l, int it, char* smem) {
  const int tid = tidx(), wid = tid >> 6, lane = tid & 63;
  const int b = it >> 6, h = (it >> 3) & 7, r = (it & 7) * 2 + (wid >> 2), j = wid & 3;
  const int fr = lane & 15, fq = lane >> 4;
  __syncthreads();
  {
    const size_t cb = (size_t)((b * 2 + l) * 8 + h) * 16384;
    attn_stage_kv<false>(p.KC + cb, 64, 0, p.VCT + cb, 256, 0, smem, tid);
  }
  const int qc = j * 16 + fr;
  const int qtok = NCTX + b * 1024 + r * 64 + qc;
  const bf16_t* qp = p.Z + (size_t)qtok * INW + 1536 + h * 64 + fq * 8;
  const bf16x8 qf0 = *(const bf16x8*)qp, qf1 = *(const bf16x8*)(qp + 32);
  float m = -INFINITY, lsum = 0.f;
  f32x4 o[4];
#pragma unroll
  for (int dt = 0; dt < 4; ++dt) o[dt] = (f32x4){0.f, 0.f, 0.f, 0.f};
  {
    const bf16_t* kbase = p.Z + 2048 + h * 64;
    const bf16_t* vtbase = p.VT + (size_t)h * 256 * 2048;
    const float* rpb_h = p.rpb + (size_t)(l * 8 + h) * 15 * 31;
    const int rs = min(max(r - 4, 0), 8);
    const int band = min(max(j * 16 - 8, 0), 32);
    for (int ch = 0; ch < 4; ++ch) {
      const int kr = rs + 2 * ch;
      const int t0 = NCTX + b * 1024 + kr * 64 + band;
      attn_chunk<true>(qf0, qf1, kbase, INW, vtbase, NTOK, t0, t0 + 16, t0 + 64, t0 + 80, rpb_h, kr - r + 7, band, qc,
                       m, lsum, o, lane);
    }
  }
  __syncthreads();
  for (int ch = 0; ch < 4; ++ch) attn_chunk_lds(qf0, qf1, smem, smem + ATT_SV_OFF, ch * 64, m, lsum, o, lane);
  attn_finish(p.YS + (size_t)qtok * 1536 + 512 + h * 64, lsum, o, lane);
}

DI void attn_load_k(const bf16_t* __restrict__ kbase, int t0, int lane, bf16x8 (&kf)[8]) {
  const int fr = lane & 15, fq = lane >> 4;
#pragma unroll
  for (int T = 0; T < 4; ++T) {
    const int tk = t0 + (T & 1) * 16 + (T >> 1) * 64;
    const bf16_t* kp = kbase + (size_t)(tk + fr) * INW + fq * 8;
    kf[2 * T] = *(const bf16x8*)kp;
    kf[2 * T + 1] = *(const bf16x8*)(kp + 32);
  }
}
DI void attn_load_v(const bf16_t* __restrict__ vtbase, int t0, int lane, u32x4 (&vf)[8]) {
  const int fr = lane & 15, fq = lane >> 4;
#pragma unroll
  for (int pr = 0; pr < 2; ++pr) {
    const int ta = t0 + pr * 64 + fq * 4, tb = ta + 16;
#pragma unroll
    for (int dt = 0; dt < 4; ++dt) {
      const bf16_t* vp = vtbase + (dt * 16 + fr) * 32;
      const u32x2 lo = *(const u32x2*)(vp + (size_t)(ta >> 5) * 2048 + (ta & 31));
      const u32x2 hi = *(const u32x2*)(vp + (size_t)(tb >> 5) * 2048 + (tb & 31));
      u32x4 vv;
      vv[0] = lo[0]; vv[1] = lo[1]; vv[2] = hi[0]; vv[3] = hi[1];
      vf[pr * 4 + dt] = vv;
    }
  }
}
DI void attn_chunk_lat(const bool HAS_NEXT, const bf16x8 qf0, const bf16x8 qf1, bf16x8 (&kf)[8], u32x4 (&vf)[8],
                       const bf16_t* __restrict__ kbase, const bf16_t* __restrict__ vtbase, int t0,
                       const float* rpb_h, int dr0, int band, int qc, float& m, float& lsum, f32x4 (&o)[4], int lane) {
  const int fr = lane & 15, fq = lane >> 4;
  f32x4 s[4];
#pragma unroll
  for (int T = 0; T < 4; ++T) {
    f32x4 z = (f32x4){0.f, 0.f, 0.f, 0.f};
    z = __builtin_amdgcn_mfma_f32_16x16x32_bf16(kf[2 * T], qf0, z, 0, 0, 0);
    z = __builtin_amdgcn_mfma_f32_16x16x32_bf16(kf[2 * T + 1], qf1, z, 0, 0, 0);
    s[T] = z;
  }

  float cmax = -INFINITY;
  const int cs = min(max(qc - 8, 0), 48);
#pragma unroll
  for (int T = 0; T < 4; ++T) {
#pragma unroll
    for (int j = 0; j < 4; ++j) {
      const int kc = band + (T & 1) * 16 + fq * 4 + j;
      const bool valid = (kc >= cs) && (kc < cs + 16);
      const int dc = min(max(kc - qc + 15, 0), 30);
      const float v = valid ? s[T][j] * 0.125f + rpb_h[(dr0 + (T >> 1)) * 31 + dc] : -INFINITY;
      s[T][j] = v;
      cmax = fmaxf(cmax, v);
    }
  }
  cmax = fmaxf(cmax, __shfl_xor(cmax, 16));
  cmax = fmaxf(cmax, __shfl_xor(cmax, 32));
  const float mnew = fmaxf(m, cmax);
  const float alpha = __expf(m - mnew);
  m = mnew;
  float ps = 0.f;
#pragma unroll
  for (int T = 0; T < 4; ++T)
#pragma unroll
    for (int j = 0; j < 4; ++j) {
      const float pv = __expf(s[T][j] - mnew);
      s[T][j] = pv;
      ps += pv;
    }
  lsum = lsum * alpha + ps;
#pragma unroll
  for (int dt = 0; dt < 4; ++dt) o[dt] *= alpha;
#pragma unroll
  for (int pr = 0; pr < 2; ++pr) {
    u32x4 pk;
    pk[0] = cvt_pk_bf16(s[2 * pr][0], s[2 * pr][1]);
    pk[1] = cvt_pk_bf16(s[2 * pr][2], s[2 * pr][3]);
    pk[2] = cvt_pk_bf16(s[2 * pr + 1][0], s[2 * pr + 1][1]);
    pk[3] = cvt_pk_bf16(s[2 * pr + 1][2], s[2 * pr + 1][3]);
    const bf16x8 pa = __builtin_bit_cast(bf16x8, pk);
#pragma unroll
    for (int dt = 0; dt < 4; ++dt)
      o[dt] = __builtin_amdgcn_mfma_f32_16x16x32_bf16(__builtin_bit_cast(bf16x8, vf[pr * 4 + dt]), pa, o[dt], 0, 0, 0);
  }
  if (HAS_NEXT) {
    attn_load_k(kbase, t0 + 128, lane, kf);
    attn_load_v(vtbase, t0 + 128, lane, vf);
  }
}

constexpr int ATT_REGION = 32768 + 64 * ATT_VROW;
DI void attn_pair(const Params& p, int l, int it, char* smem) {
  const int tid = tidx(), wid = tid >> 6, lane = tid & 63;
  const int fr = lane & 15, fq = lane >> 4;
  const int lb = it >> 6, lh = (it >> 3) & 7, r = (it & 7) * 2 + (wid >> 2), j = wid & 3;
  const int qc = j * 16 + fr;
  const int lqtok = NCTX + lb * 1024 + r * 64 + qc;
  const int cb_ = it >> 4, ch_ = (it >> 1) & 7, qt = (it & 1) * 8 + wid;
  const int cqtok = cb_ * 256 + qt * 16 + fr;
  __syncthreads();
  {
    const size_t cbo = (size_t)((lb * 2 + l) * 8 + lh) * 16384;
    attn_stage_kv<false>(p.KC + cbo, 64, 0, p.VCT + cbo, 256, 0, smem, tid);
    attn_stage_kv<true>(p.Z + 2048 + ch_ * 64, INW, cb_ * 256, p.VT + (size_t)ch_ * 256 * 2048, NTOK, cb_ * 256, smem + ATT_REGION, tid);
  }
  const bf16_t* lqp = p.Z + (size_t)lqtok * INW + 1536 + lh * 64 + fq * 8;
  const bf16x8 lq0 = *(const bf16x8*)lqp, lq1 = *(const bf16x8*)(lqp + 32);
  const bf16_t* kbase = p.Z + 2048 + lh * 64;
  const bf16_t* vtbase = p.VT + (size_t)lh * 256 * 2048;
  const float* rpb_h = p.rpb + (size_t)(l * 8 + lh) * 15 * 31;
  const int rs = min(max(r - 4, 0), 8);
  const int band = min(max(j * 16 - 8, 0), 32);
  const int tbase = NCTX + lb * 1024 + rs * 64 + band;
  float* rpb_s = (float*)(smem + 2 * ATT_REGION);
  if (tid < 465) rpb_s[tid] = rpb_h[tid];
  bf16x8 kA[8];
  u32x4 vA[8];
  attn_load_k(kbase, tbase, lane, kA);
  attn_load_v(vtbase, tbase, lane, vA);
  float m = -INFINITY, lsum = 0.f;
  f32x4 o[4];
#pragma unroll
  for (int dt = 0; dt < 4; ++dt) o[dt] = (f32x4){0.f, 0.f, 0.f, 0.f};
  const bf16_t* cqp = p.Z + (size_t)cqtok * INW + 1536 + ch_ * 64 + fq * 8;
  const bf16x8 cq0 = *(const bf16x8*)cqp, cq1 = *(const bf16x8*)(cqp + 32);
  float m2 = -INFINITY, l2 = 0.f;
  f32x4 o2[4];
#pragma unroll
  for (int dt = 0; dt < 4; ++dt) o2[dt] = (f32x4){0.f, 0.f, 0.f, 0.f};
  __syncthreads();
#pragma unroll 1
  for (int ch = 0; ch < 4; ++ch) {
    attn_chunk_lds(lq0, lq1, smem, smem + ATT_SV_OFF, ch * 64, m, lsum, o, lane);
    attn_chunk_lds(cq0, cq1, smem + ATT_REGION, smem + ATT_REGION + ATT_SV_OFF, ch * 64, m2, l2, o2, lane);
    __builtin_amdgcn_sched_barrier(0);
    attn_chunk_lat(ch < 3, lq0, lq1, kA, vA, kbase, vtbase, tbase + ch * 128, rpb_s, rs + 2 * ch - r + 7, band, qc, m, lsum, o, lane);
    __builtin_amdgcn_sched_barrier(0);
  }
  attn_finish(p.YS + (size_t)cqtok * 1536 + 512 + ch_ * 64, l2, o2, lane);
  attn_finish(p.YS + (size_t)lqtok * 1536 + 512 + lh * 64, lsum, o, lane);
}

DI void attn_ctx_unit(const Params& p, int u, int lane) {
  const int b = u >> 7, h = (u >> 4) & 7, qt = u & 15;
  const int fr = lane & 15, fq = lane >> 4;
  const int qtok = b * 256 + qt * 16 + fr;
  const bf16_t* qp = p.Z + (size_t)qtok * INW + 1536 + h * 64 + fq * 8;
  const bf16x8 qf0 = *(const bf16x8*)qp, qf1 = *(const bf16x8*)(qp + 32);
  const bf16_t* kbase = p.Z + 2048 + h * 64;
  const bf16_t* vtbase = p.VT + (size_t)h * 64 * NTOK;
  float m = -INFINITY, lsum = 0.f;
  f32x4 o[4];
#pragma unroll
  for (int dt = 0; dt < 4; ++dt) o[dt] = (f32x4){0.f, 0.f, 0.f, 0.f};
  for (int ch = 0; ch < 4; ++ch) {
    const int t0 = b * 256 + ch * 64;
    attn_chunk<false>(qf0, qf1, kbase, INW, vtbase, NTOK, t0, t0 + 16, t0 + 32, t0 + 48, nullptr, 0, 0, 0, m, lsum, o,
                      lane);
  }
  attn_finish(p.YS + (size_t)qtok * 1536 + 512 + h * 64, lsum, o, lane);
}

DI void attn_lat_unit(const Params& p, int l, int u, int lane) {
  const int b = u >> 9, h = (u >> 6) & 7, r = (u >> 2) & 15, j = u & 3;
  const int fr = lane & 15, fq = lane >> 4;
  const int qc = j * 16 + fr;
  const int qtok = NCTX + b * 1024 + r * 64 + qc;
  const bf16_t* qp = p.Z + (size_t)qtok * INW + 1536 + h * 64 + fq * 8;
  const bf16x8 qf0 = *(const bf16x8*)qp, qf1 = *(const bf16x8*)(qp + 32);
  float m = -INFINITY, lsum = 0.f;
  f32x4 o[4];
#pragma unroll
  for (int dt = 0; dt < 4; ++dt) o[dt] = (f32x4){0.f, 0.f, 0.f, 0.f};
  {
    const bf16_t* kbase = p.Z + 2048 + h * 64;
    const bf16_t* vtbase = p.VT + (size_t)h * 64 * NTOK;
    const float* rpb_h = p.rpb + (size_t)(l * 8 + h) * 15 * 31;
    const int rs = min(max(r - 4, 0), 8);
    const int band = min(max(j * 16 - 8, 0), 32);
    for (int ch = 0; ch < 4; ++ch) {
      const int kr = rs + 2 * ch;
      const int t0 = NCTX + b * 1024 + kr * 64 + band;
      attn_chunk<true>(qf0, qf1, kbase, INW, vtbase, NTOK, t0, t0 + 16, t0 + 64, t0 + 80, rpb_h, kr - r + 7, band, qc,
                       m, lsum, o, lane);
    }
  }
  {
    const bf16_t* kbase = p.KC + (size_t)((b * 2 + l) * 8 + h) * 16384;
    const bf16_t* vtbase = p.VCT + (size_t)((b * 2 + l) * 8 + h) * 16384;
    for (int ch = 0; ch < 4; ++ch) {
      const int t0 = ch * 64;
      attn_chunk<false>(qf0, qf1, kbase, 64, vtbase, 256, t0, t0 + 16, t0 + 32, t0 + 48, nullptr, 0, 0, 0, m, lsum, o,
                        lane);
    }
  }
  attn_finish(p.YS + (size_t)qtok * 1536 + 512 + h * 64, lsum, o, lane);
}

DI void unpack8(u32x4 u, float (&f)[8]) {
#pragma unroll
  for (int j = 0; j < 4; ++j) {
    f[2 * j] = bf_lo(u[j]);
    f[2 * j + 1] = bf_hi(u[j]);
  }
}
DI u32x4 pack8(const float (&f)[8]) {
  u32x4 o;
#pragma unroll
  for (int j = 0; j < 4; ++j) o[j] = cvt_pk_bf16(f[2 * j], f[2 * j + 1]);
  return o;
}

DI void conv_item(const Params& p, int l, int it) {
  const int t = tidx();
  const int row = it * 8 + (t >> 6), ch = (t & 63) * 8;
  const bf16_t* z = p.Z + (size_t)row * INW;
  float bg[8], a[8], b[8], acc[8];
  unpack8(*(const u32x4*)(z + ch), bg);
  const float* cw = p.conv_w + (size_t)l * 3 * 512 + ch;
  unpack8(*(const u32x4*)(z + 512 + ch), a);
  unpack8(*(const u32x4*)(z + 1024 + ch), b);
#pragma unroll
  for (int j = 0; j < 8; ++j) acc[j] = a[j] * b[j] * cw[512 + j];
  if (!seq_first(row)) {
    unpack8(*(const u32x4*)(z - INW + 512 + ch), a);
    unpack8(*(const u32x4*)(z - INW + 1024 + ch), b);
#pragma unroll
    for (int j = 0; j < 8; ++j) acc[j] += a[j] * b[j] * cw[j];
  }
  if (!seq_last(row)) {
    unpack8(*(const u32x4*)(z + INW + 512 + ch), a);
    unpack8(*(const u32x4*)(z + INW + 1024 + ch), b);
#pragma unroll
    for (int j = 0; j < 8; ++j) acc[j] += a[j] * b[j] * cw[1024 + j];
  }
#pragma unroll
  for (int j = 0; j < 8; ++j) acc[j] *= bg[j];
  *(u32x4*)(p.YS + (size_t)row * 1536 + ch) = pack8(acc);
}

DI void pool_item(const Params& p, int it) {
  const int t = tidx();
  const int row = it * 8 + (t >> 6), ch = (t & 63) * 8;
  const int g = ch >> 7, w = 2 << g;
  int seq0, seqn;
  if (row < NCTX) { seq0 = row & ~255; seqn = 256; } else { seq0 = row & ~1023; seqn = 1024; }
  const int tt = row - seq0;
  const int lo = max(tt - w / 2, 0), hi = min(tt - w / 2 + w, seqn);
  float acc[8], f[8];
#pragma unroll
  for (int j = 0; j < 8; ++j) acc[j] = 0.f;
  const bf16_t* zp = p.Z + (size_t)(seq0 + lo) * INW + 3072 + ch;
  const int cnt = hi - lo;
  u32x4 wv[16];
#pragma unroll
  for (int q = 0; q < 16; ++q) wv[q] = (q < cnt) ? *(const u32x4*)(zp + (size_t)q * INW) : (u32x4){0u, 0u, 0u, 0u};
#pragma unroll
  for (int q = 0; q < 16; ++q) {
    unpack8(wv[q], f);
#pragma unroll
    for (int j = 0; j < 8; ++j) acc[j] += f[j];
  }
  unpack8(*(const u32x4*)(p.Z + (size_t)row * INW + 3072 + ch), f);
  const float inv = 1.f / (float)(hi - lo);
#pragma unroll
  for (int j = 0; j < 8; ++j) acc[j] = acc[j] * inv - f[j];
  *(u32x4*)(p.YS + (size_t)row * 1536 + 1024 + ch) = pack8(acc);
}

DI float gelu_tanh(float x) {
  const float t = x * (1.5957691216f + 0.0713548163f * x * x);
  return x * __builtin_amdgcn_rcpf(1.f + __builtin_amdgcn_exp2f(-1.4426950409f * t));
}
DI void act_item(const Params& p, int l, int it) {
  const int id = it * NTHREADS + tidx();
  const int row = (id / 352) * 4, ch = (id % 352) * 8;
  const bf16_t* u = p.U + (size_t)row * (2 * DFF) + ch;
  const float* cw = p.f_conv + (size_t)l * 3 * DFF + ch;
  const bool first = seq_first(row), last = seq_last(row + 3);
  u32x4 ur[6], vr[4];
#pragma unroll
  for (int i = 0; i < 6; ++i) {
    const bool ok = (i == 0) ? !first : (i == 5) ? !last : true;
    ur[i] = ok ? *(const u32x4*)(u + (ptrdiff_t)(i - 1) * (2 * DFF)) : (u32x4){0u, 0u, 0u, 0u};
  }
#pragma unroll
  for (int i = 0; i < 4; ++i) vr[i] = *(const u32x4*)(u + (size_t)i * (2 * DFF) + DFF);
  float w0[8], w1[8], w2[8];
#pragma unroll
  for (int j = 0; j < 8; ++j) { w0[j] = cw[j]; w1[j] = cw[DFF + j]; w2[j] = cw[2 * DFF + j]; }
#pragma unroll
  for (int i = 0; i < 4; ++i) {
    float a[8], b[8], c[8], val[8], acc[8];
    unpack8(ur[i], a);
    unpack8(ur[i + 1], b);
    unpack8(ur[i + 2], c);
    unpack8(vr[i], val);
#pragma unroll
    for (int j = 0; j < 8; ++j) acc[j] = gelu_tanh(a[j] * w0[j] + b[j] * w1[j] + c[j] * w2[j]) * val[j];
    *(u32x4*)(p.ACT + (size_t)(row + i) * DFF + ch) = pack8(acc);
  }
}

DI void final_row(const Params& p, int row) {
  const int lane = tidx() & 63;
  const float* xr = p.X + (size_t)row * D;
  f32x4 v[4];
  float ss = 0.f;
#pragma unroll
  for (int i = 0; i < 4; ++i) {
    v[i] = *(const f32x4*)(xr + i * 256 + lane * 4);
    ss += v[i][0] * v[i][0] + v[i][1] * v[i][1] + v[i][2] * v[i][2] + v[i][3] * v[i][3];
  }
  ss = wave_sum(ss);
  const float rstd = rsqrtf(ss * (1.f / 1024.f) + 1e-6f);
#pragma unroll
  for (int i = 0; i < 4; ++i) {
    const int col = i * 256 + lane * 4;
    const f32x4 gg = *(const f32x4*)(p.g_final + col);
    f32x4 o;
#pragma unroll
    for (int j = 0; j < 4; ++j) o[j] = v[i][j] * rstd * gg[j];
    *(f32x4*)(p.out + (size_t)row * D + col) = o;
  }
}

constexpr int EDGE_STRIDE = 32 * 2 * DFF;
template <int CTRL>
DI float dpp_rot(float x) {
  return __builtin_bit_cast(float, __builtin_amdgcn_update_dpp(0, __builtin_bit_cast(int, x), CTRL, 0xf, 0xf, false));
}
struct EpiAct {
  static constexpr bool PERM = true, AFTER_DRAIN = false;
  bf16_t* ACT; const float* cw; float* edge; float* ex;
  DI void operator()(const f32x4 (&acc)[2][2][4][2], const pg8::Unit& u, int wr, int wc, int fr, int fq) const {
    const int chl = wc * 32 + fq * 8, ch0 = u.pn * 128 + chl;
    float w0[8], w1[8], w2[8];
#pragma unroll
    for (int j = 0; j < 8; ++j) { w0[j] = cw[ch0 + j]; w1[j] = cw[DFF + ch0 + j]; w2[j] = cw[2 * DFF + ch0 + j]; }
    float* EXF = ex;
    float* EXL = ex + 512;
#pragma unroll
    for (int ai = 0; ai < 2; ++ai) {
      const int blk = 2 * ai + wr;
      if (fr == 0) {
        *(f32x4*)(EXF + blk * 128 + chl) = acc[ai][0][0][0];
        *(f32x4*)(EXF + blk * 128 + chl + 4) = acc[ai][0][0][1];
      }
      if (fr == 15) {
        *(f32x4*)(EXL + blk * 128 + chl) = acc[ai][0][3][0];
        *(f32x4*)(EXL + blk * 128 + chl + 4) = acc[ai][0][3][1];
      }
    }
    asm volatile("s_waitcnt lgkmcnt(0)" ::: "memory");
    __builtin_amdgcn_s_barrier();
#pragma unroll
    for (int ai = 0; ai < 2; ++ai) {
      const int blk = 2 * ai + wr;
#pragma unroll
      for (int m = 0; m < 4; ++m) {
        const int row = u.pm * 256 + ai * 128 + wr * 64 + m * 16 + fr;
        float a[8], pre[8];
#pragma unroll
        for (int j = 0; j < 8; ++j) {
          const float x = acc[ai][0][m][j >> 2][j & 3];
          const float pcur = dpp_rot<0x121>(x);
          const float ncur = dpp_rot<0x12F>(x);
          float pedge, nedge;
          if (m > 0) pedge = dpp_rot<0x121>(acc[ai][0][m > 0 ? m - 1 : 0][j >> 2][j & 3]); else pedge = (blk > 0) ? EXL[(blk - 1) * 128 + chl + j] : 0.f;
          if (m < 3) nedge = dpp_rot<0x12F>(acc[ai][0][m < 3 ? m + 1 : 3][j >> 2][j & 3]); else nedge = (blk < 3) ? EXF[(blk + 1) * 128 + chl + j] : 0.f;
          const float prev = (fr == 0) ? pedge : pcur;
          const float next = (fr == 15) ? nedge : ncur;
          pre[j] = w0[j] * prev + w1[j] * x + w2[j] * next;
          a[j] = gelu_tanh(pre[j]) * acc[ai][1][m][j >> 2][j & 3];
        }
        *(u32x4*)(ACT + (size_t)row * DFF + ch0) = pack8(a);
        const bool first_row = (ai == 0 && wr == 0 && m == 0 && fr == 0), last_row = (ai == 1 && wr == 1 && m == 3 && fr == 15);
        if ((m == 0 || m == 3) && (first_row || last_row)) {
          float* e = edge + (size_t)(u.pm * 2 + (last_row ? 1 : 0)) * DFF + ch0;
#pragma unroll
          for (int j = 0; j < 8; ++j) {
            e[j] = pre[j];
            e[EDGE_STRIDE + j] = acc[ai][1][m][j >> 2][j & 3];
            e[2 * EDGE_STRIDE + j] = acc[ai][0][m][j >> 2][j & 3];
          }
        }
      }
    }
  }
};
DI void act_fix_item(const Params& p, int l, int it) {
  const int id = it * NTHREADS + tidx();
  if (id >= 12 * DFF) return;
  const int e = id / DFF, c = id % DFF;
  const int pmB = 16 + (e / 3) * 4 + (e % 3) + 1;
  const float* edge = (const float*)p.U;
  const float* cw = p.f_conv + (size_t)l * 3 * DFF;
  const float* eA = edge + (size_t)((pmB - 1) * 2 + 1) * DFF + c;
  const float* eB = edge + (size_t)(pmB * 2 + 0) * DFF + c;
  const float actA = gelu_tanh(eA[0] + cw[2 * DFF + c] * eB[2 * EDGE_STRIDE]) * eA[EDGE_STRIDE];
  const float actB = gelu_tanh(eB[0] + cw[c] * eA[2 * EDGE_STRIDE]) * eB[EDGE_STRIDE];
  p.ACT[(size_t)(pmB * 256 - 1) * DFF + c] = (bf16_t)(cvt_pk_bf16(actA, 0.f) & 0xffffu);
  p.ACT[(size_t)(pmB * 256) * DFF + c] = (bf16_t)(cvt_pk_bf16(actB, 0.f) & 0xffffu);
}

constexpr int N_PHASES = 20;
extern __shared__ __attribute__((aligned(16))) char g_smem[];
#define NI __device__ __forceinline__
constexpr size_t KV_OFF = (size_t)NTOK * D;

constexpr int WIN1_EARLY = 320;
constexpr int PREP_REST = PREP_ITEMS - PREP_T_IN;
DI void prep_rest_item(const Params& p, int l, int k, float* sm) {
  prep_item(p, l, k < PREP_WEFF ? k : k + PREP_T_IN, sm);
}
NI void ph_prep0(const Params& p) {
  char* smem = g_smem;
  const int nb = gridDim.x, bid = bidx();
  const int total = PREP_T_IN + MOD_ITEMS + CACHE_ITEMS;
  for (int it = bid; it < total; it += nb) {
    if (it < MOD_ITEMS) mod_item(p, it, (float*)smem);
    else if (it < MOD_ITEMS + CACHE_ITEMS) cache_item(p, it - MOD_ITEMS);
    else prep_item(p, 0, PREP_WEFF + (it - MOD_ITEMS - CACHE_ITEMS), (float*)smem);
  }
}
NI void ph_final(const Params& p) {
  const int nb = gridDim.x, bid = bidx(), wid = tidx() >> 6;
  for (int row = bid * NWAVES + wid; row < NTOK; row += nb * NWAVES) final_row(p, row);
}
NI void ph_normmod1(const Params& p, int l) {
  char* smem = g_smem;
  const int nb = gridDim.x, bid = bidx(), wid = tidx() >> 6;
  for (int row = (bid * NWAVES + wid) * 2; row < NTOK; row += nb * NWAVES * 2)
    normmod_row2(p, l, 0, row, l == 0 ? xin_row(p, row) : p.X + (size_t)row * D);
  if (l == 1)
    for (int k = WIN1_EARLY + bid; k < PREP_T_IN; k += nb) prep_item(p, 1, PREP_WEFF + k, (float*)smem);
}
NI void ph_inproj(const Params& p, int l) {
  pg8::Gemm g{p.H, p.WIN, NTOK, INW, D};
  pg8::StaticOrder S; S.init(NTOK, INW, (int)gridDim.x, bidx());
  EpiZ8 E{p.Z, p.VT, p.out + KV_OFF, l};
  pg8::gemm_phase<EpiZ8, pg8::StaticOrder, true, true>((PG8_LAS unsigned char*)g_smem, g, S, E);
  __syncthreads();
  {
    const int nb = (int)gridDim.x, nunits = (NTOK / 256) * (INW / 256), busy = nunits % nb, bid = bidx();
    const Params q = load_params();
    if (busy != 0 && bid >= busy)
      for (int k = bid - busy; k < PREP_REST; k += nb - busy) prep_rest_item(q, l, k, (float*)g_smem);
    else if (busy == 0)
      for (int k = bid; k < PREP_REST; k += nb) prep_rest_item(q, l, k, (float*)g_smem);
  }
}
NI void ph_attn(const Params& p, int l) {
  const int nb = gridDim.x, bid = bidx();
  for (int it = bid; it < 256; it += nb) attn_pair(p, l, it, g_smem);
  __syncthreads();
}
NI void ph_convpool(const Params& p, int l) {
  const int nb = gridDim.x, bid = bidx();
  for (int it = bid; it < 2048; it += nb) {
    if (it < 1024) conv_item(p, l, it);
    else pool_item(p, it - 1024);
  }
}
NI void ph_branch(const Params& p) {
  EpiBf16 epi{p.MERGED, D};
  gemm_phase<true>(p.YS, 1536, p.WB, 1536, 1536, D, g_smem, epi, p.Z + 3584);
}
NI void ph_outproj(const Params& p, int l) {
  EpiResid epi{&p, l, 2048, l == 0};
  gemm_phase<false>(p.MERGED, D, p.WO, D, D, D, g_smem, epi, nullptr);
}
NI void ph_normmod2(const Params& p, int l) {
  const int nb = gridDim.x, bid = bidx(), wid = tidx() >> 6;
  for (int row = (bid * NWAVES + wid) * 2; row < NTOK; row += nb * NWAVES * 2) normmod_row2(p, l, 1, row, p.X + (size_t)row * D);
}
NI void ph_up(const Params& p, int l) {
  pg8::Gemm g{p.H, p.WU, NTOK, 2 * DFF, D};
  pg8::StaticOrder S; S.init(NTOK, 2 * DFF, (int)gridDim.x, bidx());
  EpiAct E{p.ACT, p.f_conv + (size_t)l * 3 * DFF, (float*)p.U, (float*)(g_smem + 131072)};
  pg8::gemm_phase<EpiAct, pg8::StaticOrder, true, true>((PG8_LAS unsigned char*)g_smem, g, S, E);
  __syncthreads();
  if (l == 0) {
    const int nb = (int)gridDim.x, nunits = (NTOK / 256) * (2 * DFF / 256), busy = nunits % nb, bid = bidx();
    const Params q = load_params();
    if (busy != 0 && bid >= busy)
      for (int k = bid - busy; k < WIN1_EARLY; k += nb - busy) prep_item(q, 1, PREP_WEFF + k, (float*)g_smem);
    else if (busy == 0)
      for (int k = bid; k < WIN1_EARLY; k += nb) prep_item(q, 1, PREP_WEFF + k, (float*)g_smem);
  }
}
NI void ph_act(const Params& p, int l) {
  const int nb = gridDim.x, bid = bidx();
  for (int it = bid; it < (12 * DFF + NTHREADS - 1) / NTHREADS; it += nb) act_fix_item(p, l, it);
}
DI void act_fix_panel(const Params& p, int l, int pm) {
  if (pm < 16) return;
  const float* edge = (const float*)p.U;
  const float* cw = p.f_conv + (size_t)l * 3 * DFF;
  const int t = tidx();
  if ((pm & 3) != 0) {
    const float* eB = edge + (size_t)(pm * 2 + 0) * DFF;
    const float* eA = edge + (size_t)((pm - 1) * 2 + 1) * DFF;
    for (int c = t; c < DFF; c += NTHREADS) {
      const float a = gelu_tanh(eB[c] + cw[c] * eA[2 * EDGE_STRIDE + c]) * eB[EDGE_STRIDE + c];
      p.ACT[(size_t)(pm * 256) * DFF + c] = (bf16_t)(cvt_pk_bf16(a, 0.f) & 0xffffu);
    }
  }
  if ((pm & 3) != 3) {
    const float* eA = edge + (size_t)(pm * 2 + 1) * DFF;
    const float* eB = edge + (size_t)((pm + 1) * 2 + 0) * DFF;
    for (int c = t; c < DFF; c += NTHREADS) {
      const float a = gelu_tanh(eA[c] + cw[2 * DFF + c] * eB[2 * EDGE_STRIDE + c]) * eA[EDGE_STRIDE + c];
      p.ACT[(size_t)(pm * 256 + 255) * DFF + c] = (bf16_t)(cvt_pk_bf16(a, 0.f) & 0xffffu);
    }
  }
  asm volatile("s_waitcnt vmcnt(0)" ::: "memory");
  __syncthreads();
}
NI void ph_down(const Params& p, int l) {
  {
    const int bid = bidx(), nb = gridDim.x, cstep = nb >> 3;
    for (int cj = bid >> 3; cj < 32; cj += cstep) act_fix_panel(p, l, 4 * (bid & 7) + (cj & 3));
  }
  EpiResid epi{&p, l, 5120, false};
  gemm_phase<false>(p.ACT, DFF, p.WD, DFF, DFF, D, g_smem, epi, nullptr);
}

DI void run_phase(int ph) {
  const Params p = load_params();
  if (ph == 0) { ph_prep0(p); return; }
  if (ph == 19) { ph_final(p); return; }
  const int l = (ph - 1) / 9, s = (ph - 1) % 9;
  switch (s) {
    case 0: ph_normmod1(p, l); break;
    case 1: ph_inproj(p, l); break;
    case 2:
      ph_convpool(p, l);
#ifdef REP_CONVPOOL
      if (l == 0) ph_convpool(p, l);
#endif
      ph_attn(p, l);
#ifdef REP_ATTN
      if (l == 0) ph_attn(p, l);
#endif
      break;
    case 3: ph_branch(p); break;
    case 4: ph_outproj(p, l); break;
    case 5: ph_normmod2(p, l); break;
    case 6: ph_up(p, l); break;
    case 7: ph_act(p, l); break;
    case 8: ph_down(p, l); break;
  }
}


#define XB_TMO      128
#define XB_XCNT(j)  (256  + 64 * (j))
#define XB_XSUB(j)  (1280 + 64 * (j))
#define XB_XGEN(j)  (2304 + 64 * (j))
#define XB_TOP      3328
#define XB_TOPGEN   3392
#define XCD_BAR_WORDS 3456
#define XB_SPIN_CAP (1u << 20)
DI unsigned xb_ld(unsigned* p) { return __hip_atomic_load(p, __ATOMIC_RELAXED, __HIP_MEMORY_SCOPE_AGENT); }
DI unsigned xb_add(unsigned* p, unsigned v) { return __hip_atomic_fetch_add(p, v, __ATOMIC_RELAXED, __HIP_MEMORY_SCOPE_AGENT); }
DI unsigned xb_xcc_id() { return (unsigned)__builtin_amdgcn_s_getreg((3 << 11) | 20) & 0xFu; }
#define XB_SPIN(cond, bar) do { unsigned _sp = 0; while (cond) { __builtin_amdgcn_s_sleep(1); \
    if ((++_sp & 255u) == 0u) { if (xb_ld(&(bar)[XB_TMO])) break; if (_sp > XB_SPIN_CAP) { atomicAdd(&(bar)[XB_TMO], 1u); break; } } } } while (0)
struct XcdBarrier { unsigned* bar; unsigned x; };
DI XcdBarrier xcd_barrier_post(unsigned* bar) {
  XcdBarrier b; b.bar = bar; b.x = xb_xcc_id();
  if (threadIdx.x == 0) {
    volatile unsigned* st = (volatile unsigned*)(g_smem + LDS_XB_OFF);
    st[0] = 0u; st[1] = 0u;
    (void)xb_add(&bar[XB_XCNT(b.x)], 1u);
  }
  return b;
}
DI void xcd_barrier_complete(unsigned* bar, unsigned x, unsigned& nloc, unsigned& nx) {
  const unsigned G = gridDim.x;
  unsigned sum, cnt, mine, sp = 0u;
  for (;;) {
    sum = 0u; cnt = 0u; mine = 0u;
#pragma unroll
    for (unsigned j = 0; j < 16; ++j) { const unsigned c = xb_ld(&bar[XB_XCNT(j)]); sum += c; cnt += (c > 0u) ? 1u : 0u; mine = (j == x) ? c : mine; }
    if (sum == G) break;
    __builtin_amdgcn_s_sleep(1);
    if ((++sp & 255u) == 0u) { if (xb_ld(&bar[XB_TMO])) break; if (sp > XB_SPIN_CAP) { atomicAdd(&bar[XB_TMO], 1u); break; } }
  }
  nloc = mine > 0u ? mine : 1u; nx = cnt > 0u ? cnt : 1u;
}
DI void xcd_barrier(XcdBarrier& b) {
  asm volatile("s_waitcnt vmcnt(0)" ::: "memory");
  __syncthreads();
  if (threadIdx.x == 0) {
    unsigned* bar = b.bar;
    __builtin_amdgcn_s_waitcnt(0);
    volatile unsigned* st = (volatile unsigned*)(g_smem + LDS_XB_OFF);
    unsigned nloc = st[0], nx = st[1];
    if (nloc == 0u) { xcd_barrier_complete(bar, b.x, nloc, nx); st[0] = nloc; st[1] = nx; }
    const unsigned old = xb_add(&bar[XB_XSUB(b.x)], 1u);
    const unsigned gen = old / nloc;
    if (old + 1u == (gen + 1u) * nloc) {
      __builtin_amdgcn_fence(__ATOMIC_RELEASE, "agent");
      asm volatile("s_waitcnt vmcnt(0)" ::: "memory");
      const unsigned og = xb_add(&bar[XB_TOP], 1u);
      const unsigned tg = og / nx;
      if (og + 1u == (tg + 1u) * nx) xb_add(&bar[XB_TOPGEN], 1u);
      else XB_SPIN(xb_ld(&bar[XB_TOPGEN]) == tg, bar);
      __builtin_amdgcn_fence(__ATOMIC_ACQUIRE, "agent");
      xb_add(&bar[XB_XGEN(b.x)], 1u);
      asm volatile("s_waitcnt vmcnt(0)" ::: "memory");
    } else {
      XB_SPIN(xb_ld(&bar[XB_XGEN(b.x)]) == gen, bar);
      __builtin_amdgcn_fence(__ATOMIC_ACQUIRE, "agent");
      asm volatile("s_waitcnt vmcnt(0)" ::: "memory");
    }
  }
  __syncthreads();
}

__global__ void __launch_bounds__(NTHREADS, 2) mega_kernel(Params p, int ph_lo, int ph_hi) {
  cg::grid_group grid = cg::this_grid();
  XcdBarrier xb = xcd_barrier_post(load_params().BAR);
#ifndef REPEAT_MASK
#define REPEAT_MASK 0u
#endif
  for (int ph = ph_lo; ph < ph_hi; ++ph) {
    if (ph >= 1 && (ph - 1) % 9 == 7) continue;
    run_phase(ph);
    if ((REPEAT_MASK >> ph) & 1u) {
      xcd_barrier(xb);
      run_phase(ph);
    }
    if (ph + 1 < ph_hi) xcd_barrier(xb);
  }
  if (ph_hi > 1000) grid.sync();
}

extern "C" void kernel_launch(void* const* d_in, const int* in_sizes, int n_in, void* d_out, int out_size, void* d_ws,
                              size_t ws_size, hipStream_t stream) {
  static int grid_blocks = 0;
  if (!grid_blocks) {
    int dev = 0, cus = 0, per_cu = 0;
    (void)hipGetDevice(&dev);
    (void)hipDeviceGetAttribute(&cus, hipDeviceAttributeMultiprocessorCount, dev);
    (void)hipFuncSetAttribute((const void*)mega_kernel, hipFuncAttributeMaxDynamicSharedMemorySize, LDS_BYTES);
    (void)hipOccupancyMaxActiveBlocksPerMultiprocessor(&per_cu, mega_kernel, NTHREADS, LDS_BYTES);
    if (per_cu < 1) fprintf(stderr, "occupancy query reports %d blocks/CU\n", per_cu);
    grid_blocks = cus;
  }
  Params p{};
  const float** f = (const float**)&p;
  for (int i = 0; i < 20; ++i) f[i] = (const float*)d_in[i];
  p.out = (float*)d_out;
  char* ws = (char*)d_ws;
  size_t off = 0;
  auto take = [&](size_t bytes) { char* r = ws + off; off += (bytes + 255) & ~(size_t)255; return r; };
  p.BAR = (unsigned*)take(XCD_BAR_WORDS * 4);
  p.MOD = (float*)take(2 * 5 * 6144 * 4);
  p.X = (float*)take((size_t)NTOK * D * 4);
  p.KC = (bf16_t*)take((size_t)64 * 16384 * 2);
  p.VCT = (bf16_t*)take((size_t)64 * 16384 * 2);
  p.WIN = (bf16_t*)take((size_t)INW * D * 2);
  p.WB = (bf16_t*)take((size_t)D * 1536 * 2);
  p.WO = (bf16_t*)take((size_t)D * D * 2);
  p.WU = (bf16_t*)take((size_t)2 * DFF * D * 2);
  p.WD = (bf16_t*)take((size_t)D * DFF * 2);
  p.H = (bf16_t*)take((size_t)NTOK * D * 2);
  p.Z = (bf16_t*)take((size_t)NTOK * INW * 2);
  p.U = p.Z;
  char* r2 = take((size_t)NTOK * 1536 * 2 + (size_t)NTOK * D * 2 + (size_t)512 * NTOK * 2);
  p.YS = (bf16_t*)r2;
  p.MERGED = (bf16_t*)(r2 + (size_t)NTOK * 1536 * 2);
  p.VT = (bf16_t*)(r2 + (size_t)NTOK * 1536 * 2 + (size_t)NTOK * D * 2);
  p.ACT = (bf16_t*)r2;
  (void)hipMemsetAsync(p.BAR, 0, XCD_BAR_WORDS * 4, stream);
#ifndef MULTI_LAUNCH
#define MULTI_LAUNCH 0
#endif
#if MULTI_LAUNCH
  for (int ph = 0; ph < N_PHASES; ++ph) mega_kernel<<<dim3(grid_blocks), dim3(NTHREADS), LDS_BYTES, stream>>>(p, ph, ph + 1);
#else
  int lo = 0, hi = N_PHASES;
  void* args[] = {&p, &lo, &hi};
  hipError_t e = hipLaunchCooperativeKernel((void*)mega_kernel, dim3(grid_blocks), dim3(NTHREADS), args, LDS_BYTES, stream);
  if (e != hipSuccess) fprintf(stderr, "cooperative launch failed: %s (grid %d)\n", hipGetErrorString(e), grid_blocks);
#endif
}
```
